# Optimizing an MI355X kernel written in HIP

```python
import jax, jax.numpy as jnp
from jax import lax
import numpy as np

D_MODEL = 1024
BATCH = 4
SEQ = 4096
DEPTH = 1

CTX_LEN = 256
GRID_W = 64
MIX_WIDTH = D_MODEL
MLSTM_HEADS = 4
MLSTM_WIDTH = MIX_WIDTH // 2
MLSTM_HEAD_DIM = MLSTM_WIDTH // MLSTM_HEADS
RET_HEADS = 4
RET_WIDTH = MIX_WIDTH - MLSTM_WIDTH
RET_HEAD_DIM = RET_WIDTH // RET_HEADS
N_GATE_COLS = 4 * MLSTM_HEADS
SPLIT_SIZES = (MLSTM_WIDTH, MLSTM_WIDTH, MLSTM_WIDTH, MLSTM_WIDTH, N_GATE_COLS,
               RET_WIDTH, RET_WIDTH, RET_WIDTH, RET_WIDTH)
IN_COLS = sum(SPLIT_SIZES)
CHUNK = 128
N_EXPERTS = 16
EC_CAPACITY_FACTOR = 2
EXPERT_FF = 2816
ROPE_BASE = 10000.0
EPS = 1e-6

kernel_name = "hybrid_mlstm_retention_ecmoe_dit"


def rmsnorm(x, w):
    xf = x.astype(jnp.float32)
    y = xf * lax.rsqrt(jnp.mean(xf * xf, axis=-1, keepdims=True) + EPS)
    return (y * w.astype(jnp.float32)).astype(x.dtype)


def modulate(x, w, shift, scale):
    return rmsnorm(x, w) * (1 + scale) + shift


def heads(t, n_heads):
    B, T, _ = t.shape
    return t.reshape(B, T, n_heads, -1).transpose(0, 2, 1, 3)


def head_rmsnorm(h, w):
    y = h * lax.rsqrt(jnp.mean(h * h, axis=-1, keepdims=True) + EPS)
    B, H, T, dh = y.shape
    return y.transpose(0, 2, 1, 3).reshape(B, T, H * dh) * w.astype(jnp.float32)


def to_chunks(t):
    B, H, T = t.shape[:3]
    t = t.reshape((B, H, T // CHUNK, CHUNK) + t.shape[3:])
    return jnp.moveaxis(t, 2, 0)


def from_chunks(h):
    N, B, H, L, d = h.shape
    return jnp.moveaxis(h, 0, 2).reshape(B, H, N * L, d)


def flip_if(t, rev):
    return jnp.flip(t, axis=2) if rev else t


def mlstm_scan(q, k, v, ig, lf, state, with_out):
    tril = jnp.tril(jnp.ones((CHUNK, CHUNK), dtype=bool))

    def step(carry, inp):
        C, n, m = carry
        qc, kc, vc, ic, fc = inp
        b = jnp.cumsum(fc, axis=-1)
        bL = b[..., -1]
        g = bL[..., None] - b + ic
        m_new = jnp.maximum(bL + m, jnp.max(g, axis=-1))
        w = jnp.exp(g - m_new[..., None])
        decay = jnp.exp(bL + m - m_new)
        C_new = decay[..., None, None] * C + jnp.einsum('bhs,bhsv,bhsk->bhvk', w, vc, kc)
        n_new = decay[..., None] * n + jnp.einsum('bhs,bhsk->bhk', w, kc)
        if with_out:
            d_log = jnp.where(tril, b[..., :, None] - b[..., None, :] + ic[..., None, :], -jnp.inf)
            inter = b + m[..., None]
            m_t = jnp.maximum(inter, jnp.max(d_log, axis=-1))
            d_w = jnp.exp(d_log - m_t[..., None])
            i_w = jnp.exp(inter - m_t)
            s = jnp.einsum('bhtk,bhsk->bhts', qc, kc) * d_w
            num = jnp.einsum('bhts,bhsv->bhtv', s, vc) + i_w[..., None] * jnp.einsum('bhvk,bhtk->bhtv', C, qc)
            den = jnp.sum(s, axis=-1) + i_w * jnp.einsum('bhk,bhtk->bht', n, qc)
            h = num / jnp.maximum(jnp.abs(den), jnp.exp(-m_t))[..., None]
        else:
            h = None
        return (C_new, n_new, m_new), h

    xs = (to_chunks(q), to_chunks(k), to_chunks(v), to_chunks(ig), to_chunks(lf))
    carry, hs = lax.scan(step, state, xs)
    return (from_chunks(hs) if with_out else None), carry


def retention_scan(q, k, v, lg, state, with_out):
    pos = jnp.arange(CHUNK, dtype=jnp.float32)
    rel = pos[:, None] - pos[None, :]
    d_mat = jnp.where(rel >= 0, jnp.exp(jnp.maximum(rel, 0.0)[None] * lg[:, None, None]), 0.0)
    inter = jnp.exp((pos + 1.0)[None] * lg[:, None])
    k_w = jnp.exp((CHUNK - 1.0 - pos)[None] * lg[:, None])
    d_chunk = jnp.exp(CHUNK * lg)

    def step(R, inp):
        qc, kc, vc = inp
        R_new = d_chunk[None, :, None, None] * R + jnp.einsum('hs,bhsv,bhsk->bhvk', k_w, vc, kc)
        if with_out:
            s = jnp.einsum('bhtk,bhsk->bhts', qc, kc) * d_mat
            out = jnp.einsum('bhts,bhsv->bhtv', s, vc) + inter[None, :, :, None] * jnp.einsum('bhvk,bhtk->bhtv', R, qc)
        else:
            out = None
        return R_new, out

    R_fin, outs = lax.scan(step, state, (to_chunks(q), to_chunks(k), to_chunks(v)))
    return (from_chunks(outs) if with_out else None), R_fin


def rotate_pairs(t, cos, sin):
    half = t.shape[-1] // 2
    t1, t2 = t[..., :half], t[..., half:]
    return jnp.concatenate([t1 * cos - t2 * sin, t1 * sin + t2 * cos], axis=-1)


def axial_rope(t, rope_cs):
    cr, sr, cc, sc = rope_cs
    half = t.shape[-1] // 2
    return jnp.concatenate([rotate_pairs(t[..., :half], cr, sr),
                            rotate_pairs(t[..., half:], cc, sc)], axis=-1)


def split_proj(p):
    idx = np.cumsum(SPLIT_SIZES)[:-1].tolist()
    return jnp.split(p, idx, axis=-1)


def mlstm_inputs(parts, gate_bias):
    mq, mk, mv, _, mg = parts[:5]
    B, T, _ = mq.shape
    q = heads(mq, MLSTM_HEADS).astype(jnp.float32)
    k = heads(mk, MLSTM_HEADS).astype(jnp.float32) * (MLSTM_HEAD_DIM ** -0.5)
    v = heads(mv, MLSTM_HEADS).astype(jnp.float32)
    g = (mg + gate_bias).astype(jnp.float32).reshape(B, T, 4, MLSTM_HEADS).transpose(2, 0, 3, 1)
    return q, k, v, g[:2], jax.nn.log_sigmoid(g[2:])


def retention_inputs(parts, rope_cs):
    rq, rk, rv = parts[5:8]
    q = heads(rq, RET_HEADS).astype(jnp.float32)
    k = heads(rk, RET_HEADS).astype(jnp.float32) * (RET_HEAD_DIM ** -0.5)
    if rope_cs is not None:
        q, k = axial_rope(q, rope_cs), axial_rope(k, rope_cs)
    return q, k, heads(rv, RET_HEADS).astype(jnp.float32)


def token_mix(hc, hl, w_in, gate_bias, decay_logit, mlstm_norm_w, ret_norm_w, w_out, rope_cs, need_ctx_out):
    B = hl.shape[0]
    pc, pl = split_proj(hc @ w_in), split_proj(hl @ w_in)

    cq, ck, cv, cig, clf = mlstm_inputs(pc, gate_bias)
    lq, lk, lv, lig, llf = mlstm_inputs(pl, gate_bias)
    m_lat, m_ctx = 0.0, 0.0
    for d in range(2):
        rev = d == 1
        st0 = (jnp.zeros((B, MLSTM_HEADS, MLSTM_HEAD_DIM, MLSTM_HEAD_DIM), jnp.float32),
               jnp.zeros((B, MLSTM_HEADS, MLSTM_HEAD_DIM), jnp.float32),
               jnp.zeros((B, MLSTM_HEADS), jnp.float32))
        h_c, st = mlstm_scan(flip_if(cq, rev), flip_if(ck, rev), flip_if(cv, rev),
                             flip_if(cig[d], rev), flip_if(clf[d], rev), st0, need_ctx_out)
        h_l, _ = mlstm_scan(flip_if(lq, rev), flip_if(lk, rev), flip_if(lv, rev),
                            flip_if(lig[d], rev), flip_if(llf[d], rev), st, True)
        m_lat = m_lat + flip_if(h_l, rev)
        if need_ctx_out:
            m_ctx = m_ctx + flip_if(h_c, rev)

    lg = jax.nn.log_sigmoid(decay_logit.astype(jnp.float32))
    rcq, rck, rcv = retention_inputs(pc, None)
    rlq, rlk, rlv = retention_inputs(pl, rope_cs)
    r_lat, r_ctx = 0.0, 0.0
    for d in range(2):
        rev = d == 1
        R0 = jnp.zeros((B, RET_HEADS, RET_HEAD_DIM, RET_HEAD_DIM), jnp.float32)
        o_c, R = retention_scan(flip_if(rcq, rev), flip_if(rck, rev), flip_if(rcv, rev), lg[d], R0, need_ctx_out)
        o_l, _ = retention_scan(flip_if(rlq, rev), flip_if(rlk, rev), flip_if(rlv, rev), lg[d], R, True)
        r_lat = r_lat + flip_if(o_l, rev)
        if need_ctx_out:
            r_ctx = r_ctx + flip_if(o_c, rev)

    def merge(parts, m_sum, r_sum, dtype):
        y_m = jax.nn.sigmoid(parts[3].astype(jnp.float32)) * head_rmsnorm(m_sum, mlstm_norm_w)
        y_r = jax.nn.silu(parts[8].astype(jnp.float32)) * head_rmsnorm(r_sum, ret_norm_w)
        return jnp.concatenate([y_m, y_r], axis=-1).astype(dtype) @ w_out

    y_lat = merge(pl, m_lat, r_lat, hl.dtype)
    y_ctx = merge(pc, m_ctx, r_ctx, hc.dtype) if need_ctx_out else None
    return y_ctx, y_lat


def expert_choice_ffn(h, w_router, w_gate, w_up, w_down):
    B, T, D = h.shape
    cap = EC_CAPACITY_FACTOR * T // N_EXPERTS
    aff = jax.nn.softmax((h @ w_router).astype(jnp.float32), axis=-1)
    gate, idx = lax.top_k(aff.transpose(0, 2, 1), cap)
    xg = jax.vmap(lambda hb, ib: hb[ib])(h, idx)
    a = jnp.einsum('becd,edf->becf', xg, w_gate)
    u = jnp.einsum('becd,edf->becf', xg, w_up)
    y = jnp.einsum('becf,efd->becd', jax.nn.silu(a) * u, w_down) * gate[..., None].astype(h.dtype)
    return jax.vmap(lambda yb, ib: jnp.zeros((T, D), yb.dtype).at[ib.reshape(-1)].add(yb.reshape(-1, D)))(y, idx)


def setup_inputs(seed: int = 0) -> dict:
    key = jax.random.key(seed)
    ks = jax.random.split(key, 22)
    f32 = jnp.float32

    def nrm(k, shape, s):
        return jax.random.normal(k, shape, f32) * s

    x = nrm(ks[0], (BATCH, SEQ, D_MODEL), 1.0)
    c = nrm(ks[1], (BATCH, D_MODEL), 1.0)
    ctx = nrm(ks[2], (BATCH, CTX_LEN, D_MODEL), 1.0)
    c_ctx = nrm(ks[3], (D_MODEL,), 1.0)
    w_ada = nrm(ks[4], (DEPTH, D_MODEL, 6 * D_MODEL), 0.5 * D_MODEL ** -0.5)
    b_ada = nrm(ks[5], (DEPTH, 6 * D_MODEL), 0.02)
    norm1_w = 1.0 + nrm(ks[6], (DEPTH, D_MODEL), 0.02)
    norm2_w = 1.0 + nrm(ks[7], (DEPTH, D_MODEL), 0.02)
    w_in = nrm(ks[8], (DEPTH, D_MODEL, IN_COLS), D_MODEL ** -0.5)
    i_bias = nrm(ks[9], (DEPTH, 2 * MLSTM_HEADS), 0.1)
    f_bias = jnp.tile(jnp.linspace(3.0, 6.0, MLSTM_HEADS, dtype=f32), 2)[None] + nrm(ks[10], (DEPTH, 2 * MLSTM_HEADS), 0.1)
    mlstm_gate_bias = jnp.concatenate([i_bias, f_bias], axis=-1)
    base_logit = jnp.log(2.0 ** jnp.arange(5, 5 + RET_HEADS, dtype=f32) - 1.0)
    ret_decay_logit = base_logit[None, None] + nrm(ks[11], (DEPTH, 2, RET_HEADS), 0.05)
    mlstm_norm_w = 1.0 + nrm(ks[12], (DEPTH, MLSTM_WIDTH), 0.02)
    ret_norm_w = 1.0 + nrm(ks[13], (DEPTH, RET_WIDTH), 0.02)
    w_out = nrm(ks[14], (DEPTH, MIX_WIDTH, D_MODEL), MIX_WIDTH ** -0.5)
    w_router = nrm(ks[15], (DEPTH, D_MODEL, N_EXPERTS), D_MODEL ** -0.5)
    w_gate = nrm(ks[16], (DEPTH, N_EXPERTS, D_MODEL, EXPERT_FF), D_MODEL ** -0.5)
    w_up = nrm(ks[17], (DEPTH, N_EXPERTS, D_MODEL, EXPERT_FF), D_MODEL ** -0.5)
    w_down = nrm(ks[18], (DEPTH, N_EXPERTS, EXPERT_FF, D_MODEL), EXPERT_FF ** -0.5)
    final_norm_w = 1.0 + nrm(ks[19], (D_MODEL,), 0.02)
    return {"x": x, "c": c, "ctx": ctx, "c_ctx": c_ctx, "w_ada": w_ada, "b_ada": b_ada,
            "norm1_w": norm1_w, "norm2_w": norm2_w, "w_in": w_in, "mlstm_gate_bias": mlstm_gate_bias,
            "ret_decay_logit": ret_decay_logit, "mlstm_norm_w": mlstm_norm_w, "ret_norm_w": ret_norm_w,
            "w_out": w_out, "w_router": w_router, "w_gate": w_gate, "w_up": w_up, "w_down": w_down,
            "final_norm_w": final_norm_w}


def reference(x, c, ctx, c_ctx, w_ada, b_ada, norm1_w, norm2_w, w_in, mlstm_gate_bias,
              ret_decay_logit, mlstm_norm_w, ret_norm_w, w_out, w_router, w_gate, w_up, w_down,
              final_norm_w):
    T = x.shape[1]
    ROWS = T // GRID_W
    rows = jnp.repeat(jnp.arange(ROWS, dtype=jnp.float32), GRID_W)
    cols = jnp.tile(jnp.arange(GRID_W, dtype=jnp.float32), ROWS)
    n_freq = RET_HEAD_DIM // 4
    inv_freq = ROPE_BASE ** (-jnp.arange(n_freq, dtype=jnp.float32) / n_freq)
    ang_r, ang_c = rows[:, None] * inv_freq, cols[:, None] * inv_freq
    rope_cs = (jnp.cos(ang_r), jnp.sin(ang_r), jnp.cos(ang_c), jnp.sin(ang_c))

    xl, xc = x, ctx
    for l in range(DEPTH):
        last = l == DEPTH - 1
        mod_l = jax.nn.silu(c) @ w_ada[l] + b_ada[l]
        mod_c = jax.nn.silu(c_ctx) @ w_ada[l] + b_ada[l]
        sh1, sc1, g1, sh2, sc2, g2 = jnp.split(mod_l[:, None, :], 6, axis=-1)
        csh1, csc1, cg1, csh2, csc2, cg2 = jnp.split(mod_c, 6, axis=-1)

        hl = modulate(xl, norm1_w[l], sh1, sc1)
        hc = modulate(xc, norm1_w[l], csh1, csc1)
        y_ctx, y_lat = token_mix(hc, hl, w_in[l], mlstm_gate_bias[l], ret_decay_logit[l],
                                 mlstm_norm_w[l], ret_norm_w[l], w_out[l], rope_cs, not last)
        xl = xl + g1 * y_lat
        xl = xl + g2 * expert_choice_ffn(modulate(xl, norm2_w[l], sh2, sc2),
                                         w_router[l], w_gate[l], w_up[l], w_down[l])
        if not last:
            xc = xc + cg1 * y_ctx
            xc = xc + cg2 * expert_choice_ffn(modulate(xc, norm2_w[l], csh2, csc2),
                                              w_router[l], w_gate[l], w_up[l], w_down[l])
    return rmsnorm(xl, final_norm_w)
```

```cpp
#include <hip/hip_runtime.h>
#include <cstdint>
#include <cstdio>

constexpr int D = 1024, NB = 4, T = 4096, TC = 256, NH = 4, DH = 128;
constexpr int ML = NB * T;
constexpr int MC = NB * TC;
constexpr int MA = ML + MC;
constexpr int INC = 4112;
constexpr int NE = 16, CAP = 512, FF = 2816;
constexpr int NSLOT = NB * NE * CAP;
constexpr float EPS = 1e-6f;
constexpr int C_MQ = 0, C_MK = 512, C_MV = 1024, C_MO = 1536, C_MG = 2048, C_RQ = 2064, C_RK = 2576, C_RV = 3088, C_RO = 3600;

__device__ __forceinline__ float sigmoidf_(float x) { return 1.f / (1.f + expf(-x)); }
__device__ __forceinline__ float siluf_(float x) { return x / (1.f + expf(-x)); }
__device__ __forceinline__ float logsigmoidf_(float x) { return fminf(x, 0.f) - log1pf(expf(-fabsf(x))); }

__global__ void nk_mod(const float* __restrict__ c, const float* __restrict__ c_ctx, const float* __restrict__ w_ada,
                       const float* __restrict__ b_ada, float* __restrict__ mod) {
    __shared__ float sv[5][1024];
    for (int i = threadIdx.x; i < 5 * 1024; i += blockDim.x) { int r = i >> 10, k = i & 1023; float v = r < 4 ? c[r * 1024 + k] : c_ctx[k]; sv[r][k] = siluf_(v); }
    __syncthreads();
    const int n = blockIdx.x * blockDim.x + threadIdx.x;
    float a0 = 0, a1 = 0, a2 = 0, a3 = 0, a4 = 0;
    for (int k = 0; k < 1024; ++k) { float w = w_ada[(size_t)k * 6144 + n]; a0 += sv[0][k] * w; a1 += sv[1][k] * w; a2 += sv[2][k] * w; a3 += sv[3][k] * w; a4 += sv[4][k] * w; }
    float bb = b_ada[n];
    mod[0 * 6144 + n] = a0 + bb; mod[1 * 6144 + n] = a1 + bb; mod[2 * 6144 + n] = a2 + bb; mod[3 * 6144 + n] = a3 + bb; mod[4 * 6144 + n] = a4 + bb;
}

__device__ __forceinline__ float block_sum_256(float v, float* red) {
    for (int o = 32; o > 0; o >>= 1) v += __shfl_xor(v, o);
    __syncthreads();
    if ((threadIdx.x & 63) == 0) red[threadIdx.x >> 6] = v;
    __syncthreads();
    return red[0] + red[1] + red[2] + red[3];
}

__global__ void nk_norm_mod(const float* __restrict__ xa, const float* __restrict__ xb, int nlat, int rows_per_batch,
                            const float* __restrict__ w, const float* __restrict__ mod, int shift_off, int scale_off, float* __restrict__ out) {
    __shared__ float red[4];
    const int row = blockIdx.x;
    const float* src = row < nlat ? xa + (size_t)row * D : xb + (size_t)(row - nlat) * D;
    const int mr = row < nlat ? row / rows_per_batch : 4;
    float v[4]; float ss = 0;
    for (int i = 0; i < 4; ++i) { v[i] = src[threadIdx.x + 256 * i]; ss += v[i] * v[i]; }
    ss = block_sum_256(ss, red);
    const float rstd = rsqrtf(ss / D + EPS);
    for (int i = 0; i < 4; ++i) { int k = threadIdx.x + 256 * i; out[(size_t)row * D + k] = v[i] * rstd * w[k] * (1.f + mod[mr * 6144 + scale_off + k]) + mod[mr * 6144 + shift_off + k]; }
}

struct EpiStore { float* C; int ldc; int pad; __device__ void operator()(int z, int r, int c, float v) const { C[(size_t)r * ldc + c] = v; } };
template <class Epi>
__global__ void __launch_bounds__(256) nk_gemm(const float* __restrict__ A, const int* __restrict__ arow, const float* __restrict__ B, size_t a_zstride, size_t b_zstride,
                                               int lda, int arow_zstride, int ldb, int M, int N, int K, Epi epi) {
    __shared__ float As[8][128 + 4];
    __shared__ float Bs[8][128 + 4];
    const int z = blockIdx.z; const int m0 = blockIdx.y * 128, n0 = blockIdx.x * 128;
    const int tid = threadIdx.x, ty = tid >> 4, tx = tid & 15;
    const float* Bz = B + (size_t)z * b_zstride;
    const int ar = tid >> 1, ak = (tid & 1) * 4;
    const int arow_g = arow ? arow[(size_t)z * arow_zstride + m0 + ar] : (m0 + ar);
    const float* ap = A + (size_t)z * a_zstride + (size_t)arow_g * lda + ak;
    const int bk = tid >> 5, bn = (tid & 31) * 4;
    float acc[8][8];
#pragma unroll
    for (int i = 0; i < 8; ++i)
#pragma unroll
        for (int j = 0; j < 8; ++j) acc[i][j] = 0.f;
    for (int k0 = 0; k0 < K; k0 += 8) {
        const float4 av = *(const float4*)(ap + k0);
        float4 bv = make_float4(0, 0, 0, 0);
        if (n0 + bn < N) bv = *(const float4*)(Bz + (size_t)(k0 + bk) * ldb + n0 + bn);
        __syncthreads();
        As[ak + 0][ar] = av.x; As[ak + 1][ar] = av.y; As[ak + 2][ar] = av.z; As[ak + 3][ar] = av.w;
        *(float4*)&Bs[bk][bn] = bv;
        __syncthreads();
#pragma unroll
        for (int k = 0; k < 8; ++k) {
            float a[8], b[8];
            *(float4*)&a[0] = *(const float4*)&As[k][ty * 4]; *(float4*)&a[4] = *(const float4*)&As[k][64 + ty * 4];
            *(float4*)&b[0] = *(const float4*)&Bs[k][tx * 4]; *(float4*)&b[4] = *(const float4*)&Bs[k][64 + tx * 4];
#pragma unroll
            for (int i = 0; i < 8; ++i)
#pragma unroll
                for (int j = 0; j < 8; ++j) acc[i][j] += a[i] * b[j];
        }
    }
#pragma unroll
    for (int i = 0; i < 8; ++i) {
        const int r = m0 + (i < 4 ? ty * 4 + i : 64 + ty * 4 + i - 4);
#pragma unroll
        for (int j = 0; j < 8; ++j) { const int cc = n0 + (j < 4 ? tx * 4 + j : 64 + tx * 4 + j - 4); if (cc < N) epi(z, r, cc, acc[i][j]); }
    }
}

__global__ void nk_rope_scale(float* __restrict__ P) {
    const int row = blockIdx.x; float* p = P + (size_t)row * INC;
    const float s = 0.08838834764831845f;
    for (int i = threadIdx.x; i < 512; i += blockDim.x) { p[C_MK + i] *= s; p[C_RK + i] *= s; }
    __syncthreads();
    if (row < ML) {
        const int t = row % T; const float pr = (float)(t / 64), pc = (float)(t % 64);
        for (int i = threadIdx.x; i < 2 * 4 * 64; i += blockDim.x) {
            const int which = i / 256, h = (i / 64) % 4, pi = i % 64; const int half = pi / 32, f = pi % 32;
            const float invf = powf(10000.f, -(float)f / 32.f); const float ang = (half ? pc : pr) * invf; const float cs = cosf(ang), sn = sinf(ang);
            float* q = p + (which ? C_RK : C_RQ) + h * 128 + half * 64;
            const float t1 = q[f], t2 = q[f + 32]; q[f] = t1 * cs - t2 * sn; q[f + 32] = t1 * sn + t2 * cs;
        }
    }
}

__global__ void __launch_bounds__(512) nk_scan(const float* __restrict__ P, const float* __restrict__ gate_bias, const float* __restrict__ decay_logit, float* __restrict__ hout) {
    const int bid = blockIdx.x; const int dir = bid & 1, h = (bid >> 1) & 3, b = (bid >> 3) & 3, kind = bid >> 5;
    const int tid = threadIdx.x, v = tid >> 2, ks = tid & 3;
    float C[32], n[32];
#pragma unroll
    for (int j = 0; j < 32; ++j) { C[j] = 0.f; n[j] = 0.f; }
    float m = 0.f;
    const int cq = (kind ? C_RQ : C_MQ) + h * 128, ck = (kind ? C_RK : C_MK) + h * 128, cv = (kind ? C_RV : C_MV) + h * 128;
    const float bi = gate_bias[dir * 4 + h], bf = gate_bias[8 + dir * 4 + h];
    const float lg = logsigmoidf_(decay_logit[dir * 4 + h]); const float gam = expf(lg);
    float* ho = hout + (size_t)dir * ML * 1024 + kind * 512 + h * 128 + v;
    for (int i = 0; i < TC + T; ++i) {
        const bool lat = i >= TC;
        const int tt = lat ? (dir ? T - 1 - (i - TC) : i - TC) : (dir ? TC - 1 - i : i);
        const size_t row = lat ? (size_t)b * T + tt : (size_t)ML + b * TC + tt;
        const float* p = P + row * INC;
        float kk[32], qq[32];
#pragma unroll
        for (int j = 0; j < 32; ++j) { kk[j] = p[ck + 4 * j + ks]; qq[j] = lat ? p[cq + 4 * j + ks] : 0.f; }
        const float vv = p[cv + v];
        float fp, ip;
        if (kind == 0) {
            const float ig = p[C_MG + dir * 4 + h] + bi; const float lf = logsigmoidf_(p[C_MG + 8 + dir * 4 + h] + bf);
            const float mn = fmaxf(lf + m, ig); fp = expf(lf + m - mn); ip = expf(ig - mn); m = mn;
        } else { fp = gam; ip = 1.f; }
        float num = 0.f, den = 0.f; const float iv = ip * vv;
#pragma unroll
        for (int j = 0; j < 32; ++j) { C[j] = fp * C[j] + iv * kk[j]; n[j] = fp * n[j] + ip * kk[j]; num += C[j] * qq[j]; den += n[j] * qq[j]; }
        num += __shfl_xor(num, 1); num += __shfl_xor(num, 2); den += __shfl_xor(den, 1); den += __shfl_xor(den, 2);
        if (lat && ks == 0) {
            float hval = kind == 0 ? num / fmaxf(fabsf(den), expf(-m)) : num;
            ho[row * 1024] = hval;
        }
    }
}

__global__ void nk_merge(const float* __restrict__ P, const float* __restrict__ hout, const float* __restrict__ mw, const float* __restrict__ rw, float* __restrict__ y) {
    const int row = blockIdx.x; const int tid = threadIdx.x;
    const float* h0 = hout + (size_t)row * 1024; const float* h1 = hout + (size_t)ML * 1024 + (size_t)row * 1024;
    float s[4]; float ss = 0;
    for (int i = 0; i < 4; ++i) { s[i] = h0[tid * 4 + i] + h1[tid * 4 + i]; ss += s[i] * s[i]; }
    for (int o = 1; o < 32; o <<= 1) ss += __shfl_xor(ss, o);
    const float r = rsqrtf(ss / 128.f + EPS);
    const float* p = P + (size_t)row * INC;
    for (int i = 0; i < 4; ++i) {
        const int cidx = tid * 4 + i; float g, w;
        if (cidx < 512) { g = sigmoidf_(p[C_MO + cidx]); w = mw[cidx]; } else { g = siluf_(p[C_RO + cidx - 512]); w = rw[cidx - 512]; }
        y[(size_t)row * 1024 + cidx] = g * s[i] * r * w;
    }
}

struct EpiResid { const float* x; const float* mod; float* out; int goff; int pad; __device__ void operator()(int z, int r, int c, float v) const { out[(size_t)r * D + c] = x[(size_t)r * D + c] + mod[(r / T) * 6144 + goff + c] * v; } };

__global__ void nk_router(const float* __restrict__ h2, const float* __restrict__ wr, float* __restrict__ aff) {
    __shared__ float part[16][16];
    const int row = blockIdx.x, tid = threadIdx.x, e = tid & 15, g = tid >> 4;
    float a = 0.f;
    for (int k = g; k < D; k += 16) a += h2[(size_t)row * D + k] * wr[k * 16 + e];
    part[g][e] = a; __syncthreads();
    if (tid < 16) {
        float l = 0; for (int i = 0; i < 16; ++i) l += part[i][tid];
        float mx = l; for (int o = 1; o < 16; o <<= 1) mx = fmaxf(mx, __shfl_xor(mx, o));
        float ex = expf(l - mx), sm = ex; for (int o = 1; o < 16; o <<= 1) sm += __shfl_xor(sm, o);
        aff[(size_t)row * 16 + tid] = ex / sm;
    }
}

__global__ void nk_topk(const float* __restrict__ aff, int* __restrict__ idx, float* __restrict__ gate, int* __restrict__ slotmap) {
    __shared__ float sa[T];
    const int b = blockIdx.z, e = blockIdx.y, t = blockIdx.x * 256 + threadIdx.x;
    for (int i = threadIdx.x; i < T; i += 256) sa[i] = aff[((size_t)b * T + i) * 16 + e];
    __syncthreads();
    const float a = sa[t]; int rank = 0;
    for (int i = 0; i < T; ++i) { const float o = sa[i]; rank += (o > a || (o == a && i < t)) ? 1 : 0; }
    if (rank < CAP) { idx[(b * NE + e) * CAP + rank] = b * T + t; gate[(b * NE + e) * CAP + rank] = a; }
    slotmap[((size_t)b * T + t) * NE + e] = rank < CAP ? (b * NE + e) * CAP + rank : -1;
}

struct EpiGate { float* hb; __device__ void operator()(int z, int r, int c, float v) const { hb[((size_t)z * 2048 + r) * FF + c] = siluf_(v); } };
struct EpiUp { float* hb; __device__ void operator()(int z, int r, int c, float v) const { hb[((size_t)z * 2048 + r) * FF + c] *= v; } };
struct EpiDown { float* ys; const float* gate; __device__ void operator()(int z, int r, int c, float v) const {
    const int b = r >> 9, cc = r & 511; const int slot = (b * NE + z) * CAP + cc; ys[(size_t)slot * D + c] = v * gate[slot]; } };

__global__ void nk_erow(const int* __restrict__ idx, int* __restrict__ erow) {
    const int i = blockIdx.x * 256 + threadIdx.x; if (i >= NSLOT) return;
    const int e = i / 2048, r = i % 2048, b = r >> 9, c = r & 511; erow[i] = idx[(b * NE + e) * CAP + c];
}

__global__ void nk_final(const float* __restrict__ xl, const float* __restrict__ ys, const int* __restrict__ slotmap, const float* __restrict__ mod,
                         const float* __restrict__ fw, float* __restrict__ out) {
    __shared__ float red[4];
    const int row = blockIdx.x, b = row / T;
    float v[4]; float ss = 0;
    for (int i = 0; i < 4; ++i) {
        const int k = threadIdx.x + 256 * i; float acc = 0.f;
        for (int e = 0; e < NE; ++e) { const int s = slotmap[(size_t)row * NE + e]; if (s >= 0) acc += ys[(size_t)s * D + k]; }
        v[i] = xl[(size_t)row * D + k] + mod[b * 6144 + 5120 + k] * acc; ss += v[i] * v[i];
    }
    ss = block_sum_256(ss, red);
    const float rstd = rsqrtf(ss / D + EPS);
    for (int i = 0; i < 4; ++i) { const int k = threadIdx.x + 256 * i; out[(size_t)row * D + k] = v[i] * rstd * fw[k]; }
}

extern "C" void kernel_launch(void* const* d_in, const int* in_sizes, int n_in, void* d_out, int out_size, void* d_ws, size_t ws_size, hipStream_t stream) {
    const float* x = (const float*)d_in[0]; const float* c = (const float*)d_in[1]; const float* ctx = (const float*)d_in[2]; const float* c_ctx = (const float*)d_in[3];
    const float* w_ada = (const float*)d_in[4]; const float* b_ada = (const float*)d_in[5]; const float* norm1_w = (const float*)d_in[6]; const float* norm2_w = (const float*)d_in[7];
    const float* w_in = (const float*)d_in[8]; const float* gate_bias = (const float*)d_in[9]; const float* decay_logit = (const float*)d_in[10];
    const float* mnw = (const float*)d_in[11]; const float* rnw = (const float*)d_in[12]; const float* w_out = (const float*)d_in[13]; const float* w_router = (const float*)d_in[14];
    const float* w_gate = (const float*)d_in[15]; const float* w_up = (const float*)d_in[16]; const float* w_down = (const float*)d_in[17]; const float* final_w = (const float*)d_in[18];
    float* out = (float*)d_out;
    char* ws = (char*)d_ws; size_t off = 0;
    auto carve = [&](size_t bytes) { char* p = ws + off; off += (bytes + 255) & ~(size_t)255; return p; };
    float* mod = (float*)carve(5 * 6144 * 4);
    float* aff = (float*)carve((size_t)ML * 16 * 4);
    int* idx = (int*)carve(NSLOT * 4); float* gate = (float*)carve(NSLOT * 4); int* erow = (int*)carve(NSLOT * 4);
    int* slotmap = (int*)carve((size_t)ML * NE * 4);
    float* xl = (float*)carve((size_t)ML * D * 4);
    char* R1 = carve((size_t)NSLOT * FF * 4);
    float* P = (float*)R1; float* hbuf = (float*)R1;
    char* R2 = carve((size_t)3 * ML * D * 4);
    float* hn = (float*)R2; float* hout = (float*)R2;
    float* y = (float*)(R2 + (size_t)2 * ML * D * 4);
    float* h2 = (float*)R2; float* ys = (float*)(R2 + (size_t)ML * D * 4);
    if (off > ws_size) { fprintf(stderr, "ws too small: need %zu have %zu\n", off, ws_size); return; }

    nk_mod<<<24, 256, 0, stream>>>(c, c_ctx, w_ada, b_ada, mod);
    nk_norm_mod<<<MA, 256, 0, stream>>>(x, ctx, ML, T, norm1_w, mod, 0, 1024, hn);
    nk_gemm<EpiStore><<<dim3((INC + 127) / 128, MA / 128, 1), 256, 0, stream>>>(hn, nullptr, w_in, 0, 0, D, 0, INC, MA, INC, D, EpiStore{P, INC, 0});
    nk_rope_scale<<<MA, 256, 0, stream>>>(P);
    nk_scan<<<64, 512, 0, stream>>>(P, gate_bias, decay_logit, hout);
    nk_merge<<<ML, 256, 0, stream>>>(P, hout, mnw, rnw, y);
    nk_gemm<EpiResid><<<dim3(D / 128, ML / 128, 1), 256, 0, stream>>>(y, nullptr, w_out, 0, 0, D, 0, D, ML, D, D, EpiResid{x, mod, xl, 2048, 0});
    nk_norm_mod<<<ML, 256, 0, stream>>>(xl, xl, ML, T, norm2_w, mod, 3072, 4096, h2);
    nk_router<<<ML, 256, 0, stream>>>(h2, w_router, aff);
    nk_topk<<<dim3(T / 256, NE, NB), 256, 0, stream>>>(aff, idx, gate, slotmap);
    nk_erow<<<NSLOT / 256, 256, 0, stream>>>(idx, erow);
    nk_gemm<EpiGate><<<dim3(FF / 128, 2048 / 128, NE), 256, 0, stream>>>(h2, erow, w_gate, 0, (size_t)D * FF, D, 2048, FF, 2048, FF, D, EpiGate{hbuf});
    nk_gemm<EpiUp><<<dim3(FF / 128, 2048 / 128, NE), 256, 0, stream>>>(h2, erow, w_up, 0, (size_t)D * FF, D, 2048, FF, 2048, FF, D, EpiUp{hbuf});
    nk_gemm<EpiDown><<<dim3(D / 128, 2048 / 128, NE), 256, 0, stream>>>(hbuf, nullptr, w_down, (size_t)2048 * FF, (size_t)FF * D, FF, 0, D, 2048, D, FF, EpiDown{ys, gate});
    nk_final<<<ML, 256, 0, stream>>>(xl, ys, slotmap, mod, final_w, out);
}
```

```cpp
#include <hip/hip_runtime.h>
#include <cstdint>
#include <cstdio>

constexpr int D = 1024, NB = 4, T = 4096, TC = 256, NH = 4, DH = 128;
constexpr int ML = NB * T;
constexpr int MC = NB * TC;
constexpr int MA = ML + MC;
constexpr int INC = 4112;
constexpr int NE = 16, CAP = 512, FF = 2816;
constexpr int NSLOT = NB * NE * CAP;
constexpr float EPS = 1e-6f;
constexpr int C_MQ = 0, C_MK = 512, C_MV = 1024, C_MO = 1536, C_MG = 2048, C_RQ = 2064, C_RK = 2576, C_RV = 3088, C_RO = 3600;

__device__ __forceinline__ float sigmoidf_(float x) { return 1.f / (1.f + expf(-x)); }
__device__ __forceinline__ float siluf_(float x) { return x / (1.f + expf(-x)); }
__device__ __forceinline__ float logsigmoidf_(float x) { return fminf(x, 0.f) - log1pf(expf(-fabsf(x))); }

__global__ void nk_mod(const float* __restrict__ c, const float* __restrict__ c_ctx, const float* __restrict__ w_ada,
                       const float* __restrict__ b_ada, float* __restrict__ mod) {
    __shared__ float sv[5][1024];
    for (int i = threadIdx.x; i < 5 * 1024; i += blockDim.x) { int r = i >> 10, k = i & 1023; float v = r < 4 ? c[r * 1024 + k] : c_ctx[k]; sv[r][k] = siluf_(v); }
    __syncthreads();
    const int n = blockIdx.x * blockDim.x + threadIdx.x;
    float a0 = 0, a1 = 0, a2 = 0, a3 = 0, a4 = 0;
    for (int k = 0; k < 1024; ++k) { float w = w_ada[(size_t)k * 6144 + n]; a0 += sv[0][k] * w; a1 += sv[1][k] * w; a2 += sv[2][k] * w; a3 += sv[3][k] * w; a4 += sv[4][k] * w; }
    float bb = b_ada[n];
    mod[0 * 6144 + n] = a0 + bb; mod[1 * 6144 + n] = a1 + bb; mod[2 * 6144 + n] = a2 + bb; mod[3 * 6144 + n] = a3 + bb; mod[4 * 6144 + n] = a4 + bb;
}

__device__ __forceinline__ float block_sum_256(float v, float* red) {
    for (int o = 32; o > 0; o >>= 1) v += __shfl_xor(v, o);
    __syncthreads();
    if ((threadIdx.x & 63) == 0) red[threadIdx.x >> 6] = v;
    __syncthreads();
    return red[0] + red[1] + red[2] + red[3];
}

__global__ void nk_norm_mod(const float* __restrict__ xa, const float* __restrict__ xb, int nlat, int rows_per_batch,
                            const float* __restrict__ w, const float* __restrict__ mod, int shift_off, int scale_off, float* __restrict__ out) {
    __shared__ float red[4];
    const int row = blockIdx.x;
    const float* src = row < nlat ? xa + (size_t)row * D : xb + (size_t)(row - nlat) * D;
    const int mr = row < nlat ? row / rows_per_batch : 4;
    float v[4]; float ss = 0;
    for (int i = 0; i < 4; ++i) { v[i] = src[threadIdx.x + 256 * i]; ss += v[i] * v[i]; }
    ss = block_sum_256(ss, red);
    const float rstd = rsqrtf(ss / D + EPS);
    for (int i = 0; i < 4; ++i) { int k = threadIdx.x + 256 * i; out[(size_t)row * D + k] = v[i] * rstd * w[k] * (1.f + mod[mr * 6144 + scale_off + k]) + mod[mr * 6144 + shift_off + k]; }
}

struct EpiStore { float* C; int ldc; int pad; __device__ void operator()(int z, int r, int c, float v) const { C[(size_t)r * ldc + c] = v; } };
template <class Epi>
__global__ void __launch_bounds__(256) nk_gemm(const float* __restrict__ A, const int* __restrict__ arow, const float* __restrict__ B, size_t a_zstride, size_t b_zstride,
                                               int lda, int arow_zstride, int ldb, int M, int N, int K, Epi epi) {
    __shared__ float As[8][128 + 4];
    __shared__ float Bs[8][128 + 4];
    const int z = blockIdx.z; const int m0 = blockIdx.y * 128, n0 = blockIdx.x * 128;
    const int tid = threadIdx.x, ty = tid >> 4, tx = tid & 15;
    const float* Bz = B + (size_t)z * b_zstride;
    const int ar = tid >> 1, ak = (tid & 1) * 4;
    const int arow_g = arow ? arow[(size_t)z * arow_zstride + m0 + ar] : (m0 + ar);
    const float* ap = A + (size_t)z * a_zstride + (size_t)arow_g * lda + ak;
    const int bk = tid >> 5, bn = (tid & 31) * 4;
    float acc[8][8];
#pragma unroll
    for (int i = 0; i < 8; ++i)
#pragma unroll
        for (int j = 0; j < 8; ++j) acc[i][j] = 0.f;
    for (int k0 = 0; k0 < K; k0 += 8) {
        const float4 av = *(const float4*)(ap + k0);
        float4 bv = make_float4(0, 0, 0, 0);
        if (n0 + bn < N) bv = *(const float4*)(Bz + (size_t)(k0 + bk) * ldb + n0 + bn);
        __syncthreads();
        As[ak + 0][ar] = av.x; As[ak + 1][ar] = av.y; As[ak + 2][ar] = av.z; As[ak + 3][ar] = av.w;
        *(float4*)&Bs[bk][bn] = bv;
        __syncthreads();
#pragma unroll
        for (int k = 0; k < 8; ++k) {
            float a[8], b[8];
            *(float4*)&a[0] = *(const float4*)&As[k][ty * 4]; *(float4*)&a[4] = *(const float4*)&As[k][64 + ty * 4];
            *(float4*)&b[0] = *(const float4*)&Bs[k][tx * 4]; *(float4*)&b[4] = *(const float4*)&Bs[k][64 + tx * 4];
#pragma unroll
            for (int i = 0; i < 8; ++i)
#pragma unroll
                for (int j = 0; j < 8; ++j) acc[i][j] += a[i] * b[j];
        }
    }
#pragma unroll
    for (int i = 0; i < 8; ++i) {
        const int r = m0 + (i < 4 ? ty * 4 + i : 64 + ty * 4 + i - 4);
#pragma unroll
        for (int j = 0; j < 8; ++j) { const int cc = n0 + (j < 4 ? tx * 4 + j : 64 + tx * 4 + j - 4); if (cc < N) epi(z, r, cc, acc[i][j]); }
    }
}

__global__ void nk_rope_scale(float* __restrict__ P) {
    const int row = blockIdx.x; float* p = P + (size_t)row * INC;
    const float s = 0.08838834764831845f;
    for (int i = threadIdx.x; i < 512; i += blockDim.x) { p[C_MK + i] *= s; p[C_RK + i] *= s; }
    __syncthreads();
    if (row < ML) {
        const int t = row % T; const float pr = (float)(t / 64), pc = (float)(t % 64);
        for (int i = threadIdx.x; i < 2 * 4 * 64; i += blockDim.x) {
            const int which = i / 256, h = (i / 64) % 4, pi = i % 64; const int half = pi / 32, f = pi % 32;
            const float invf = powf(10000.f, -(float)f / 32.f); const float ang = (half ? pc : pr) * invf; const float cs = cosf(ang), sn = sinf(ang);
            float* q = p + (which ? C_RK : C_RQ) + h * 128 + half * 64;
            const float t1 = q[f], t2 = q[f + 32]; q[f] = t1 * cs - t2 * sn; q[f + 32] = t1 * sn + t2 * cs;
        }
    }
}

__global__ void __launch_bounds__(512) nk_scan(const float* __restrict__ P, const float* __restrict__ gate_bias, const float* __restrict__ decay_logit, float* __restrict__ hout) {
    const int bid = blockIdx.x; const int dir = bid & 1, h = (bid >> 1) & 3, b = (bid >> 3) & 3, kind = bid >> 5;
    const int tid = threadIdx.x, v = tid >> 2, ks = tid & 3;
    float C[32], n[32];
#pragma unroll
    for (int j = 0; j < 32; ++j) { C[j] = 0.f; n[j] = 0.f; }
    float m = 0.f;
    const int cq = (kind ? C_RQ : C_MQ) + h * 128, ck = (kind ? C_RK : C_MK) + h * 128, cv = (kind ? C_RV : C_MV) + h * 128;
    const float bi = gate_bias[dir * 4 + h], bf = gate_bias[8 + dir * 4 + h];
    const float lg = logsigmoidf_(decay_logit[dir * 4 + h]); const float gam = expf(lg);
    float* ho = hout + (size_t)dir * ML * 1024 + kind * 512 + h * 128 + v;
    for (int i = 0; i < TC + T; ++i) {
        const bool lat = i >= TC;
        const int tt = lat ? (dir ? T - 1 - (i - TC) : i - TC) : (dir ? TC - 1 - i : i);
        const size_t row = lat ? (size_t)b * T + tt : (size_t)ML + b * TC + tt;
        const float* p = P + row * INC;
        float kk[32], qq[32];
#pragma unroll
        for (int j = 0; j < 32; ++j) { kk[j] = p[ck + 4 * j + ks]; qq[j] = lat ? p[cq + 4 * j + ks] : 0.f; }
        const float vv = p[cv + v];
        float fp, ip;
        if (kind == 0) {
            const float ig = p[C_MG + dir * 4 + h] + bi; const float lf = logsigmoidf_(p[C_MG + 8 + dir * 4 + h] + bf);
            const float mn = fmaxf(lf + m, ig); fp = expf(lf + m - mn); ip = expf(ig - mn); m = mn;
        } else { fp = gam; ip = 1.f; }
        float num = 0.f, den = 0.f; const float iv = ip * vv;
#pragma unroll
        for (int j = 0; j < 32; ++j) { C[j] = fp * C[j] + iv * kk[j]; n[j] = fp * n[j] + ip * kk[j]; num += C[j] * qq[j]; den += n[j] * qq[j]; }
        num += __shfl_xor(num, 1); num += __shfl_xor(num, 2); den += __shfl_xor(den, 1); den += __shfl_xor(den, 2);
        if (lat && ks == 0) {
            float hval = kind == 0 ? num / fmaxf(fabsf(den), expf(-m)) : num;
            ho[row * 1024] = hval;
        }
    }
}

__global__ void nk_merge(const float* __restrict__ P, const float* __restrict__ hout, const float* __restrict__ mw, const float* __restrict__ rw, float* __restrict__ y) {
    const int row = blockIdx.x; const int tid = threadIdx.x;
    const float* h0 = hout + (size_t)row * 1024; const float* h1 = hout + (size_t)ML * 1024 + (size_t)row * 1024;
    float s[4]; float ss = 0;
    for (int i = 0; i < 4; ++i) { s[i] = h0[tid * 4 + i] + h1[tid * 4 + i]; ss += s[i] * s[i]; }
    for (int o = 1; o < 32; o <<= 1) ss += __shfl_xor(ss, o);
    const float r = rsqrtf(ss / 128.f + EPS);
    const float* p = P + (size_t)row * INC;
    for (int i = 0; i < 4; ++i) {
        const int cidx = tid * 4 + i; float g, w;
        if (cidx < 512) { g = sigmoidf_(p[C_MO + cidx]); w = mw[cidx]; } else { g = siluf_(p[C_RO + cidx - 512]); w = rw[cidx - 512]; }
        y[(size_t)row * 1024 + cidx] = g * s[i] * r * w;
    }
}

struct EpiResid { const float* x; const float* mod; float* out; int goff; int pad; __device__ void operator()(int z, int r, int c, float v) const { out[(size_t)r * D + c] = x[(size_t)r * D + c] + mod[(r / T) * 6144 + goff + c] * v; } };

__global__ void nk_router(const float* __restrict__ h2, const float* __restrict__ wr, float* __restrict__ aff) {
    __shared__ float part[16][16];
    const int row = blockIdx.x, tid = threadIdx.x, e = tid & 15, g = tid >> 4;
    float a = 0.f;
    for (int k = g; k < D; k += 16) a += h2[(size_t)row * D + k] * wr[k * 16 + e];
    part[g][e] = a; __syncthreads();
    if (tid < 16) {
        float l = 0; for (int i = 0; i < 16; ++i) l += part[i][tid];
        float mx = l; for (int o = 1; o < 16; o <<= 1) mx = fmaxf(mx, __shfl_xor(mx, o));
        float ex = expf(l - mx), sm = ex; for (int o = 1; o < 16; o <<= 1) sm += __shfl_xor(sm, o);
        aff[(size_t)row * 16 + tid] = ex / sm;
    }
}

__global__ void nk_topk(const float* __restrict__ aff, int* __restrict__ idx, float* __restrict__ gate, int* __restrict__ slotmap) {
    __shared__ float sa[T];
    const int b = blockIdx.z, e = blockIdx.y, t = blockIdx.x * 256 + threadIdx.x;
    for (int i = threadIdx.x; i < T; i += 256) sa[i] = aff[((size_t)b * T + i) * 16 + e];
    __syncthreads();
    const float a = sa[t]; int rank = 0;
    for (int i = 0; i < T; ++i) { const float o = sa[i]; rank += (o > a || (o == a && i < t)) ? 1 : 0; }
    const int R = e * 2048 + b * CAP + rank;
    if (rank < CAP) { idx[R] = b * T + t; gate[R] = a; }
    slotmap[((size_t)b * T + t) * NE + e] = rank < CAP ? R : -1;
}

struct EpiGate { float* hb; __device__ void operator()(int z, int r, int c, float v) const { hb[((size_t)z * 2048 + r) * FF + c] = siluf_(v); } };
struct EpiUp { float* hb; __device__ void operator()(int z, int r, int c, float v) const { hb[((size_t)z * 2048 + r) * FF + c] *= v; } };
struct EpiDown { float* ys; const float* gate; __device__ void operator()(int z, int r, int c, float v) const {
    const int slot = z * 2048 + r; ys[(size_t)slot * D + c] = v * gate[slot]; } };

__global__ void nk_erow(const int* __restrict__ idx, int* __restrict__ erow) {
    const int i = blockIdx.x * 256 + threadIdx.x; if (i >= NSLOT) return;
    erow[i] = idx[i];
}

__global__ void nk_final(const float* __restrict__ xl, const float* __restrict__ ys, const int* __restrict__ slotmap, const float* __restrict__ mod,
                         const float* __restrict__ fw, float* __restrict__ out) {
    __shared__ float red[4];
    const int row = blockIdx.x, b = row / T;
    float v[4]; float ss = 0;
    for (int i = 0; i < 4; ++i) {
        const int k = threadIdx.x + 256 * i; float acc = 0.f;
        for (int e = 0; e < NE; ++e) { const int s = slotmap[(size_t)row * NE + e]; if (s >= 0) acc += ys[(size_t)s * D + k]; }
        v[i] = xl[(size_t)row * D + k] + mod[b * 6144 + 5120 + k] * acc; ss += v[i] * v[i];
    }
    ss = block_sum_256(ss, red);
    const float rstd = rsqrtf(ss / D + EPS);
    for (int i = 0; i < 4; ++i) { const int k = threadIdx.x + 256 * i; out[(size_t)row * D + k] = v[i] * rstd * fw[k]; }
}


#define LAS __attribute__((address_space(3)))
typedef unsigned short bf16_t;
typedef short bf16x8 __attribute__((ext_vector_type(8)));
typedef float f32x4 __attribute__((ext_vector_type(4)));
typedef unsigned u32x4 __attribute__((ext_vector_type(4)));
typedef unsigned u32x2 __attribute__((ext_vector_type(2)));
constexpr int NTHR = 512;
constexpr int LDS_BYTES = 155648;

__device__ __forceinline__ unsigned f2bf(float f) { unsigned u = __float_as_uint(f); return (u + 0x7fffu + ((u >> 16) & 1u)) >> 16; }
__device__ __forceinline__ unsigned pk2(float lo, float hi) { return f2bf(lo) | (f2bf(hi) << 16); }
__device__ __forceinline__ float bf2f(unsigned short b) { return __uint_as_float((unsigned)b << 16); }
__device__ __forceinline__ unsigned cvt_pk_bf16(float lo, float hi) { unsigned r; asm volatile("v_cvt_pk_bf16_f32 %0, %1, %2" : "=v"(r) : "v"(lo), "v"(hi)); return r; }
__device__ __forceinline__ float fast_silu(float x) { return x * __builtin_amdgcn_rcpf(1.f + __expf(-x)); }

namespace pg8 {
constexpr int BM = 256, BK = 64, HALF = 128, HTB = HALF * BK * 2  , STAGE_BYTES = 8 * HTB;
__device__ __forceinline__ int lds_byte(int r, int c) { const int st = (r >> 4) * 2 + (c >> 5), rr = r & 15, cc = c & 31, ob = rr * 64 + cc * 2; return st * 1024 + (ob ^ (((ob >> 9) & 1) << 5)); }
__device__ __forceinline__ void stage_rc(int b, int& R, int& C) { const int st = b / 1024, sb = b % 1024, swz = sb ^ (((sb >> 9) & 1) << 5); R = (st >> 1) * 16 + swz / 64; C = (st & 1) * 32 + (swz % 64) / 2; }
__device__ __forceinline__ int perm32(int rho) { const int n = rho >> 4, i = rho & 15; return 8 * (i >> 2) + 4 * n + (i & 3); }
struct Unit { const char* a; const char* b; const int* arows; int pm, pn, aux, pad; };

template <class Epi, class Sched>
__device__ __forceinline__ void gemm_phase(LAS unsigned char* lds, const int K, const Sched& S, const Epi& E) {
    const int tid = threadIdx.x, wid = __builtin_amdgcn_readfirstlane(tid >> 6), lane = tid & 63, wr = wid >> 2, wc = wid & 3, fr = lane & 15, fq = lane >> 4;
    const int nt = K / BK;
    int RA[2], CA[2]; unsigned voffB[2];
#pragma unroll
    for (int i = 0; i < 2; ++i) { int R, C; stage_rc(tid * 16 + i * 8192, R, C); const int Rb = Epi::PERM ? ((R & ~31) + perm32(R & 31)) : R; RA[i] = R; CA[i] = C; voffB[i] = (unsigned)(Rb * K + C) * 2u; }
    const size_t kstep = (size_t)(BK * 2);
    const size_t hstep = (size_t)HALF * K * 2;
    const unsigned ldsw = (unsigned)wid * 1024u;
    const int aoff = lds_byte(wr * 64 + fr, fq * 8), boff = lds_byte(wc * 32 + fr, fq * 8);
#define PG8_SA(b, h) (((b) * 2 + (h)) * HTB)
#define PG8_SB(b, h) ((4 + (b) * 2 + (h)) * HTB)
#define PG8_STAGE(bufoff, gbase, voff) do { _Pragma("unroll") for (int _i = 0; _i < 2; ++_i) \
        __builtin_amdgcn_global_load_lds((const unsigned*)((const char*)(gbase) + (voff)[_i]), (LAS unsigned*)(lds + (bufoff) + ldsw + _i * 8192), 16, 0, 0); } while (0)
#define PG8_LDA(dst, b, h) do { _Pragma("unroll") for (int m = 0; m < 4; ++m) _Pragma("unroll") for (int k = 0; k < 2; ++k) dst[m][k] = *(const LAS bf16x8*)(lds + PG8_SA(b, h) + aoff + m * 2048 + k * 1024); } while (0)
#define PG8_LDB(dst, b, h) do { _Pragma("unroll") for (int n = 0; n < 2; ++n) _Pragma("unroll") for (int k = 0; k < 2; ++k) dst[n][k] = *(const LAS bf16x8*)(lds + PG8_SB(b, h) + boff + n * 2048 + k * 1024); } while (0)
#define PG8_MMA(ai, bj, At, Bt) do { __builtin_amdgcn_s_setprio(1); _Pragma("unroll") for (int m = 0; m < 4; ++m) _Pragma("unroll") for (int n = 0; n < 2; ++n) _Pragma("unroll") for (int k = 0; k < 2; ++k) \
        acc[ai][bj][m][n] = __builtin_amdgcn_mfma_f32_16x16x32_bf16(Bt[n][k], At[m][k], acc[ai][bj][m][n], 0, 0, 0); __builtin_amdgcn_s_setprio(0); } while (0)
#define PG8_WAIT_V(n) asm volatile("s_waitcnt vmcnt(" #n ")" ::: "memory")
#define PG8_WAIT_L(n) asm volatile("s_waitcnt lgkmcnt(" #n ")" ::: "memory")
#define PG8_BAR __builtin_amdgcn_s_barrier()
#define PG8_SCHED __builtin_amdgcn_sched_barrier(0)
#define PG8_AOFF(dst, u) do { _Pragma("unroll") for (int _h = 0; _h < 2; ++_h) _Pragma("unroll") for (int _i = 0; _i < 2; ++_i) { const int _r = _h * HALF + RA[_i]; \
        const int _ri = (u).arows ? (u).arows[_r] : _r; dst[_h][_i] = (unsigned)(_ri * K + CA[_i]) * 2u; } } while (0)
    Unit cur, nxt; int ui = 0;
    if (!S.next(0, cur)) return;
    f32x4 acc[2][2][4][2];
#pragma unroll
    for (int a = 0; a < 2; ++a)
#pragma unroll
        for (int b = 0; b < 2; ++b)
#pragma unroll
            for (int m = 0; m < 4; ++m)
#pragma unroll
                for (int n = 0; n < 2; ++n) acc[a][b][m][n] = (f32x4){0.f, 0.f, 0.f, 0.f};
    bf16x8 At[4][2], B0[2][2], B1[2][2];
    unsigned cO[2][2], nO[2][2];
    PG8_AOFF(cO, cur);
    const char* cA = cur.a; const char* cB = cur.b;
    PG8_STAGE(PG8_SB(0, 0), cB, voffB); PG8_STAGE(PG8_SB(0, 1), cB + hstep, voffB); PG8_STAGE(PG8_SA(0, 0), cA, cO[0]); PG8_STAGE(PG8_SA(0, 1), cA, cO[1]);
    if (wr == 1) PG8_BAR;
    PG8_WAIT_V(2); PG8_BAR;
    PG8_STAGE(PG8_SB(1, 0), cB + kstep, voffB); PG8_STAGE(PG8_SA(1, 0), cA + kstep, cO[0]); PG8_STAGE(PG8_SB(1, 1), cB + hstep + kstep, voffB);
    PG8_WAIT_V(6); PG8_BAR;
    for (;;) {
        const bool has_next = S.next(ui + 1, nxt);
        if (has_next) { PG8_AOFF(nO, nxt); } else {
#pragma unroll
            for (int h = 0; h < 2; ++h)
#pragma unroll
                for (int i = 0; i < 2; ++i) nO[h][i] = cO[h][i]; }
        const char* nA = has_next ? nxt.a : cA; const char* nB = has_next ? nxt.b : cB;
        for (int t = 0; t < nt; t += 2) {
            const bool last = (t == nt - 2);
            const char* a1 = cA + (size_t)(t + 1) * kstep;
            const char* a2 = last ? nA : cA + (size_t)(t + 2) * kstep; const char* b2 = last ? nB : cB + (size_t)(t + 2) * kstep;
            const char* a3 = a2 + kstep; const char* b3 = b2 + kstep;
            unsigned o2[2][2];
#pragma unroll
            for (int h = 0; h < 2; ++h)
#pragma unroll
                for (int i = 0; i < 2; ++i) o2[h][i] = last ? nO[h][i] : cO[h][i];
            PG8_LDB(B0, 0, 0); PG8_LDB(B1, 0, 1); PG8_SCHED; PG8_LDA(At, 0, 0); PG8_STAGE(PG8_SA(1, 1), a1, cO[1]);
            PG8_WAIT_V(8); PG8_WAIT_L(0); PG8_BAR; PG8_MMA(0, 0, At, B0); PG8_MMA(0, 1, At, B1); PG8_BAR; PG8_SCHED;
            PG8_LDA(At, 0, 1); PG8_STAGE(PG8_SB(0, 0), b2, voffB); PG8_STAGE(PG8_SB(0, 1), b2 + hstep, voffB); PG8_STAGE(PG8_SA(0, 0), a2, o2[0]);
            PG8_WAIT_V(8); PG8_WAIT_L(0); PG8_BAR; PG8_MMA(1, 0, At, B0); PG8_MMA(1, 1, At, B1); PG8_BAR; PG8_SCHED;
            PG8_LDB(B0, 1, 0); PG8_LDB(B1, 1, 1); PG8_SCHED; PG8_LDA(At, 1, 0); PG8_STAGE(PG8_SA(0, 1), a2, o2[1]);
            PG8_WAIT_V(8); PG8_WAIT_L(0); PG8_BAR; PG8_MMA(0, 0, At, B0); PG8_MMA(0, 1, At, B1); PG8_BAR; PG8_SCHED;
            PG8_LDA(At, 1, 1); PG8_STAGE(PG8_SB(1, 0), b3, voffB); PG8_STAGE(PG8_SB(1, 1), b3 + hstep, voffB); PG8_STAGE(PG8_SA(1, 0), a3, o2[0]);
            PG8_WAIT_V(8); PG8_WAIT_L(0); PG8_BAR; PG8_MMA(1, 0, At, B0); PG8_MMA(1, 1, At, B1); PG8_BAR; PG8_SCHED;
        }
        if (wr == 0) PG8_BAR;
        E(acc, cur, wr, wc, fr, fq);
        if (!has_next) break;
#pragma unroll
        for (int a = 0; a < 2; ++a)
#pragma unroll
            for (int b = 0; b < 2; ++b)
#pragma unroll
                for (int m = 0; m < 4; ++m)
#pragma unroll
                    for (int n = 0; n < 2; ++n) acc[a][b][m][n] = (f32x4){0.f, 0.f, 0.f, 0.f};
        cur = nxt; cA = nA; cB = nB; ++ui;
#pragma unroll
        for (int h = 0; h < 2; ++h)
#pragma unroll
            for (int i = 0; i < 2; ++i) cO[h][i] = nO[h][i];
        if (wr == 1) PG8_BAR;
    }
    PG8_WAIT_V(0);
    PG8_BAR;
#undef PG8_SA
#undef PG8_SB
#undef PG8_STAGE
#undef PG8_LDA
#undef PG8_LDB
#undef PG8_MMA
#undef PG8_WAIT_V
#undef PG8_WAIT_L
#undef PG8_BAR
#undef PG8_SCHED
#undef PG8_AOFF
}
}

struct SchedMoe1 {
    const char* X; const int* erow; const char* W; int G, c;
    __device__ __forceinline__ bool next(int i, pg8::Unit& u) const {
        const int L = i * G + c; if (L >= 2816) return false;
        const int x = L & 7, uu = L >> 3, el = uu / 176, w = uu % 176, e = 2 * x + el;
        u.pm = e * 8 + (w & 7); u.pn = w >> 3; u.aux = e; u.pad = 0;
        u.a = X; u.arows = erow + u.pm * 256; u.b = W + (size_t)(e * 22 + u.pn) * 256 * (D * 2);
        return true;
    }
};
struct EpiSwiGLU {
    static constexpr bool PERM = true;
    bf16_t* H;
    __device__ __forceinline__ void operator()(const f32x4 (&acc)[2][2][4][2], const pg8::Unit& u, int wr, int wc, int fr, int fq) const {
        const int row0 = u.pm * 256 + wr * 64 + fr, col0 = u.pn * 128 + wc * 32 + 8 * fq;
#pragma unroll
        for (int ai = 0; ai < 2; ++ai)
#pragma unroll
            for (int m = 0; m < 4; ++m) {
                const f32x4 g0 = acc[ai][0][m][0], g1 = acc[ai][0][m][1], u0 = acc[ai][1][m][0], u1 = acc[ai][1][m][1];
                u32x4 w;
                w.x = cvt_pk_bf16(fast_silu(g0[0]) * u0[0], fast_silu(g0[1]) * u0[1]); w.y = cvt_pk_bf16(fast_silu(g0[2]) * u0[2], fast_silu(g0[3]) * u0[3]);
                w.z = cvt_pk_bf16(fast_silu(g1[0]) * u1[0], fast_silu(g1[1]) * u1[1]); w.w = cvt_pk_bf16(fast_silu(g1[2]) * u1[2], fast_silu(g1[3]) * u1[3]);
                *(u32x4*)(H + (size_t)(row0 + ai * 128 + m * 16) * FF + col0) = w;
            }
    }
};
struct SchedMoe2 {
    const char* H; const char* W; int G, c;
    __device__ __forceinline__ bool next(int i, pg8::Unit& u) const {
        const int L = i * G + c; if (L >= 512) return false;
        const int x = L & 7, uu = L >> 3, el = uu >> 5, w = uu & 31, e = 2 * x + el;
        u.pm = e * 8 + (w & 7); u.pn = w >> 3; u.aux = e; u.pad = 0;
        u.a = H + (size_t)u.pm * 256 * (FF * 2); u.arows = nullptr; u.b = W + (size_t)(e * 4 + u.pn) * 256 * (FF * 2);
        return true;
    }
};
struct EpiDownBf16 {
    static constexpr bool PERM = true;
    bf16_t* Y; const float* gate;
    __device__ __forceinline__ void operator()(const f32x4 (&acc)[2][2][4][2], const pg8::Unit& u, int wr, int wc, int fr, int fq) const {
        const int row0 = u.pm * 256 + wr * 64 + fr, col0 = u.pn * 256 + wc * 32 + 8 * fq;
#pragma unroll
        for (int ai = 0; ai < 2; ++ai)
#pragma unroll
            for (int m = 0; m < 4; ++m) {
                const int r = row0 + ai * 128 + m * 16; const float g = gate[r];
#pragma unroll
                for (int bj = 0; bj < 2; ++bj) {
                    const f32x4 v0 = acc[ai][bj][m][0] * g, v1 = acc[ai][bj][m][1] * g;
                    u32x4 w; w.x = cvt_pk_bf16(v0[0], v0[1]); w.y = cvt_pk_bf16(v0[2], v0[3]); w.z = cvt_pk_bf16(v1[0], v1[1]); w.w = cvt_pk_bf16(v1[2], v1[3]);
                    *(u32x4*)(Y + (size_t)r * D + col0 + bj * 128) = w;
                }
            }
    }
};

template <class RowMap>
__device__ __forceinline__ void cvt_item(const float* W, int N, bf16_t* WT, int ldt, LAS float* scr, int kb, int nb, int lane, const RowMap& rm) {
    const int k0 = 64 * kb, n0 = 32 * nb; const int n = n0 + (lane & 31); const bool ok = n < N;
#pragma unroll 8
    for (int i = 0; i < 32; ++i) { const int kk = 2 * i + (lane >> 5); scr[kk * 33 + (lane & 31)] = ok ? W[(size_t)(k0 + kk) * N + n] : 0.f; }
    asm volatile("s_waitcnt lgkmcnt(0)" ::: "memory");
    const int c = lane & 7;
#pragma unroll
    for (int j = 0; j < 4; ++j) { const int nl = (lane >> 3) + 8 * j; const LAS float* s = scr + (8 * c) * 33 + nl; const int dr = rm(n0 + nl);
        u32x4 o; o.x = pk2(s[0 * 33], s[1 * 33]); o.y = pk2(s[2 * 33], s[3 * 33]); o.z = pk2(s[4 * 33], s[5 * 33]); o.w = pk2(s[6 * 33], s[7 * 33]);
        if (dr >= 0) *(u32x4*)(WT + (size_t)dr * ldt + k0 + 8 * c) = o; }
    asm volatile("s_waitcnt lgkmcnt(0)" ::: "memory");
}
struct RmGateUp { int base; __device__ __forceinline__ int operator()(int n) const { return base + (n >> 7) * 256 + (n & 127); } };
struct RmLin { int base; __device__ __forceinline__ int operator()(int n) const { return base + n; } };

struct FastP {
    const float *w_gate, *w_up, *w_down; const float* gate; const int* erow;
    bf16_t *WguT, *WdT, *H2, *Hb, *Ys;
};

__device__ __forceinline__ void phase_convert_moe(const FastP& p, LAS unsigned char* lds, int bid, int nb) {
    const int wave = __builtin_amdgcn_readfirstlane(threadIdx.x >> 6), lane = threadIdx.x & 63;
    LAS float* scr = (LAS float*)(lds + wave * 8448);
    const int gw = bid * 8 + wave, NGW = nb * 8;
    constexpr int IGU = 16 * 88, ID = 44 * 32;
    constexpr int NIT = NE * (2 * IGU + ID);
    for (int it = gw; it < NIT; it += NGW) {
        const int e = it / (2 * IGU + ID); int r = it % (2 * IGU + ID);
        if (r < IGU) { cvt_item(p.w_gate + (size_t)e * D * FF, FF, p.WguT, D, scr, r / 88, r % 88, lane, RmGateUp{e * 5632}); continue; } r -= IGU;
        if (r < IGU) { cvt_item(p.w_up + (size_t)e * D * FF, FF, p.WguT, D, scr, r / 88, r % 88, lane, RmGateUp{e * 5632 + 128}); continue; } r -= IGU;
        cvt_item(p.w_down + (size_t)e * FF * D, D, p.WdT, FF, scr, r / 32, r % 32, lane, RmLin{e * D});
    }
}
__global__ void __launch_bounds__(NTHR, 2) fk_convert_moe(FastP p) { extern __shared__ __attribute__((aligned(16))) unsigned char lds[]; phase_convert_moe(p, (LAS unsigned char*)lds, blockIdx.x, gridDim.x); }
__global__ void __launch_bounds__(NTHR, 2) fk_moe1(FastP p) {
    extern __shared__ __attribute__((aligned(16))) unsigned char lds[];
    SchedMoe1 S{(const char*)p.H2, p.erow, (const char*)p.WguT, (int)gridDim.x, (int)blockIdx.x}; EpiSwiGLU E{p.Hb};
    pg8::gemm_phase(((LAS unsigned char*)lds), D, S, E);
}
__global__ void __launch_bounds__(NTHR, 2) fk_moe2(FastP p) {
    extern __shared__ __attribute__((aligned(16))) unsigned char lds[];
    SchedMoe2 S{(const char*)p.Hb, (const char*)p.WdT, (int)gridDim.x, (int)blockIdx.x}; EpiDownBf16 E{p.Ys, p.gate};
    pg8::gemm_phase(((LAS unsigned char*)lds), FF, S, E);
}
__global__ void ak_f32_to_bf16(const float* __restrict__ in, bf16_t* __restrict__ out, size_t n4) {
    for (size_t i = (size_t)blockIdx.x * blockDim.x + threadIdx.x; i < n4; i += (size_t)gridDim.x * blockDim.x) { const float4 v = ((const float4*)in)[i]; u32x2 o; o.x = pk2(v.x, v.y); o.y = pk2(v.z, v.w); ((u32x2*)out)[i] = o; }
}
__global__ void nk_final_bf16(const float* __restrict__ xl, const bf16_t* __restrict__ ys, const int* __restrict__ slotmap, const float* __restrict__ mod,
                              const float* __restrict__ fw, float* __restrict__ out) {
    __shared__ float red[4];
    const int row = blockIdx.x, b = row / T;
    float v[4]; float ss = 0;
    for (int i = 0; i < 4; ++i) {
        const int k = threadIdx.x + 256 * i; float acc = 0.f;
        for (int e = 0; e < NE; ++e) { const int s = slotmap[(size_t)row * NE + e]; if (s >= 0) acc += bf2f(ys[(size_t)s * D + k]); }
        v[i] = xl[(size_t)row * D + k] + mod[b * 6144 + 5120 + k] * acc; ss += v[i] * v[i];
    }
    ss = block_sum_256(ss, red);
    const float rstd = rsqrtf(ss / D + EPS);
    for (int i = 0; i < 4; ++i) { const int k = threadIdx.x + 256 * i; out[(size_t)row * D + k] = v[i] * rstd * fw[k]; }
}

extern "C" void kernel_launch(void* const* d_in, const int* in_sizes, int n_in, void* d_out, int out_size, void* d_ws, size_t ws_size, hipStream_t stream) {
    const float* x = (const float*)d_in[0]; const float* c = (const float*)d_in[1]; const float* ctx = (const float*)d_in[2]; const float* c_ctx = (const float*)d_in[3];
    const float* w_ada = (const float*)d_in[4]; const float* b_ada = (const float*)d_in[5]; const float* norm1_w = (const float*)d_in[6]; const float* norm2_w = (const float*)d_in[7];
    const float* w_in = (const float*)d_in[8]; const float* gate_bias = (const float*)d_in[9]; const float* decay_logit = (const float*)d_in[10];
    const float* mnw = (const float*)d_in[11]; const float* rnw = (const float*)d_in[12]; const float* w_out = (const float*)d_in[13]; const float* w_router = (const float*)d_in[14];
    const float* w_gate = (const float*)d_in[15]; const float* w_up = (const float*)d_in[16]; const float* w_down = (const float*)d_in[17]; const float* final_w = (const float*)d_in[18];
    float* out = (float*)d_out;
    char* ws = (char*)d_ws; size_t off = 0;
    auto carve = [&](size_t bytes) { char* p = ws + off; off += (bytes + 255) & ~(size_t)255; return p; };
    float* mod = (float*)carve(5 * 6144 * 4);
    float* aff = (float*)carve((size_t)ML * 16 * 4);
    int* idx = (int*)carve(NSLOT * 4); float* gate = (float*)carve(NSLOT * 4); int* erow = (int*)carve(NSLOT * 4);
    int* slotmap = (int*)carve((size_t)ML * NE * 4);
    float* xl = (float*)carve((size_t)ML * D * 4);
    const size_t x0 = off;
    float* P = (float*)carve((size_t)MA * INC * 4);
    char* R2 = carve((size_t)3 * ML * D * 4);
    float* hn = (float*)R2; float* hout = (float*)R2; float* y = (float*)(R2 + (size_t)2 * ML * D * 4);
    const size_t early_end = off;
    off = x0;
    bf16_t* WguT = (bf16_t*)carve((size_t)NE * 5632 * D * 2);
    bf16_t* WdT = (bf16_t*)carve((size_t)NE * D * FF * 2);
    bf16_t* Hb = (bf16_t*)carve((size_t)NSLOT * FF * 2);
    float* h2 = (float*)carve((size_t)ML * D * 4);
    bf16_t* H2 = (bf16_t*)carve((size_t)ML * D * 2);
    bf16_t* Ys = (bf16_t*)carve((size_t)NSLOT * D * 2);
    if (off < early_end) off = early_end;
    if (off > ws_size) { fprintf(stderr, "ws too small: need %zu have %zu\n", off, ws_size); return; }
    static bool attr_done = false;
    if (!attr_done) {
        hipFuncSetAttribute((const void*)fk_convert_moe, hipFuncAttributeMaxDynamicSharedMemorySize, LDS_BYTES);
        hipFuncSetAttribute((const void*)fk_moe1, hipFuncAttributeMaxDynamicSharedMemorySize, LDS_BYTES);
        hipFuncSetAttribute((const void*)fk_moe2, hipFuncAttributeMaxDynamicSharedMemorySize, LDS_BYTES);
        attr_done = true;
    }
    FastP fp{}; fp.w_gate = w_gate; fp.w_up = w_up; fp.w_down = w_down; fp.gate = gate; fp.erow = erow; fp.WguT = WguT; fp.WdT = WdT; fp.H2 = H2; fp.Hb = Hb; fp.Ys = Ys;

    nk_mod<<<24, 256, 0, stream>>>(c, c_ctx, w_ada, b_ada, mod);
    nk_norm_mod<<<MA, 256, 0, stream>>>(x, ctx, ML, T, norm1_w, mod, 0, 1024, hn);
    nk_gemm<EpiStore><<<dim3((INC + 127) / 128, MA / 128, 1), 256, 0, stream>>>(hn, nullptr, w_in, 0, 0, D, 0, INC, MA, INC, D, EpiStore{P, INC, 0});
    nk_rope_scale<<<MA, 256, 0, stream>>>(P);
    nk_scan<<<64, 512, 0, stream>>>(P, gate_bias, decay_logit, hout);
    nk_merge<<<ML, 256, 0, stream>>>(P, hout, mnw, rnw, y);
    nk_gemm<EpiResid><<<dim3(D / 128, ML / 128, 1), 256, 0, stream>>>(y, nullptr, w_out, 0, 0, D, 0, D, ML, D, D, EpiResid{x, mod, xl, 2048, 0});
    fk_convert_moe<<<256, NTHR, LDS_BYTES, stream>>>(fp);
    nk_norm_mod<<<ML, 256, 0, stream>>>(xl, xl, ML, T, norm2_w, mod, 3072, 4096, h2);
    nk_router<<<ML, 256, 0, stream>>>(h2, w_router, aff);
    nk_topk<<<dim3(T / 256, NE, NB), 256, 0, stream>>>(aff, idx, gate, slotmap);
    nk_erow<<<NSLOT / 256, 256, 0, stream>>>(idx, erow);
    ak_f32_to_bf16<<<2048, 256, 0, stream>>>(h2, H2, (size_t)ML * D / 4);
    fk_moe1<<<256, NTHR, LDS_BYTES, stream>>>(fp);
    fk_moe2<<<256, NTHR, LDS_BYTES, stream>>>(fp);
    nk_final_bf16<<<ML, 256, 0, stream>>>(xl, Ys, slotmap, mod, final_w, out);
}
```

```cpp
#include <hip/hip_runtime.h>
#include <cstdint>
#include <cstdio>

constexpr int D = 1024, NB = 4, T = 4096, TC = 256, NH = 4, DH = 128;
constexpr int ML = NB * T;
constexpr int MC = NB * TC;
constexpr int MA = ML + MC;
constexpr int INC = 4112;
constexpr int NE = 16, CAP = 512, FF = 2816;
constexpr int NSLOT = NB * NE * CAP;
constexpr float EPS = 1e-6f;
constexpr int C_MQ = 0, C_MK = 512, C_MV = 1024, C_MO = 1536, C_MG = 2048, C_RQ = 2064, C_RK = 2576, C_RV = 3088, C_RO = 3600;

__device__ __forceinline__ float sigmoidf_(float x) { return 1.f / (1.f + expf(-x)); }
__device__ __forceinline__ float siluf_(float x) { return x / (1.f + expf(-x)); }
__device__ __forceinline__ float logsigmoidf_(float x) { return fminf(x, 0.f) - log1pf(expf(-fabsf(x))); }

__global__ void nk_mod(const float* __restrict__ c, const float* __restrict__ c_ctx, const float* __restrict__ w_ada,
                       const float* __restrict__ b_ada, float* __restrict__ mod) {
    __shared__ float sv[5][1024];
    for (int i = threadIdx.x; i < 5 * 1024; i += blockDim.x) { int r = i >> 10, k = i & 1023; float v = r < 4 ? c[r * 1024 + k] : c_ctx[k]; sv[r][k] = siluf_(v); }
    __syncthreads();
    const int n = blockIdx.x * blockDim.x + threadIdx.x;
    float a0 = 0, a1 = 0, a2 = 0, a3 = 0, a4 = 0;
    for (int k = 0; k < 1024; ++k) { float w = w_ada[(size_t)k * 6144 + n]; a0 += sv[0][k] * w; a1 += sv[1][k] * w; a2 += sv[2][k] * w; a3 += sv[3][k] * w; a4 += sv[4][k] * w; }
    float bb = b_ada[n];
    mod[0 * 6144 + n] = a0 + bb; mod[1 * 6144 + n] = a1 + bb; mod[2 * 6144 + n] = a2 + bb; mod[3 * 6144 + n] = a3 + bb; mod[4 * 6144 + n] = a4 + bb;
}

__device__ __forceinline__ float block_sum_256(float v, float* red) {
    for (int o = 32; o > 0; o >>= 1) v += __shfl_xor(v, o);
    __syncthreads();
    if ((threadIdx.x & 63) == 0) red[threadIdx.x >> 6] = v;
    __syncthreads();
    return red[0] + red[1] + red[2] + red[3];
}

__global__ void nk_norm_mod(const float* __restrict__ xa, const float* __restrict__ xb, int nlat, int rows_per_batch,
                            const float* __restrict__ w, const float* __restrict__ mod, int shift_off, int scale_off, float* __restrict__ out) {
    __shared__ float red[4];
    const int row = blockIdx.x;
    const float* src = row < nlat ? xa + (size_t)row * D : xb + (size_t)(row - nlat) * D;
    const int mr = row < nlat ? row / rows_per_batch : 4;
    float v[4]; float ss = 0;
    for (int i = 0; i < 4; ++i) { v[i] = src[threadIdx.x + 256 * i]; ss += v[i] * v[i]; }
    ss = block_sum_256(ss, red);
    const float rstd = rsqrtf(ss / D + EPS);
    for (int i = 0; i < 4; ++i) { int k = threadIdx.x + 256 * i; out[(size_t)row * D + k] = v[i] * rstd * w[k] * (1.f + mod[mr * 6144 + scale_off + k]) + mod[mr * 6144 + shift_off + k]; }
}

struct EpiStore { float* C; int ldc; int pad; __device__ void operator()(int z, int r, int c, float v) const { C[(size_t)r * ldc + c] = v; } };
template <class Epi>
__global__ void __launch_bounds__(256) nk_gemm(const float* __restrict__ A, const int* __restrict__ arow, const float* __restrict__ B, size_t a_zstride, size_t b_zstride,
                                               int lda, int arow_zstride, int ldb, int M, int N, int K, Epi epi) {
    __shared__ float As[8][128 + 4];
    __shared__ float Bs[8][128 + 4];
    const int z = blockIdx.z; const int m0 = blockIdx.y * 128, n0 = blockIdx.x * 128;
    const int tid = threadIdx.x, ty = tid >> 4, tx = tid & 15;
    const float* Bz = B + (size_t)z * b_zstride;
    const int ar = tid >> 1, ak = (tid & 1) * 4;
    const int arow_g = arow ? arow[(size_t)z * arow_zstride + m0 + ar] : (m0 + ar);
    const float* ap = A + (size_t)z * a_zstride + (size_t)arow_g * lda + ak;
    const int bk = tid >> 5, bn = (tid & 31) * 4;
    float acc[8][8];
#pragma unroll
    for (int i = 0; i < 8; ++i)
#pragma unroll
        for (int j = 0; j < 8; ++j) acc[i][j] = 0.f;
    for (int k0 = 0; k0 < K; k0 += 8) {
        const float4 av = *(const float4*)(ap + k0);
        float4 bv = make_float4(0, 0, 0, 0);
        if (n0 + bn < N) bv = *(const float4*)(Bz + (size_t)(k0 + bk) * ldb + n0 + bn);
        __syncthreads();
        As[ak + 0][ar] = av.x; As[ak + 1][ar] = av.y; As[ak + 2][ar] = av.z; As[ak + 3][ar] = av.w;
        *(float4*)&Bs[bk][bn] = bv;
        __syncthreads();
#pragma unroll
        for (int k = 0; k < 8; ++k) {
            float a[8], b[8];
            *(float4*)&a[0] = *(const float4*)&As[k][ty * 4]; *(float4*)&a[4] = *(const float4*)&As[k][64 + ty * 4];
            *(float4*)&b[0] = *(const float4*)&Bs[k][tx * 4]; *(float4*)&b[4] = *(const float4*)&Bs[k][64 + tx * 4];
#pragma unroll
            for (int i = 0; i < 8; ++i)
#pragma unroll
                for (int j = 0; j < 8; ++j) acc[i][j] += a[i] * b[j];
        }
    }
#pragma unroll
    for (int i = 0; i < 8; ++i) {
        const int r = m0 + (i < 4 ? ty * 4 + i : 64 + ty * 4 + i - 4);
#pragma unroll
        for (int j = 0; j < 8; ++j) { const int cc = n0 + (j < 4 ? tx * 4 + j : 64 + tx * 4 + j - 4); if (cc < N) epi(z, r, cc, acc[i][j]); }
    }
}

__global__ void nk_rope_scale(float* __restrict__ P) {
    const int row = blockIdx.x; float* p = P + (size_t)row * INC;
    const float s = 0.08838834764831845f;
    for (int i = threadIdx.x; i < 512; i += blockDim.x) { p[C_MK + i] *= s; p[C_RK + i] *= s; }
    __syncthreads();
    if (row < ML) {
        const int t = row % T; const float pr = (float)(t / 64), pc = (float)(t % 64);
        for (int i = threadIdx.x; i < 2 * 4 * 64; i += blockDim.x) {
            const int which = i / 256, h = (i / 64) % 4, pi = i % 64; const int half = pi / 32, f = pi % 32;
            const float invf = powf(10000.f, -(float)f / 32.f); const float ang = (half ? pc : pr) * invf; const float cs = cosf(ang), sn = sinf(ang);
            float* q = p + (which ? C_RK : C_RQ) + h * 128 + half * 64;
            const float t1 = q[f], t2 = q[f + 32]; q[f] = t1 * cs - t2 * sn; q[f + 32] = t1 * sn + t2 * cs;
        }
    }
}

constexpr int PB_MQ = 0, PB_MK = 512, PB_MV = 1024, PB_MO = 1536, PB_RQ = 2048, PB_RK = 2560, PB_RV = 3072, PB_RO = 3584, PBC = 4096;
__device__ __forceinline__ float ldbf(const unsigned short* p) { return __uint_as_float((unsigned)(*p) << 16); }
__global__ void __launch_bounds__(512) nk_scan(const unsigned short* __restrict__ P, const float* __restrict__ G, const float* __restrict__ gate_bias, const float* __restrict__ decay_logit, float* __restrict__ hout) {
    const int bid = blockIdx.x; const int dir = bid & 1, h = (bid >> 1) & 3, b = (bid >> 3) & 3, kind = bid >> 5;
    const int tid = threadIdx.x, v = tid >> 2, ks = tid & 3;
    float C[32], n[32];
#pragma unroll
    for (int j = 0; j < 32; ++j) { C[j] = 0.f; n[j] = 0.f; }
    float m = 0.f;
    const int cq = (kind ? PB_RQ : PB_MQ) + h * 128, ck = (kind ? PB_RK : PB_MK) + h * 128, cv = (kind ? PB_RV : PB_MV) + h * 128;
    const float bi = gate_bias[dir * 4 + h], bf = gate_bias[8 + dir * 4 + h];
    const float lg = logsigmoidf_(decay_logit[dir * 4 + h]); const float gam = expf(lg);
    float* ho = hout + (size_t)dir * ML * 1024 + kind * 512 + h * 128 + v;
    for (int i = 0; i < TC + T; ++i) {
        const bool lat = i >= TC;
        const int tt = lat ? (dir ? T - 1 - (i - TC) : i - TC) : (dir ? TC - 1 - i : i);
        const size_t row = lat ? (size_t)b * T + tt : (size_t)ML + b * TC + tt;
        const unsigned short* p = P + row * PBC;
        float kk[32], qq[32];
#pragma unroll
        for (int j = 0; j < 32; ++j) { kk[j] = ldbf(p + ck + 4 * j + ks); qq[j] = lat ? ldbf(p + cq + 4 * j + ks) : 0.f; }
        const float vv = ldbf(p + cv + v);
        float fp, ip;
        if (kind == 0) {
            const float ig = G[row * 16 + dir * 4 + h] + bi; const float lf = logsigmoidf_(G[row * 16 + 8 + dir * 4 + h] + bf);
            const float mn = fmaxf(lf + m, ig); fp = expf(lf + m - mn); ip = expf(ig - mn); m = mn;
        } else { fp = gam; ip = 1.f; }
        float num = 0.f, den = 0.f; const float iv = ip * vv;
#pragma unroll
        for (int j = 0; j < 32; ++j) { C[j] = fp * C[j] + iv * kk[j]; n[j] = fp * n[j] + ip * kk[j]; num += C[j] * qq[j]; den += n[j] * qq[j]; }
        num += __shfl_xor(num, 1); num += __shfl_xor(num, 2); den += __shfl_xor(den, 1); den += __shfl_xor(den, 2);
        if (lat && ks == 0) {
            float hval = kind == 0 ? num / fmaxf(fabsf(den), expf(-m)) : num;
            ho[row * 1024] = hval;
        }
    }
}

__global__ void nk_merge(const unsigned short* __restrict__ P, const float* __restrict__ hout, const float* __restrict__ mw, const float* __restrict__ rw, float* __restrict__ y) {
    const int row = blockIdx.x; const int tid = threadIdx.x;
    const float* h0 = hout + (size_t)row * 1024; const float* h1 = hout + (size_t)ML * 1024 + (size_t)row * 1024;
    float s[4]; float ss = 0;
    for (int i = 0; i < 4; ++i) { s[i] = h0[tid * 4 + i] + h1[tid * 4 + i]; ss += s[i] * s[i]; }
    for (int o = 1; o < 32; o <<= 1) ss += __shfl_xor(ss, o);
    const float r = rsqrtf(ss / 128.f + EPS);
    const unsigned short* p = P + (size_t)row * PBC;
    for (int i = 0; i < 4; ++i) {
        const int cidx = tid * 4 + i; float g, w;
        if (cidx < 512) { g = sigmoidf_(ldbf(p + PB_MO + cidx)); w = mw[cidx]; } else { g = siluf_(ldbf(p + PB_RO + cidx - 512)); w = rw[cidx - 512]; }
        y[(size_t)row * 1024 + cidx] = g * s[i] * r * w;
    }
}

struct EpiResid { const float* x; const float* mod; float* out; int goff; int pad; __device__ void operator()(int z, int r, int c, float v) const { out[(size_t)r * D + c] = x[(size_t)r * D + c] + mod[(r / T) * 6144 + goff + c] * v; } };

__global__ void nk_router(const float* __restrict__ h2, const float* __restrict__ wr, float* __restrict__ aff) {
    __shared__ float part[16][16];
    const int row = blockIdx.x, tid = threadIdx.x, e = tid & 15, g = tid >> 4;
    float a = 0.f;
    for (int k = g; k < D; k += 16) a += h2[(size_t)row * D + k] * wr[k * 16 + e];
    part[g][e] = a; __syncthreads();
    if (tid < 16) {
        float l = 0; for (int i = 0; i < 16; ++i) l += part[i][tid];
        float mx = l; for (int o = 1; o < 16; o <<= 1) mx = fmaxf(mx, __shfl_xor(mx, o));
        float ex = expf(l - mx), sm = ex; for (int o = 1; o < 16; o <<= 1) sm += __shfl_xor(sm, o);
        aff[(size_t)row * 16 + tid] = ex / sm;
    }
}

__global__ void nk_topk(const float* __restrict__ aff, int* __restrict__ idx, float* __restrict__ gate, int* __restrict__ slotmap) {
    __shared__ float sa[T];
    const int b = blockIdx.z, e = blockIdx.y, t = blockIdx.x * 256 + threadIdx.x;
    for (int i = threadIdx.x; i < T; i += 256) sa[i] = aff[((size_t)b * T + i) * 16 + e];
    __syncthreads();
    const float a = sa[t]; int rank = 0;
    for (int i = 0; i < T; ++i) { const float o = sa[i]; rank += (o > a || (o == a && i < t)) ? 1 : 0; }
    const int R = e * 2048 + b * CAP + rank;
    if (rank < CAP) { idx[R] = b * T + t; gate[R] = a; }
    slotmap[((size_t)b * T + t) * NE + e] = rank < CAP ? R : -1;
}

struct EpiGate { float* hb; __device__ void operator()(int z, int r, int c, float v) const { hb[((size_t)z * 2048 + r) * FF + c] = siluf_(v); } };
struct EpiUp { float* hb; __device__ void operator()(int z, int r, int c, float v) const { hb[((size_t)z * 2048 + r) * FF + c] *= v; } };
struct EpiDown { float* ys; const float* gate; __device__ void operator()(int z, int r, int c, float v) const {
    const int slot = z * 2048 + r; ys[(size_t)slot * D + c] = v * gate[slot]; } };

__global__ void nk_erow(const int* __restrict__ idx, int* __restrict__ erow) {
    const int i = blockIdx.x * 256 + threadIdx.x; if (i >= NSLOT) return;
    erow[i] = idx[i];
}

__global__ void nk_final(const float* __restrict__ xl, const float* __restrict__ ys, const int* __restrict__ slotmap, const float* __restrict__ mod,
                         const float* __restrict__ fw, float* __restrict__ out) {
    __shared__ float red[4];
    const int row = blockIdx.x, b = row / T;
    float v[4]; float ss = 0;
    for (int i = 0; i < 4; ++i) {
        const int k = threadIdx.x + 256 * i; float acc = 0.f;
        for (int e = 0; e < NE; ++e) { const int s = slotmap[(size_t)row * NE + e]; if (s >= 0) acc += ys[(size_t)s * D + k]; }
        v[i] = xl[(size_t)row * D + k] + mod[b * 6144 + 5120 + k] * acc; ss += v[i] * v[i];
    }
    ss = block_sum_256(ss, red);
    const float rstd = rsqrtf(ss / D + EPS);
    for (int i = 0; i < 4; ++i) { const int k = threadIdx.x + 256 * i; out[(size_t)row * D + k] = v[i] * rstd * fw[k]; }
}


#define LAS __attribute__((address_space(3)))
typedef unsigned short bf16_t;
typedef short bf16x8 __attribute__((ext_vector_type(8)));
typedef float f32x4 __attribute__((ext_vector_type(4)));
typedef unsigned u32x4 __attribute__((ext_vector_type(4)));
typedef unsigned u32x2 __attribute__((ext_vector_type(2)));
constexpr int NTHR = 512;
constexpr int LDS_BYTES = 155648;

__device__ __forceinline__ unsigned f2bf(float f) { unsigned u = __float_as_uint(f); return (u + 0x7fffu + ((u >> 16) & 1u)) >> 16; }
__device__ __forceinline__ unsigned pk2(float lo, float hi) { return f2bf(lo) | (f2bf(hi) << 16); }
__device__ __forceinline__ float bf2f(unsigned short b) { return __uint_as_float((unsigned)b << 16); }
__device__ __forceinline__ unsigned cvt_pk_bf16(float lo, float hi) { unsigned r; asm volatile("v_cvt_pk_bf16_f32 %0, %1, %2" : "=v"(r) : "v"(lo), "v"(hi)); return r; }
__device__ __forceinline__ float fast_silu(float x) { return x * __builtin_amdgcn_rcpf(1.f + __expf(-x)); }

namespace pg8 {
constexpr int BM = 256, BK = 64, HALF = 128, HTB = HALF * BK * 2  , STAGE_BYTES = 8 * HTB;
__device__ __forceinline__ int lds_byte(int r, int c) { const int st = (r >> 4) * 2 + (c >> 5), rr = r & 15, cc = c & 31, ob = rr * 64 + cc * 2; return st * 1024 + (ob ^ (((ob >> 9) & 1) << 5)); }
__device__ __forceinline__ void stage_rc(int b, int& R, int& C) { const int st = b / 1024, sb = b % 1024, swz = sb ^ (((sb >> 9) & 1) << 5); R = (st >> 1) * 16 + swz / 64; C = (st & 1) * 32 + (swz % 64) / 2; }
__device__ __forceinline__ int perm32(int rho) { const int n = rho >> 4, i = rho & 15; return 8 * (i >> 2) + 4 * n + (i & 3); }
struct Unit { const char* a; const char* b; const int* arows; int pm, pn, aux, pad; };

template <class Epi, class Sched>
__device__ __forceinline__ void gemm_phase(LAS unsigned char* lds, const int K, const Sched& S, const Epi& E) {
    const int tid = threadIdx.x, wid = __builtin_amdgcn_readfirstlane(tid >> 6), lane = tid & 63, wr = wid >> 2, wc = wid & 3, fr = lane & 15, fq = lane >> 4;
    const int nt = K / BK;
    int RA[2], CA[2]; unsigned voffB[2];
#pragma unroll
    for (int i = 0; i < 2; ++i) { int R, C; stage_rc(tid * 16 + i * 8192, R, C); const int Rb = Epi::PERM ? ((R & ~31) + perm32(R & 31)) : R; RA[i] = R; CA[i] = C; voffB[i] = (unsigned)(Rb * K + C) * 2u; }
    const size_t kstep = (size_t)(BK * 2);
    const size_t hstep = (size_t)HALF * K * 2;
    const unsigned ldsw = (unsigned)wid * 1024u;
    const int aoff = lds_byte(wr * 64 + fr, fq * 8), boff = lds_byte(wc * 32 + fr, fq * 8);
#define PG8_SA(b, h) (((b) * 2 + (h)) * HTB)
#define PG8_SB(b, h) ((4 + (b) * 2 + (h)) * HTB)
#define PG8_STAGE(bufoff, gbase, voff) do { _Pragma("unroll") for (int _i = 0; _i < 2; ++_i) \
        __builtin_amdgcn_global_load_lds((const unsigned*)((const char*)(gbase) + (voff)[_i]), (LAS unsigned*)(lds + (bufoff) + ldsw + _i * 8192), 16, 0, 0); } while (0)
#define PG8_LDA(dst, b, h) do { _Pragma("unroll") for (int m = 0; m < 4; ++m) _Pragma("unroll") for (int k = 0; k < 2; ++k) dst[m][k] = *(const LAS bf16x8*)(lds + PG8_SA(b, h) + aoff + m * 2048 + k * 1024); } while (0)
#define PG8_LDB(dst, b, h) do { _Pragma("unroll") for (int n = 0; n < 2; ++n) _Pragma("unroll") for (int k = 0; k < 2; ++k) dst[n][k] = *(const LAS bf16x8*)(lds + PG8_SB(b, h) + boff + n * 2048 + k * 1024); } while (0)
#define PG8_MMA(ai, bj, At, Bt) do { __builtin_amdgcn_s_setprio(1); _Pragma("unroll") for (int m = 0; m < 4; ++m) _Pragma("unroll") for (int n = 0; n < 2; ++n) _Pragma("unroll") for (int k = 0; k < 2; ++k) \
        acc[ai][bj][m][n] = __builtin_amdgcn_mfma_f32_16x16x32_bf16(Bt[n][k], At[m][k], acc[ai][bj][m][n], 0, 0, 0); __builtin_amdgcn_s_setprio(0); } while (0)
#define PG8_WAIT_V(n) asm volatile("s_waitcnt vmcnt(" #n ")" ::: "memory")
#define PG8_WAIT_L(n) asm volatile("s_waitcnt lgkmcnt(" #n ")" ::: "memory")
#define PG8_BAR __builtin_amdgcn_s_barrier()
#define PG8_SCHED __builtin_amdgcn_sched_barrier(0)
#define PG8_AOFF(dst, u) do { _Pragma("unroll") for (int _h = 0; _h < 2; ++_h) _Pragma("unroll") for (int _i = 0; _i < 2; ++_i) { const int _r = _h * HALF + RA[_i]; \
        const int _ri = (u).arows ? (u).arows[_r] : _r; dst[_h][_i] = (unsigned)(_ri * K + CA[_i]) * 2u; } } while (0)
    Unit cur, nxt; int ui = 0;
    if (!S.next(0, cur)) return;
    f32x4 acc[2][2][4][2];
#pragma unroll
    for (int a = 0; a < 2; ++a)
#pragma unroll
        for (int b = 0; b < 2; ++b)
#pragma unroll
            for (int m = 0; m < 4; ++m)
#pragma unroll
                for (int n = 0; n < 2; ++n) acc[a][b][m][n] = (f32x4){0.f, 0.f, 0.f, 0.f};
    bf16x8 At[4][2], B0[2][2], B1[2][2];
    unsigned cO[2][2], nO[2][2];
    PG8_AOFF(cO, cur);
    const char* cA = cur.a; const char* cB = cur.b;
    PG8_STAGE(PG8_SB(0, 0), cB, voffB); PG8_STAGE(PG8_SB(0, 1), cB + hstep, voffB); PG8_STAGE(PG8_SA(0, 0), cA, cO[0]); PG8_STAGE(PG8_SA(0, 1), cA, cO[1]);
    if (wr == 1) PG8_BAR;
    PG8_WAIT_V(2); PG8_BAR;
    PG8_STAGE(PG8_SB(1, 0), cB + kstep, voffB); PG8_STAGE(PG8_SA(1, 0), cA + kstep, cO[0]); PG8_STAGE(PG8_SB(1, 1), cB + hstep + kstep, voffB);
    PG8_WAIT_V(6); PG8_BAR;
    for (;;) {
        const bool has_next = S.next(ui + 1, nxt);
        if (has_next) { PG8_AOFF(nO, nxt); } else {
#pragma unroll
            for (int h = 0; h < 2; ++h)
#pragma unroll
                for (int i = 0; i < 2; ++i) nO[h][i] = cO[h][i]; }
        const char* nA = has_next ? nxt.a : cA; const char* nB = has_next ? nxt.b : cB;
        for (int t = 0; t < nt; t += 2) {
            const bool last = (t == nt - 2);
            const char* a1 = cA + (size_t)(t + 1) * kstep;
            const char* a2 = last ? nA : cA + (size_t)(t + 2) * kstep; const char* b2 = last ? nB : cB + (size_t)(t + 2) * kstep;
            const char* a3 = a2 + kstep; const char* b3 = b2 + kstep;
            unsigned o2[2][2];
#pragma unroll
            for (int h = 0; h < 2; ++h)
#pragma unroll
                for (int i = 0; i < 2; ++i) o2[h][i] = last ? nO[h][i] : cO[h][i];
            PG8_LDB(B0, 0, 0); PG8_LDB(B1, 0, 1); PG8_SCHED; PG8_LDA(At, 0, 0); PG8_STAGE(PG8_SA(1, 1), a1, cO[1]);
            PG8_WAIT_V(8); PG8_WAIT_L(0); PG8_BAR; PG8_MMA(0, 0, At, B0); PG8_MMA(0, 1, At, B1); PG8_BAR; PG8_SCHED;
            PG8_LDA(At, 0, 1); PG8_STAGE(PG8_SB(0, 0), b2, voffB); PG8_STAGE(PG8_SB(0, 1), b2 + hstep, voffB); PG8_STAGE(PG8_SA(0, 0), a2, o2[0]);
            PG8_WAIT_V(8); PG8_WAIT_L(0); PG8_BAR; PG8_MMA(1, 0, At, B0); PG8_MMA(1, 1, At, B1); PG8_BAR; PG8_SCHED;
            PG8_LDB(B0, 1, 0); PG8_LDB(B1, 1, 1); PG8_SCHED; PG8_LDA(At, 1, 0); PG8_STAGE(PG8_SA(0, 1), a2, o2[1]);
            PG8_WAIT_V(8); PG8_WAIT_L(0); PG8_BAR; PG8_MMA(0, 0, At, B0); PG8_MMA(0, 1, At, B1); PG8_BAR; PG8_SCHED;
            PG8_LDA(At, 1, 1); PG8_STAGE(PG8_SB(1, 0), b3, voffB); PG8_STAGE(PG8_SB(1, 1), b3 + hstep, voffB); PG8_STAGE(PG8_SA(1, 0), a3, o2[0]);
            PG8_WAIT_V(8); PG8_WAIT_L(0); PG8_BAR; PG8_MMA(1, 0, At, B0); PG8_MMA(1, 1, At, B1); PG8_BAR; PG8_SCHED;
        }
        if (wr == 0) PG8_BAR;
        E(acc, cur, wr, wc, fr, fq);
        if (!has_next) break;
#pragma unroll
        for (int a = 0; a < 2; ++a)
#pragma unroll
            for (int b = 0; b < 2; ++b)
#pragma unroll
                for (int m = 0; m < 4; ++m)
#pragma unroll
                    for (int n = 0; n < 2; ++n) acc[a][b][m][n] = (f32x4){0.f, 0.f, 0.f, 0.f};
        cur = nxt; cA = nA; cB = nB; ++ui;
#pragma unroll
        for (int h = 0; h < 2; ++h)
#pragma unroll
            for (int i = 0; i < 2; ++i) cO[h][i] = nO[h][i];
        if (wr == 1) PG8_BAR;
    }
    PG8_WAIT_V(0);
    PG8_BAR;
#undef PG8_SA
#undef PG8_SB
#undef PG8_STAGE
#undef PG8_LDA
#undef PG8_LDB
#undef PG8_MMA
#undef PG8_WAIT_V
#undef PG8_WAIT_L
#undef PG8_BAR
#undef PG8_SCHED
#undef PG8_AOFF
}
}

struct SchedMoe1 {
    const char* X; const int* erow; const char* W; int G, c;
    __device__ __forceinline__ bool next(int i, pg8::Unit& u) const {
        const int L = i * G + c; if (L >= 2816) return false;
        const int x = L & 7, uu = L >> 3, el = uu / 176, w = uu % 176, e = 2 * x + el;
        u.pm = e * 8 + (w & 7); u.pn = w >> 3; u.aux = e; u.pad = 0;
        u.a = X; u.arows = erow + u.pm * 256; u.b = W + (size_t)(e * 22 + u.pn) * 256 * (D * 2);
        return true;
    }
};
struct EpiSwiGLU {
    static constexpr bool PERM = true;
    bf16_t* H;
    __device__ __forceinline__ void operator()(const f32x4 (&acc)[2][2][4][2], const pg8::Unit& u, int wr, int wc, int fr, int fq) const {
        const int row0 = u.pm * 256 + wr * 64 + fr, col0 = u.pn * 128 + wc * 32 + 8 * fq;
#pragma unroll
        for (int ai = 0; ai < 2; ++ai)
#pragma unroll
            for (int m = 0; m < 4; ++m) {
                const f32x4 g0 = acc[ai][0][m][0], g1 = acc[ai][0][m][1], u0 = acc[ai][1][m][0], u1 = acc[ai][1][m][1];
                u32x4 w;
                w.x = cvt_pk_bf16(fast_silu(g0[0]) * u0[0], fast_silu(g0[1]) * u0[1]); w.y = cvt_pk_bf16(fast_silu(g0[2]) * u0[2], fast_silu(g0[3]) * u0[3]);
                w.z = cvt_pk_bf16(fast_silu(g1[0]) * u1[0], fast_silu(g1[1]) * u1[1]); w.w = cvt_pk_bf16(fast_silu(g1[2]) * u1[2], fast_silu(g1[3]) * u1[3]);
                *(u32x4*)(H + (size_t)(row0 + ai * 128 + m * 16) * FF + col0) = w;
            }
    }
};
struct SchedMoe2 {
    const char* H; const char* W; int G, c;
    __device__ __forceinline__ bool next(int i, pg8::Unit& u) const {
        const int L = i * G + c; if (L >= 512) return false;
        const int x = L & 7, uu = L >> 3, el = uu >> 5, w = uu & 31, e = 2 * x + el;
        u.pm = e * 8 + (w & 7); u.pn = w >> 3; u.aux = e; u.pad = 0;
        u.a = H + (size_t)u.pm * 256 * (FF * 2); u.arows = nullptr; u.b = W + (size_t)(e * 4 + u.pn) * 256 * (FF * 2);
        return true;
    }
};
struct EpiDownBf16 {
    static constexpr bool PERM = true;
    bf16_t* Y; const float* gate;
    __device__ __forceinline__ void operator()(const f32x4 (&acc)[2][2][4][2], const pg8::Unit& u, int wr, int wc, int fr, int fq) const {
        const int row0 = u.pm * 256 + wr * 64 + fr, col0 = u.pn * 256 + wc * 32 + 8 * fq;
#pragma unroll
        for (int ai = 0; ai < 2; ++ai)
#pragma unroll
            for (int m = 0; m < 4; ++m) {
                const int r = row0 + ai * 128 + m * 16; const float g = gate[r];
#pragma unroll
                for (int bj = 0; bj < 2; ++bj) {
                    const f32x4 v0 = acc[ai][bj][m][0] * g, v1 = acc[ai][bj][m][1] * g;
                    u32x4 w; w.x = cvt_pk_bf16(v0[0], v0[1]); w.y = cvt_pk_bf16(v0[2], v0[3]); w.z = cvt_pk_bf16(v1[0], v1[1]); w.w = cvt_pk_bf16(v1[2], v1[3]);
                    *(u32x4*)(Y + (size_t)r * D + col0 + bj * 128) = w;
                }
            }
    }
};

template <class RowMap>
__device__ __forceinline__ void cvt_item(const float* W, int N, bf16_t* WT, int ldt, LAS float* scr, int kb, int nb, int lane, const RowMap& rm) {
    const int k0 = 64 * kb, n0 = 32 * nb; const int n = n0 + (lane & 31); const bool ok = n < N;
#pragma unroll 8
    for (int i = 0; i < 32; ++i) { const int kk = 2 * i + (lane >> 5); scr[kk * 33 + (lane & 31)] = ok ? W[(size_t)(k0 + kk) * N + n] : 0.f; }
    asm volatile("s_waitcnt lgkmcnt(0)" ::: "memory");
    const int c = lane & 7;
#pragma unroll
    for (int j = 0; j < 4; ++j) { const int nl = (lane >> 3) + 8 * j; const LAS float* s = scr + (8 * c) * 33 + nl; const int dr = rm(n0 + nl);
        u32x4 o; o.x = pk2(s[0 * 33], s[1 * 33]); o.y = pk2(s[2 * 33], s[3 * 33]); o.z = pk2(s[4 * 33], s[5 * 33]); o.w = pk2(s[6 * 33], s[7 * 33]);
        if (dr >= 0) *(u32x4*)(WT + (size_t)dr * ldt + k0 + 8 * c) = o; }
    asm volatile("s_waitcnt lgkmcnt(0)" ::: "memory");
}
struct RmGateUp { int base; __device__ __forceinline__ int operator()(int n) const { return base + (n >> 7) * 256 + (n & 127); } };
struct RmLin { int base; __device__ __forceinline__ int operator()(int n) const { return base + n; } };

struct FastP {
    const float *w_gate, *w_up, *w_down; const float* gate; const int* erow;
    bf16_t *WguT, *WdT, *H2, *Hb, *Ys;
};

__device__ __forceinline__ void phase_convert_moe(const FastP& p, LAS unsigned char* lds, int bid, int nb) {
    const int wave = __builtin_amdgcn_readfirstlane(threadIdx.x >> 6), lane = threadIdx.x & 63;
    LAS float* scr = (LAS float*)(lds + wave * 8448);
    const int gw = bid * 8 + wave, NGW = nb * 8;
    constexpr int IGU = 16 * 88, ID = 44 * 32;
    constexpr int NIT = NE * (2 * IGU + ID);
    for (int it = gw; it < NIT; it += NGW) {
        const int e = it / (2 * IGU + ID); int r = it % (2 * IGU + ID);
        if (r < IGU) { cvt_item(p.w_gate + (size_t)e * D * FF, FF, p.WguT, D, scr, r / 88, r % 88, lane, RmGateUp{e * 5632}); continue; } r -= IGU;
        if (r < IGU) { cvt_item(p.w_up + (size_t)e * D * FF, FF, p.WguT, D, scr, r / 88, r % 88, lane, RmGateUp{e * 5632 + 128}); continue; } r -= IGU;
        cvt_item(p.w_down + (size_t)e * FF * D, D, p.WdT, FF, scr, r / 32, r % 32, lane, RmLin{e * D});
    }
}
__global__ void __launch_bounds__(NTHR, 2) fk_convert_moe(FastP p) { extern __shared__ __attribute__((aligned(16))) unsigned char lds[]; phase_convert_moe(p, (LAS unsigned char*)lds, blockIdx.x, gridDim.x); }
__global__ void __launch_bounds__(NTHR, 2) fk_moe1(FastP p) {
    extern __shared__ __attribute__((aligned(16))) unsigned char lds[];
    SchedMoe1 S{(const char*)p.H2, p.erow, (const char*)p.WguT, (int)gridDim.x, (int)blockIdx.x}; EpiSwiGLU E{p.Hb};
    pg8::gemm_phase(((LAS unsigned char*)lds), D, S, E);
}
__global__ void __launch_bounds__(NTHR, 2) fk_moe2(FastP p) {
    extern __shared__ __attribute__((aligned(16))) unsigned char lds[];
    SchedMoe2 S{(const char*)p.Hb, (const char*)p.WdT, (int)gridDim.x, (int)blockIdx.x}; EpiDownBf16 E{p.Ys, p.gate};
    pg8::gemm_phase(((LAS unsigned char*)lds), FF, S, E);
}

struct RmWin { __device__ __forceinline__ int operator()(int n) const {
    if (n >= INC || (n >= 2048 && n < 2064)) return -1;
    const int f = n < 2048 ? n : n - 16; const int region = f >> 9, h = (f >> 7) & 3; int o = f & 127;
    if (region == 4 || region == 5) { const int half = o >> 6, oo = o & 63; o = half * 64 + ((oo & 31) << 1) + (oo >> 5); }
    return region * 512 + h * 128 + o; } };
struct FastQ {
    const float *x, *ctx, *c, *c_ctx, *w_ada, *b_ada, *norm1_w, *w_in, *w_out, *mnw, *rnw;
    float *mod, *ropetab, *G, *normw; bf16_t *WinT, *WoutT, *XN, *Pb;
};
__device__ __forceinline__ void phase_mod(const FastQ& p, LAS unsigned char* lds, int bid, int nb) {
    LAS float* sv = (LAS float*)lds; LAS float* red = sv + 5 * 1024;
    const int tid = threadIdx.x;
    for (int i = tid; i < 5 * 1024; i += NTHR) { const int r = i >> 10, k = i & 1023; const float v = r < 4 ? p.c[r * 1024 + k] : p.c_ctx[k]; sv[i] = v / (1.f + expf(-v)); }
    __syncthreads();
    for (int cb = bid; cb < 192; cb += nb) {
        const int cl = tid & 31, kg = tid >> 5, col = cb * 32 + cl;
        float a0 = 0, a1 = 0, a2 = 0, a3 = 0, a4 = 0;
#pragma unroll 8
        for (int kk = 0; kk < 64; ++kk) { const int k = kg * 64 + kk; const float w = p.w_ada[(size_t)k * 6144 + col]; a0 += sv[k] * w; a1 += sv[1024 + k] * w; a2 += sv[2048 + k] * w; a3 += sv[3072 + k] * w; a4 += sv[4096 + k] * w; }
        red[(kg * 5 + 0) * 32 + cl] = a0; red[(kg * 5 + 1) * 32 + cl] = a1; red[(kg * 5 + 2) * 32 + cl] = a2; red[(kg * 5 + 3) * 32 + cl] = a3; red[(kg * 5 + 4) * 32 + cl] = a4;
        __syncthreads();
        if (tid < 160) { const int r = tid >> 5, c2 = tid & 31; float sum = 0.f; for (int g = 0; g < 16; ++g) sum += red[(g * 5 + r) * 32 + c2]; p.mod[r * 6144 + cb * 32 + c2] = sum + p.b_ada[cb * 32 + c2]; }
        __syncthreads();
    }
    for (int i = bid * NTHR + tid; i < 1024; i += nb * NTHR) p.normw[i] = i < 512 ? p.mnw[i] : p.rnw[i - 512];
    for (int i = bid * NTHR + tid; i < 2048; i += nb * NTHR) { const int pos = i >> 5, f = i & 31; const float ang = (float)pos * powf(10000.f, -(float)f / 32.f); p.ropetab[2 * i] = cosf(ang); p.ropetab[2 * i + 1] = sinf(ang); }
}
__device__ __forceinline__ void phase_convert_small(const FastQ& p, LAS unsigned char* lds, int bid, int nb) {
    const int wave = __builtin_amdgcn_readfirstlane(threadIdx.x >> 6), lane = threadIdx.x & 63;
    LAS float* scr = (LAS float*)(lds + wave * 8448);
    const int gw = bid * 8 + wave, NGW = nb * 8;
    constexpr int IIN = 16 * 129, IOUT = 16 * 32;
    for (int it = gw; it < IIN + IOUT; it += NGW) {
        if (it < IIN) cvt_item(p.w_in, INC, p.WinT, D, scr, it / 129, it % 129, lane, RmWin{});
        else { const int r = it - IIN; cvt_item(p.w_out, D, p.WoutT, D, scr, r / 32, r % 32, lane, RmLin{0}); }
    }
}
__device__ __forceinline__ void phase_norm1(const FastQ& p, LAS unsigned char* lds, int bid, int nb) {
    LAS float* wg = (LAS float*)lds;
    const int tid = threadIdx.x, wave = __builtin_amdgcn_readfirstlane(tid >> 6), lane = tid & 63;
    for (int i = tid; i < 1024 * 16; i += NTHR) { const int k = i >> 4, j = i & 15; wg[k * 20 + j] = p.w_in[(size_t)k * INC + 2048 + j]; }
    __syncthreads();
    const int gw = bid * 8 + wave, NGW = nb * 8;
    for (int row = gw; row < MA; row += NGW) {
        const float* src = row < ML ? p.x + (size_t)row * D : p.ctx + (size_t)(row - ML) * D;
        const float* md = p.mod + (row < ML ? (row >> 12) : 4) * 6144;
        float v[16]; float ss = 0.f;
#pragma unroll
        for (int i = 0; i < 16; ++i) { v[i] = src[lane + 64 * i]; ss += v[i] * v[i]; }
#pragma unroll
        for (int o = 1; o < 64; o <<= 1) ss += __shfl_xor(ss, o);
        const float rstd = rsqrtf(ss * (1.f / D) + EPS);
        float g[16];
#pragma unroll
        for (int j = 0; j < 16; ++j) g[j] = 0.f;
#pragma unroll
        for (int i = 0; i < 16; ++i) {
            const int k = lane + 64 * i;
            const float hh = v[i] * rstd * p.norm1_w[k] * (1.f + md[1024 + k]) + md[k];
            p.XN[(size_t)row * D + k] = (bf16_t)f2bf(hh);
            const LAS f32x4* wr = (const LAS f32x4*)(wg + k * 20);
            const f32x4 w0 = wr[0], w1 = wr[1], w2 = wr[2], w3 = wr[3];
            g[0] += hh * w0[0]; g[1] += hh * w0[1]; g[2] += hh * w0[2]; g[3] += hh * w0[3]; g[4] += hh * w1[0]; g[5] += hh * w1[1]; g[6] += hh * w1[2]; g[7] += hh * w1[3];
            g[8] += hh * w2[0]; g[9] += hh * w2[1]; g[10] += hh * w2[2]; g[11] += hh * w2[3]; g[12] += hh * w3[0]; g[13] += hh * w3[1]; g[14] += hh * w3[2]; g[15] += hh * w3[3];
            if (i & 1) asm volatile("" ::: "memory");
        }
#pragma unroll
        for (int j = 0; j < 16; ++j) g[j] += __shfl_xor(g[j], 32);
        float g1[8], g2[4], g3[2];
        { const bool hi = lane & 16;
#pragma unroll
          for (int j = 0; j < 8; ++j) { const float mine = hi ? g[j + 8] : g[j], theirs = hi ? g[j] : g[j + 8]; g1[j] = mine + __shfl_xor(theirs, 16); } }
        { const bool hi = lane & 8;
#pragma unroll
          for (int j = 0; j < 4; ++j) { const float mine = hi ? g1[j + 4] : g1[j], theirs = hi ? g1[j] : g1[j + 4]; g2[j] = mine + __shfl_xor(theirs, 8); } }
        { const bool hi = lane & 4;
#pragma unroll
          for (int j = 0; j < 2; ++j) { const float mine = hi ? g2[j + 2] : g2[j], theirs = hi ? g2[j] : g2[j + 2]; g3[j] = mine + __shfl_xor(theirs, 4); } }
        float g4; { const bool hi = lane & 2; const float mine = hi ? g3[1] : g3[0], theirs = hi ? g3[0] : g3[1]; g4 = mine + __shfl_xor(theirs, 2); }
        g4 += __shfl_xor(g4, 1);
        if ((lane & 33) == 0) p.G[(size_t)row * 16 + (lane >> 1)] = g4;
    }
}
struct SchedInProj {
    const char* XN; const char* W; int G, c;
    __device__ __forceinline__ bool next(int i, pg8::Unit& u) const {
        const int L = i * G + c; if (L >= 1056) return false;
        if (L < 1024) { const int x = L & 7, uu = L >> 3; u.pm = 8 * x + (uu & 7); u.pn = uu >> 3; }
        else { const int r = L - 1024; u.pm = 64 + (r & 3); const int q = r >> 2; u.pn = (q < 4 ? 2 : 6) + q; }
        u.aux = 0; u.pad = 0; u.arows = nullptr;
        u.a = XN + (size_t)u.pm * 256 * (D * 2); u.b = W + (size_t)u.pn * 256 * (D * 2);
        return true;
    }
};
struct EpiInProj {
    static constexpr bool PERM = true;
    bf16_t* P; const float* tab;
    __device__ __forceinline__ void operator()(const f32x4 (&acc)[2][2][4][2], const pg8::Unit& u, int wr, int wc, int fr, int fq) const {
        const int row0 = u.pm * 256 + wr * 64 + fr, col0 = u.pn * 256 + wc * 32 + 8 * fq;
        const bool kcol = (u.pn == 2 || u.pn == 3 || u.pn == 10 || u.pn == 11);
        const float sc = kcol ? 0.08838834764831845f : 1.f;
        const bool rope = (u.pn >= 8 && u.pn < 12 && u.pm < 64);
        const int fbase = (wc & 1) * 16 + 4 * fq;
#pragma unroll
        for (int ai = 0; ai < 2; ++ai)
#pragma unroll
            for (int m = 0; m < 4; ++m) {
                const int r = row0 + ai * 128 + m * 16;
                f32x4 cs0 = (f32x4){1.f, 0.f, 1.f, 0.f}, cs1 = cs0;
                if (rope) { const int t = r & 4095; const int pos = (wc >> 1) ? (t & 63) : (t >> 6); const f32x4* tp = (const f32x4*)(tab + 2 * (pos * 32 + fbase)); cs0 = tp[0]; cs1 = tp[1]; }
#pragma unroll
                for (int bj = 0; bj < 2; ++bj) {
                    f32x4 v0 = acc[ai][bj][m][0] * sc, v1 = acc[ai][bj][m][1] * sc;
                    if (rope) {
                        const f32x4 a = v0, b = v1;
                        v0[0] = a[0] * cs0[0] - a[1] * cs0[1]; v0[1] = a[0] * cs0[1] + a[1] * cs0[0]; v0[2] = a[2] * cs0[2] - a[3] * cs0[3]; v0[3] = a[2] * cs0[3] + a[3] * cs0[2];
                        v1[0] = b[0] * cs1[0] - b[1] * cs1[1]; v1[1] = b[0] * cs1[1] + b[1] * cs1[0]; v1[2] = b[2] * cs1[2] - b[3] * cs1[3]; v1[3] = b[2] * cs1[3] + b[3] * cs1[2];
                    }
                    u32x4 w; w.x = cvt_pk_bf16(v0[0], v0[1]); w.y = cvt_pk_bf16(v0[2], v0[3]); w.z = cvt_pk_bf16(v1[0], v1[1]); w.w = cvt_pk_bf16(v1[2], v1[3]);
                    *(u32x4*)(P + (size_t)r * PBC + col0 + bj * 128) = w;
                }
            }
    }
};
__global__ void __launch_bounds__(NTHR, 2) fk_p0(FastQ p) { extern __shared__ __attribute__((aligned(16))) unsigned char lds[]; phase_mod(p, (LAS unsigned char*)lds, blockIdx.x, gridDim.x); __syncthreads(); phase_convert_small(p, (LAS unsigned char*)lds, blockIdx.x, gridDim.x); }
__global__ void __launch_bounds__(NTHR, 2) fk_p1(FastQ p) { extern __shared__ __attribute__((aligned(16))) unsigned char lds[]; phase_norm1(p, (LAS unsigned char*)lds, blockIdx.x, gridDim.x); }
__global__ void __launch_bounds__(NTHR, 2) fk_p2(FastQ p) {
    extern __shared__ __attribute__((aligned(16))) unsigned char lds[];
    SchedInProj S{(const char*)p.XN, (const char*)p.WinT, (int)gridDim.x, (int)blockIdx.x}; EpiInProj E{p.Pb, p.ropetab};
    pg8::gemm_phase(((LAS unsigned char*)lds), D, S, E);
}

typedef short s16x4 __attribute__((ext_vector_type(4)));
constexpr int NCH = 34;
constexpr int RS_QK = 272, RS_V = 304;
struct MixP {
    const bf16_t* Pb; const float* G; const float* gate_bias; const float* decay_logit; const float* normw;
    bf16_t* ST; float* NV; float* SC; bf16_t* YM;
};
__device__ __forceinline__ size_t mix_row(int b, int ch, int p) { return ch < 32 ? (size_t)b * T + ch * 128 + p : (size_t)ML + b * TC + (ch - 32) * 128 + p; }
__device__ __forceinline__ bf16x8 tr_frag(const LAS unsigned char* pl, int rs) {
    const s16x4 lo = __builtin_amdgcn_ds_read_tr16_b64_v4i16((LAS s16x4*)(pl));
    const s16x4 hi = __builtin_amdgcn_ds_read_tr16_b64_v4i16((LAS s16x4*)(pl + 4 * rs));
    return __builtin_shufflevector(lo, hi, 0, 1, 2, 3, 4, 5, 6, 7);
}
__device__ __forceinline__ void stage128(LAS unsigned char* dst, int rs, const bf16_t* src, size_t gstride) {
    const int t = threadIdx.x, r = t >> 2;
#pragma unroll
    for (int j = 0; j < 4; ++j) { const int c = (j * 4 + (t & 3)) * 8; const u32x4 v = *(const u32x4*)(src + (size_t)r * gstride + c); *(LAS u32x4*)(dst + r * rs + c * 2) = v; }
}
__device__ __forceinline__ void gate_prep(const MixP& p, int kind, int b, int h, int ch, LAS float* aF, LAS float* aB, LAS float* bF, LAS float* bB, LAS float* lfF, LAS float* lfB, LAS float* igF, LAS float* igB) {
    const int tid = threadIdx.x;
    if (tid < 128) {
        if (kind == 0) {
            const float* g = p.G + mix_row(b, ch, tid) * 16;
            igF[tid] = g[h] + p.gate_bias[h]; igB[tid] = g[4 + h] + p.gate_bias[4 + h];
            lfF[tid] = logsigmoidf_(g[8 + h] + p.gate_bias[8 + h]); lfB[tid] = logsigmoidf_(g[12 + h] + p.gate_bias[12 + h]);
        } else { igF[tid] = 0.f; igB[tid] = 0.f; lfF[tid] = logsigmoidf_(p.decay_logit[h]); lfB[tid] = logsigmoidf_(p.decay_logit[4 + h]); }
    }
    __syncthreads();
    if (tid < 128) { float sum = 0.f; for (int j = 0; j <= tid; ++j) sum += lfF[j]; bF[tid] = sum; aF[tid] = igF[tid] - sum; }
    else if (tid < 256) { const int q = tid - 128; float sum = 0.f; for (int j = 127; j >= q; --j) sum += lfB[j]; bB[q] = sum; aB[q] = igB[q] - sum; }
    __syncthreads();
}

__device__ __forceinline__ void phase_mixA(const MixP& p, LAS unsigned char* lds, int bid, int nb) {
    LAS unsigned char* Kimg = lds; LAS unsigned char* VF = lds + 34816; LAS unsigned char* VB = VF + 38912;
    LAS float* arr = (LAS float*)(VB + 38912);
    LAS float *aF = arr, *aB = arr + 128, *bF = arr + 256, *bB = arr + 384, *lfF = arr + 512, *lfB = arr + 640, *igF = arr + 768, *igB = arr + 896, *wF = arr + 1024, *wB = arr + 1152;
    const int tid = threadIdx.x, wave = __builtin_amdgcn_readfirstlane(tid >> 6), lane = tid & 63, g = lane >> 4, i16 = lane & 15, q = i16 >> 2, pp = i16 & 3;
    for (int tile = bid; tile < 2 * 16 * NCH; tile += nb) {
        const int ch = tile % NCH, h = (tile / NCH) & 3, b = (tile / (NCH * 4)) & 3, kind = tile / (NCH * 16);
        const size_t row0 = mix_row(b, ch, 0);
        stage128(Kimg, RS_QK, p.Pb + row0 * PBC + (kind ? PB_RK : PB_MK) + h * 128, PBC);
        gate_prep(p, kind, b, h, ch, aF, aB, bF, bB, lfF, lfB, igF, igB);
        if (tid < 256) {
            LAS float* a = tid < 128 ? aF : aB; float mx = a[0]; for (int j = 1; j < 128; ++j) mx = fmaxf(mx, a[j]);
            const int pq = tid & 127; (tid < 128 ? wF : wB)[pq] = expf(a[pq] - mx);
            if (pq == 0) { const int dir = tid >> 7; float* sc = p.SC + ((size_t)tile * 2 + dir) * 4; sc[0] = dir ? bB[0] : bF[127]; sc[1] = mx; }
        }
        __syncthreads();
        {
            const bf16_t* src = p.Pb + row0 * PBC + (kind ? PB_RV : PB_MV) + h * 128; const int r = tid >> 2; const float wf = wF[r], wb = wB[r];
#pragma unroll
            for (int j = 0; j < 4; ++j) { const int c = (j * 4 + (tid & 3)) * 8; const u32x4 v = *(const u32x4*)(src + (size_t)r * PBC + c); u32x4 of, ob;
#pragma unroll
                for (int e = 0; e < 4; ++e) { const float lo = __uint_as_float(v[e] << 16), hi = __uint_as_float(v[e] & 0xffff0000u); of[e] = pk2(lo * wf, hi * wf); ob[e] = pk2(lo * wb, hi * wb); }
                *(LAS u32x4*)(VF + r * RS_V + c * 2) = of; *(LAS u32x4*)(VB + r * RS_V + c * 2) = ob; }
            if (tid < 256) { const int rr = tid & 127; LAS unsigned char* V = tid < 128 ? VF : VB; const float w = (tid < 128 ? wF : wB)[rr];
                *(LAS u32x4*)(V + rr * RS_V + 256) = (u32x4){f2bf(w), 0u, 0u, 0u}; *(LAS u32x4*)(V + rr * RS_V + 272) = (u32x4){0u, 0u, 0u, 0u}; }
        }
        __syncthreads();
        const int dir = wave >> 2, kb = wave & 3; const LAS unsigned char* V = dir ? VB : VF;
        f32x4 acc[2][9];
#pragma unroll
        for (int mi = 0; mi < 2; ++mi)
#pragma unroll
            for (int ni = 0; ni < 9; ++ni) acc[mi][ni] = (f32x4){0.f, 0.f, 0.f, 0.f};
#pragma unroll
        for (int ks = 0; ks < 4; ++ks) {
            const int srow = 32 * ks + 8 * g + q;
            bf16x8 a[2];
#pragma unroll
            for (int mi = 0; mi < 2; ++mi) a[mi] = tr_frag(Kimg + srow * RS_QK + (32 * kb + 16 * mi + 4 * pp) * 2, RS_QK);
#pragma unroll
            for (int ni = 0; ni < 9; ++ni) { const bf16x8 bv = tr_frag(V + srow * RS_V + (16 * ni + 4 * pp) * 2, RS_V);
#pragma unroll
                for (int mi = 0; mi < 2; ++mi) acc[mi][ni] = __builtin_amdgcn_mfma_f32_16x16x32_bf16(a[mi], bv, acc[mi][ni], 0, 0, 0); }
        }
        bf16_t* st = p.ST + ((size_t)tile * 2 + dir) * 16384;
#pragma unroll
        for (int mi = 0; mi < 2; ++mi) { const int k0 = 32 * kb + 16 * mi + 4 * g;
#pragma unroll
            for (int ni = 0; ni < 8; ++ni) { const f32x4 v = acc[mi][ni]; u32x2 o; o.x = pk2(v[0], v[1]); o.y = pk2(v[2], v[3]); *(u32x2*)(st + (size_t)(16 * ni + i16) * 128 + k0) = o; }
            if (i16 == 0) *(f32x4*)(p.NV + ((size_t)tile * 2 + dir) * 128 + k0) = acc[mi][8]; }
        __syncthreads();
    }
}

__device__ __forceinline__ void phase_mixB(const MixP& p, int bid, int nb) {
    for (int w = bid * NTHR + threadIdx.x; w < 64 * 2048; w += nb * NTHR) {
        const int combo = w >> 11, e = w & 2047, v = e >> 4, k0 = (e & 15) * 8;
        const int dir = combo & 1, h = (combo >> 1) & 3, b = (combo >> 3) & 3, kind = combo >> 5;
        const int tb = ((kind * 4 + b) * 4 + h) * NCH;
        float C[8], n[8];
#pragma unroll
        for (int j = 0; j < 8; ++j) { C[j] = 0.f; n[j] = 0.f; }
        float m = 0.f;
#pragma unroll 1
        for (int jb = 0; jb < NCH; jb += 17) {
            u32x4 U[17];
#pragma unroll
            for (int jj = 0; jj < 17; ++jj) { const int j = jb + jj; const int ch = dir ? 33 - j : (j < 2 ? 32 + j : j - 2); U[jj] = *(const u32x4*)(p.ST + ((size_t)(tb + ch) * 2 + dir) * 16384 + v * 128 + k0); }
#pragma unroll
            for (int jj = 0; jj < 17; ++jj) {
                const int j = jb + jj; const int ch = dir ? 33 - j : (j < 2 ? 32 + j : j - 2);
                const size_t td = (size_t)(tb + ch) * 2 + dir;
                float* sc = p.SC + td * 4; const float bL = sc[0], amax = sc[1];
                float mn, alpha, beta;
                if (kind == 0) { mn = fmaxf(bL + m, bL + amax); alpha = expf(bL + m - mn); beta = expf(bL + amax - mn); } else { mn = 0.f; alpha = expf(bL); beta = expf(bL + amax); }
                u32x4 o; o.x = pk2(C[0], C[1]); o.y = pk2(C[2], C[3]); o.z = pk2(C[4], C[5]); o.w = pk2(C[6], C[7]);
                *(u32x4*)(p.ST + td * 16384 + v * 128 + k0) = o;
                if (e == 0) sc[2] = m;
#pragma unroll
                for (int q = 0; q < 4; ++q) { C[2 * q] = alpha * C[2 * q] + beta * __uint_as_float(U[jj][q] << 16); C[2 * q + 1] = alpha * C[2 * q + 1] + beta * __uint_as_float(U[jj][q] & 0xffff0000u); }
                if (v == 0) { float* nv = p.NV + td * 128 + k0; const f32x4 n0 = *(const f32x4*)nv, n1 = *(const f32x4*)(nv + 4);
                    *(f32x4*)nv = (f32x4){n[0], n[1], n[2], n[3]}; *(f32x4*)(nv + 4) = (f32x4){n[4], n[5], n[6], n[7]};
#pragma unroll
                    for (int q = 0; q < 4; ++q) { n[q] = alpha * n[q] + beta * n0[q]; n[4 + q] = alpha * n[4 + q] + beta * n1[q]; } }
                m = mn;
            }
        }
    }
}

__device__ __forceinline__ void phase_mixC(const MixP& p, LAS unsigned char* lds, int bid, int nb) {
    LAS unsigned char* Qimg = lds; LAS unsigned char* Kimg = lds + 34816; LAS unsigned char* Vimg = lds + 69632; LAS unsigned char* Cimg = lds + 108544;
    LAS float* arr = (LAS float*)(lds + 147712);
    LAS float *aF = arr, *aB = arr + 128, *bF = arr + 256, *bB = arr + 384, *MF = arr + 512, *MB = arr + 640, *lfF = arr + 768, *lfB = arr + 896, *igF = arr + 1024, *igB = arr + 1152;
    const int tid = threadIdx.x, wave = __builtin_amdgcn_readfirstlane(tid >> 6), lane = tid & 63, g = lane >> 4, i16 = lane & 15, q = i16 >> 2, pp = i16 & 3;
    LAS unsigned char* Pw = Cimg + wave * 4352;
    for (int tile = bid; tile < 2 * 16 * 32; tile += nb) {
        const int ch = tile & 31, h = (tile >> 5) & 3, b = (tile >> 7) & 3, kind = tile >> 9;
        const int tileA = ((kind * 4 + b) * 4 + h) * NCH + ch;
        const size_t row0 = (size_t)b * T + ch * 128;
        const bf16_t* prow = p.Pb + row0 * PBC + h * 128;
        stage128(Qimg, RS_QK, prow + (kind ? PB_RQ : PB_MQ), PBC);
        stage128(Kimg, RS_QK, prow + (kind ? PB_RK : PB_MK), PBC);
        stage128(Vimg, RS_V, prow + (kind ? PB_RV : PB_MV), PBC);
        if (tid < 128) { *(LAS u32x4*)(Vimg + tid * RS_V + 256) = (u32x4){0x3F80u, 0u, 0u, 0u}; *(LAS u32x4*)(Vimg + tid * RS_V + 272) = (u32x4){0u, 0u, 0u, 0u}; }
        stage128(Cimg, RS_QK, p.ST + ((size_t)tileA * 2 + 0) * 16384, 128);
        if (tid < 128) { ((LAS unsigned short*)(Cimg + 128 * RS_QK))[tid] = (unsigned short)f2bf(p.NV[((size_t)tileA * 2 + 0) * 128 + tid]); }
        for (int z = tid; z < 15 * 68; z += NTHR) ((LAS unsigned*)(Cimg + 129 * RS_QK))[z] = 0u;
        gate_prep(p, kind, b, h, ch, aF, aB, bF, bB, lfF, lfB, igF, igB);
        const float minF = p.SC[((size_t)tileA * 2 + 0) * 4 + 2], minB = p.SC[((size_t)tileA * 2 + 1) * 4 + 2];
        if (tid < 128) { if (kind == 0) { float mx = minF; for (int j = 0; j <= tid; ++j) mx = fmaxf(mx, aF[j]); MF[tid] = mx; } else MF[tid] = -bF[tid]; }
        else if (tid < 256) { const int t2 = tid - 128; if (kind == 0) { float mx = minB; for (int j = 127; j >= t2; --j) mx = fmaxf(mx, aB[j]); MB[t2] = mx; } else MB[t2] = -bB[t2]; }
        bf16x8 aq[4];
#pragma unroll
        for (int ks = 0; ks < 4; ++ks) aq[ks] = *(const LAS bf16x8*)(Qimg + (16 * wave + i16) * RS_QK + (32 * ks + 8 * g) * 2);
        f32x4 accF[9], accB[9];
#pragma unroll
        for (int ni = 0; ni < 9; ++ni) { accF[ni] = (f32x4){0.f, 0.f, 0.f, 0.f}; accB[ni] = (f32x4){0.f, 0.f, 0.f, 0.f}; }
#pragma unroll
        for (int ni = 0; ni < 9; ++ni)
#pragma unroll
            for (int ks = 0; ks < 4; ++ks) { const bf16x8 bc = *(const LAS bf16x8*)(Cimg + (16 * ni + i16) * RS_QK + (32 * ks + 8 * g) * 2); accF[ni] = __builtin_amdgcn_mfma_f32_16x16x32_bf16(aq[ks], bc, accF[ni], 0, 0, 0); }
        __syncthreads();
        stage128(Cimg, RS_QK, p.ST + ((size_t)tileA * 2 + 1) * 16384, 128);
        if (tid < 128) { ((LAS unsigned short*)(Cimg + 128 * RS_QK))[tid] = (unsigned short)f2bf(p.NV[((size_t)tileA * 2 + 1) * 128 + tid]); }
        __syncthreads();
#pragma unroll
        for (int ni = 0; ni < 9; ++ni)
#pragma unroll
            for (int ks = 0; ks < 4; ++ks) { const bf16x8 bc = *(const LAS bf16x8*)(Cimg + (16 * ni + i16) * RS_QK + (32 * ks + 8 * g) * 2); accB[ni] = __builtin_amdgcn_mfma_f32_16x16x32_bf16(aq[ks], bc, accB[ni], 0, 0, 0); }
        f32x4 st[8];
#pragma unroll
        for (int nj = 0; nj < 8; ++nj) { st[nj] = (f32x4){0.f, 0.f, 0.f, 0.f};
#pragma unroll
            for (int ks = 0; ks < 4; ++ks) { const bf16x8 ak = *(const LAS bf16x8*)(Kimg + (16 * nj + i16) * RS_QK + (32 * ks + 8 * g) * 2); st[nj] = __builtin_amdgcn_mfma_f32_16x16x32_bf16(ak, aq[ks], st[nj], 0, 0, 0); } }
        __syncthreads();
        const int tl = 16 * wave + i16;
#define MIXC_DIR(dir, ACC) do { \
            const LAS float* aD = dir ? aB : aF; const LAS float* MD = dir ? MB : MF; const LAS float* bD = dir ? bB : bF; \
            const float Mt = MD[tl]; \
            _Pragma("unroll") for (int nj = 0; nj < 8; ++nj) { const int s0 = 16 * nj + 4 * g; const f32x4 av = *(const LAS f32x4*)(aD + s0); float pv[4]; \
                _Pragma("unroll") for (int r = 0; r < 4; ++r) { const int s = s0 + r; const bool ok = dir ? (s >= tl) : (s <= tl); pv[r] = ok ? st[nj][r] * expf(av[r] - Mt) : 0.f; } \
                u32x2 o; o.x = pk2(pv[0], pv[1]); o.y = pk2(pv[2], pv[3]); *(LAS u32x2*)(Pw + i16 * RS_QK + s0 * 2) = o; } \
            __syncthreads(); \
            const float mIn = dir ? minB : minF; \
            _Pragma("unroll") for (int r = 0; r < 4; ++r) { const float iw = expf(mIn - MD[16 * wave + 4 * g + r]); \
                _Pragma("unroll") for (int ni = 0; ni < 9; ++ni) ACC[ni][r] *= iw; } \
            _Pragma("unroll") for (int ks = 0; ks < 4; ++ks) { const bf16x8 ap = *(const LAS bf16x8*)(Pw + i16 * RS_QK + (32 * ks + 8 * g) * 2); \
                _Pragma("unroll") for (int ni = 0; ni < 9; ++ni) { const bf16x8 bv = tr_frag(Vimg + (32 * ks + 8 * g + q) * RS_V + (16 * ni + 4 * pp) * 2, RS_V); ACC[ni] = __builtin_amdgcn_mfma_f32_16x16x32_bf16(ap, bv, ACC[ni], 0, 0, 0); } \
                asm volatile("" ::: "memory"); } \
            _Pragma("unroll") for (int r = 0; r < 4; ++r) { \
                float inv = 1.f; \
                if (kind == 0) { const float den = __shfl(ACC[8][r], lane & 48); const int t = 16 * wave + 4 * g + r; inv = 1.f / fmaxf(fabsf(den), expf(-(bD[t] + MD[t]))); } \
                _Pragma("unroll") for (int ni = 0; ni < 8; ++ni) ACC[ni][r] *= inv; } \
            __syncthreads(); } while (0)
        MIXC_DIR(0, accF);
        MIXC_DIR(1, accB);
#undef MIXC_DIR
#pragma unroll
        for (int r = 0; r < 4; ++r) {
            float ss = 0.f;
#pragma unroll
            for (int ni = 0; ni < 8; ++ni) { const float hs = accF[ni][r] + accB[ni][r]; ss += hs * hs; }
            ss += __shfl_xor(ss, 1); ss += __shfl_xor(ss, 2); ss += __shfl_xor(ss, 4); ss += __shfl_xor(ss, 8);
            const float rn = rsqrtf(ss * (1.f / 128.f) + EPS);
            const size_t row = row0 + 16 * wave + 4 * g + r;
            const bf16_t* orow = p.Pb + row * PBC + (kind ? PB_RO : PB_MO) + h * 128;
            bf16_t* yrow = p.YM + row * D + kind * 512 + h * 128;
            const float* nw = p.normw + kind * 512 + h * 128;
#pragma unroll
            for (int ni = 0; ni < 8; ++ni) { const int v = 16 * ni + i16; const float o = bf2f(orow[v]); const float gt = kind ? fast_silu(o) : __builtin_amdgcn_rcpf(1.f + __expf(-o));
                yrow[v] = (bf16_t)f2bf(gt * (accF[ni][r] + accB[ni][r]) * rn * nw[v]); }
        }
        __syncthreads();
    }
}
__global__ void __launch_bounds__(NTHR, 2) fk_mixA(MixP p) { extern __shared__ __attribute__((aligned(16))) unsigned char lds[]; phase_mixA(p, (LAS unsigned char*)lds, blockIdx.x, gridDim.x); }
__global__ void __launch_bounds__(NTHR, 2) fk_mixB(MixP p) { phase_mixB(p, blockIdx.x, gridDim.x); }
__global__ void __launch_bounds__(NTHR, 2) fk_mixC(MixP p) { extern __shared__ __attribute__((aligned(16))) unsigned char lds[]; phase_mixC(p, (LAS unsigned char*)lds, blockIdx.x, gridDim.x); }
__global__ void ak_bf16_to_f32(const bf16_t* __restrict__ in, float* __restrict__ out, size_t n) {
    for (size_t i = (size_t)blockIdx.x * blockDim.x + threadIdx.x; i < n; i += (size_t)gridDim.x * blockDim.x) out[i] = bf2f(in[i]);
}

struct TailP {
    const float *x, *mod, *norm2_w, *w_router, *final_w; const bf16_t *YM, *WoutT, *Ys;
    float *xl, *aff, *gate, *out; bf16_t* H2; int *idx, *slotmap;
};
struct SchedOutProj {
    const char* A; const char* W; int G, c;
    __device__ __forceinline__ bool next(int i, pg8::Unit& u) const {
        const int L = i * G + c; if (L >= 256) return false;
        const int x = L & 7, uu = L >> 3; u.pm = 8 * x + (uu & 7); u.pn = uu >> 3; u.aux = 0; u.pad = 0; u.arows = nullptr;
        u.a = A + (size_t)u.pm * 256 * (D * 2); u.b = W + (size_t)u.pn * 256 * (D * 2); return true;
    }
};
struct EpiOutProj {
    static constexpr bool PERM = false;
    const float* x; const float* mod; float* xl;
    __device__ __forceinline__ void operator()(const f32x4 (&acc)[2][2][4][2], const pg8::Unit& u, int wr, int wc, int fr, int fq) const {
        const int row0 = u.pm * 256 + wr * 64 + fr, col0 = u.pn * 256 + wc * 32 + 4 * fq;
#pragma unroll
        for (int ai = 0; ai < 2; ++ai)
#pragma unroll
            for (int m = 0; m < 4; ++m) { const int r = row0 + ai * 128 + m * 16; const float* g1 = mod + (r >> 12) * 6144 + 2048;
#pragma unroll
                for (int bj = 0; bj < 2; ++bj)
#pragma unroll
                    for (int n = 0; n < 2; ++n) { const int c = col0 + bj * 128 + n * 16; const f32x4 xv = *(const f32x4*)(x + (size_t)r * D + c), gv = *(const f32x4*)(g1 + c);
                        *(f32x4*)(xl + (size_t)r * D + c) = xv + gv * acc[ai][bj][m][n]; } }
    }
};
__device__ __forceinline__ void phase_norm2(const TailP& p, LAS unsigned char* lds, int bid, int nb) {
    LAS float* wg = (LAS float*)lds;
    const int tid = threadIdx.x, wave = __builtin_amdgcn_readfirstlane(tid >> 6), lane = tid & 63;
    for (int i = tid; i < 1024 * 16; i += NTHR) { const int k = i >> 4, j = i & 15; wg[k * 20 + j] = p.w_router[i]; }
    __syncthreads();
    const int gw = bid * 8 + wave, NGW = nb * 8;
    for (int row = gw; row < ML; row += NGW) {
        const float* src = p.xl + (size_t)row * D; const float* md = p.mod + (row >> 12) * 6144;
        float v[16]; float ss = 0.f;
#pragma unroll
        for (int i = 0; i < 16; ++i) { v[i] = src[lane + 64 * i]; ss += v[i] * v[i]; }
#pragma unroll
        for (int o = 1; o < 64; o <<= 1) ss += __shfl_xor(ss, o);
        const float rstd = rsqrtf(ss * (1.f / D) + EPS);
        float g[16];
#pragma unroll
        for (int j = 0; j < 16; ++j) g[j] = 0.f;
#pragma unroll
        for (int i = 0; i < 16; ++i) {
            const int k = lane + 64 * i;
            const float hh = v[i] * rstd * p.norm2_w[k] * (1.f + md[4096 + k]) + md[3072 + k];
            p.H2[(size_t)row * D + k] = (bf16_t)f2bf(hh);
            const LAS f32x4* wr = (const LAS f32x4*)(wg + k * 20);
            const f32x4 w0 = wr[0], w1 = wr[1], w2 = wr[2], w3 = wr[3];
            g[0] += hh * w0[0]; g[1] += hh * w0[1]; g[2] += hh * w0[2]; g[3] += hh * w0[3]; g[4] += hh * w1[0]; g[5] += hh * w1[1]; g[6] += hh * w1[2]; g[7] += hh * w1[3];
            g[8] += hh * w2[0]; g[9] += hh * w2[1]; g[10] += hh * w2[2]; g[11] += hh * w2[3]; g[12] += hh * w3[0]; g[13] += hh * w3[1]; g[14] += hh * w3[2]; g[15] += hh * w3[3];
            if (i & 1) asm volatile("" ::: "memory");
        }
#pragma unroll
        for (int j = 0; j < 16; ++j) g[j] += __shfl_xor(g[j], 32);
        float g1[8], g2[4], g3[2];
        { const bool hi = lane & 16;
#pragma unroll
          for (int j = 0; j < 8; ++j) { const float mine = hi ? g[j + 8] : g[j], theirs = hi ? g[j] : g[j + 8]; g1[j] = mine + __shfl_xor(theirs, 16); } }
        { const bool hi = lane & 8;
#pragma unroll
          for (int j = 0; j < 4; ++j) { const float mine = hi ? g1[j + 4] : g1[j], theirs = hi ? g1[j] : g1[j + 4]; g2[j] = mine + __shfl_xor(theirs, 8); } }
        { const bool hi = lane & 4;
#pragma unroll
          for (int j = 0; j < 2; ++j) { const float mine = hi ? g2[j + 2] : g2[j], theirs = hi ? g2[j] : g2[j + 2]; g3[j] = mine + __shfl_xor(theirs, 4); } }
        float lg; { const bool hi = lane & 2; const float mine = hi ? g3[1] : g3[0], theirs = hi ? g3[0] : g3[1]; lg = mine + __shfl_xor(theirs, 2); }
        lg += __shfl_xor(lg, 1);
        float mx = lg; mx = fmaxf(mx, __shfl_xor(mx, 2)); mx = fmaxf(mx, __shfl_xor(mx, 4)); mx = fmaxf(mx, __shfl_xor(mx, 8)); mx = fmaxf(mx, __shfl_xor(mx, 16));
        const float ex = expf(lg - mx); float sm = ex; sm += __shfl_xor(sm, 2); sm += __shfl_xor(sm, 4); sm += __shfl_xor(sm, 8); sm += __shfl_xor(sm, 16);
        if ((lane & 33) == 0) p.aff[(size_t)row * 16 + (lane >> 1)] = ex / sm;
    }
}
__device__ __forceinline__ void phase_topk(const TailP& p, LAS unsigned char* lds, int bid, int nb) {
    LAS unsigned* hist = (LAS unsigned*)lds;
    LAS unsigned* ctl = hist + 256;
    LAS unsigned* wsum = ctl + 8;
    const int tid = threadIdx.x, wave = tid >> 6, lane = tid & 63;
    for (int item = bid; item < NB * NE; item += nb) {
        const int b = item >> 4, e = item & 15;
        unsigned key[8];
#pragma unroll
        for (int j = 0; j < 8; ++j) key[j] = __float_as_uint(p.aff[((size_t)b * T + tid * 8 + j) * 16 + e]);
        if (tid == 0) { ctl[0] = 0u; ctl[1] = (unsigned)CAP; }
        unsigned prefix = 0u, krem = CAP;
#pragma unroll 1
        for (int pass = 0; pass < 4; ++pass) {
            const int shift = 24 - 8 * pass;
            if (tid < 256) hist[tid] = 0u;
            __syncthreads();
#pragma unroll
            for (int j = 0; j < 8; ++j) { const bool match = pass == 0 ? true : ((key[j] >> (shift + 8)) == prefix); if (match) atomicAdd((unsigned*)(hist + ((key[j] >> shift) & 255u)), 1u); }
            __syncthreads();
            if (tid < 256) { unsigned above = 0u; for (int d = tid + 1; d < 256; ++d) above += hist[d]; const unsigned mine = hist[tid];
                if (above < krem && krem <= above + mine) { ctl[0] = (prefix << 8) | (unsigned)tid; ctl[1] = krem - above; } }
            __syncthreads();
            prefix = ctl[0]; krem = ctl[1];
            __syncthreads();
        }
        unsigned ng = 0u, ne = 0u;
#pragma unroll
        for (int j = 0; j < 8; ++j) { ng += key[j] > prefix ? 1u : 0u; ne += key[j] == prefix ? 1u : 0u; }
        unsigned sg = ng, se = ne;
#pragma unroll
        for (int o = 1; o < 64; o <<= 1) { const unsigned tg = __shfl_up(sg, o), te = __shfl_up(se, o); if (lane >= o) { sg += tg; se += te; } }
        if (lane == 63) { wsum[wave * 2] = sg; wsum[wave * 2 + 1] = se; }
        __syncthreads();
        unsigned bg = sg - ng, be = se - ne;
        for (int w = 0; w < wave; ++w) { bg += wsum[w * 2]; be += wsum[w * 2 + 1]; }
#pragma unroll
        for (int j = 0; j < 8; ++j) {
            const int t = tid * 8 + j; const bool gr = key[j] > prefix, eq = key[j] == prefix; const bool sel = gr || (eq && be < krem);
            const int cslot = (int)(bg + (be < krem ? be : krem)); const int R = e * 2048 + b * CAP + cslot;
            if (sel) { p.idx[R] = b * T + t; p.gate[R] = __uint_as_float(key[j]); }
            p.slotmap[((size_t)b * T + t) * NE + e] = sel ? R : -1;
            bg += gr ? 1u : 0u; be += eq ? 1u : 0u;
        }
        __syncthreads();
    }
}
__device__ __forceinline__ void phase_final(const TailP& p, int bid, int nb) {
    const int tid = threadIdx.x, wave = __builtin_amdgcn_readfirstlane(tid >> 6), lane = tid & 63;
    const int gw = bid * 8 + wave, NGW = nb * 8;
    for (int row = gw; row < ML; row += NGW) {
        const int sm = lane < 16 ? p.slotmap[(size_t)row * NE + lane] : -1;
        f32x4 a[4];
#pragma unroll
        for (int i = 0; i < 4; ++i) a[i] = (f32x4){0.f, 0.f, 0.f, 0.f};
#pragma unroll
        for (int e = 0; e < NE; ++e) { const int sl = __builtin_amdgcn_readlane(sm, e);
            if (sl >= 0) { const u32x2* yr = (const u32x2*)(p.Ys + (size_t)sl * D);
#pragma unroll
                for (int i = 0; i < 4; ++i) { const u32x2 w = yr[lane + 64 * i]; a[i][0] += __uint_as_float(w.x << 16); a[i][1] += __uint_as_float(w.x & 0xffff0000u); a[i][2] += __uint_as_float(w.y << 16); a[i][3] += __uint_as_float(w.y & 0xffff0000u); } } }
        const float* g2 = p.mod + (row >> 12) * 6144 + 5120; float ss = 0.f;
#pragma unroll
        for (int i = 0; i < 4; ++i) { const int k = 4 * (lane + 64 * i); const f32x4 xv = *(const f32x4*)(p.xl + (size_t)row * D + k), gv = *(const f32x4*)(g2 + k); a[i] = xv + gv * a[i];
            ss += (a[i][0] * a[i][0] + a[i][1] * a[i][1]) + (a[i][2] * a[i][2] + a[i][3] * a[i][3]); }
#pragma unroll
        for (int o = 1; o < 64; o <<= 1) ss += __shfl_xor(ss, o);
        const float rstd = rsqrtf(ss * (1.f / D) + EPS);
#pragma unroll
        for (int i = 0; i < 4; ++i) { const int k = 4 * (lane + 64 * i); const f32x4 fw = *(const f32x4*)(p.final_w + k); *(f32x4*)(p.out + (size_t)row * D + k) = a[i] * rstd * fw; }
    }
}
__global__ void __launch_bounds__(NTHR, 2) fk_outproj(TailP p) {
    extern __shared__ __attribute__((aligned(16))) unsigned char lds[];
    SchedOutProj S{(const char*)p.YM, (const char*)p.WoutT, (int)gridDim.x, (int)blockIdx.x}; EpiOutProj E{p.x, p.mod, p.xl};
    pg8::gemm_phase(((LAS unsigned char*)lds), D, S, E);
}
__global__ void __launch_bounds__(NTHR, 2) fk_norm2(TailP p) { extern __shared__ __attribute__((aligned(16))) unsigned char lds[]; phase_norm2(p, (LAS unsigned char*)lds, blockIdx.x, gridDim.x); }
__global__ void __launch_bounds__(NTHR, 2) fk_topk(TailP p) { extern __shared__ __attribute__((aligned(16))) unsigned char lds[]; phase_topk(p, (LAS unsigned char*)lds, blockIdx.x, gridDim.x); }
__global__ void __launch_bounds__(NTHR, 2) fk_final(TailP p) { phase_final(p, blockIdx.x, gridDim.x); }
__global__ void ak_f32_to_bf16(const float* __restrict__ in, bf16_t* __restrict__ out, size_t n4) {
    for (size_t i = (size_t)blockIdx.x * blockDim.x + threadIdx.x; i < n4; i += (size_t)gridDim.x * blockDim.x) { const float4 v = ((const float4*)in)[i]; u32x2 o; o.x = pk2(v.x, v.y); o.y = pk2(v.z, v.w); ((u32x2*)out)[i] = o; }
}
__global__ void nk_final_bf16(const float* __restrict__ xl, const bf16_t* __restrict__ ys, const int* __restrict__ slotmap, const float* __restrict__ mod,
                              const float* __restrict__ fw, float* __restrict__ out) {
    __shared__ float red[4];
    const int row = blockIdx.x, b = row / T;
    float v[4]; float ss = 0;
    for (int i = 0; i < 4; ++i) {
        const int k = threadIdx.x + 256 * i; float acc = 0.f;
        for (int e = 0; e < NE; ++e) { const int s = slotmap[(size_t)row * NE + e]; if (s >= 0) acc += bf2f(ys[(size_t)s * D + k]); }
        v[i] = xl[(size_t)row * D + k] + mod[b * 6144 + 5120 + k] * acc; ss += v[i] * v[i];
    }
    ss = block_sum_256(ss, red);
    const float rstd = rsqrtf(ss / D + EPS);
    for (int i = 0; i < 4; ++i) { const int k = threadIdx.x + 256 * i; out[(size_t)row * D + k] = v[i] * rstd * fw[k]; }
}

extern "C" void kernel_launch(void* const* d_in, const int* in_sizes, int n_in, void* d_out, int out_size, void* d_ws, size_t ws_size, hipStream_t stream) {
    const float* x = (const float*)d_in[0]; const float* c = (const float*)d_in[1]; const float* ctx = (const float*)d_in[2]; const float* c_ctx = (const float*)d_in[3];
    const float* w_ada = (const float*)d_in[4]; const float* b_ada = (const float*)d_in[5]; const float* norm1_w = (const float*)d_in[6]; const float* norm2_w = (const float*)d_in[7];
    const float* w_in = (const float*)d_in[8]; const float* gate_bias = (const float*)d_in[9]; const float* decay_logit = (const float*)d_in[10];
    const float* mnw = (const float*)d_in[11]; const float* rnw = (const float*)d_in[12]; const float* w_out = (const float*)d_in[13]; const float* w_router = (const float*)d_in[14];
    const float* w_gate = (const float*)d_in[15]; const float* w_up = (const float*)d_in[16]; const float* w_down = (const float*)d_in[17]; const float* final_w = (const float*)d_in[18];
    float* out = (float*)d_out;
    char* ws = (char*)d_ws; size_t off = 0;
    auto carve = [&](size_t bytes) { char* p = ws + off; off += (bytes + 255) & ~(size_t)255; return p; };
    float* mod = (float*)carve(5 * 6144 * 4);
    float* aff = (float*)carve((size_t)ML * 16 * 4);
    int* idx = (int*)carve(NSLOT * 4); float* gate = (float*)carve(NSLOT * 4); int* erow = (int*)carve(NSLOT * 4);
    int* slotmap = (int*)carve((size_t)ML * NE * 4);
    float* xl = (float*)carve((size_t)ML * D * 4);
    const size_t x0 = off;
    bf16_t* WinT = (bf16_t*)carve((size_t)4096 * D * 2); bf16_t* WoutT = (bf16_t*)carve((size_t)D * D * 2);
    float* ropetab = (float*)carve(2048 * 2 * 4); float* normw = (float*)carve(1024 * 4); float* G = (float*)carve((size_t)MA * 16 * 4);
    bf16_t* XN = (bf16_t*)carve((size_t)MA * D * 2); bf16_t* Pb = (bf16_t*)carve((size_t)MA * PBC * 2);
    float* y = (float*)carve((size_t)ML * D * 4);
    bf16_t* ST = (bf16_t*)carve((size_t)2 * 16 * NCH * 2 * 16384 * 2); float* NV = (float*)carve((size_t)2 * 16 * NCH * 2 * 128 * 4); float* SC = (float*)carve((size_t)2 * 16 * NCH * 2 * 4 * 4);
    bf16_t* YM = (bf16_t*)carve((size_t)ML * D * 2);
    const size_t early_end = off;
    off = x0;
    bf16_t* WguT = (bf16_t*)carve((size_t)NE * 5632 * D * 2);
    bf16_t* WdT = (bf16_t*)carve((size_t)NE * D * FF * 2);
    bf16_t* Hb = (bf16_t*)carve((size_t)NSLOT * FF * 2);
    float* h2 = (float*)carve((size_t)ML * D * 4);
    bf16_t* H2 = (bf16_t*)carve((size_t)ML * D * 2);
    bf16_t* Ys = (bf16_t*)carve((size_t)NSLOT * D * 2);
    if (off < early_end) off = early_end;
    if (off > ws_size) { fprintf(stderr, "ws too small: need %zu have %zu\n", off, ws_size); return; }
    static bool attr_done = false;
    if (!attr_done) {
        hipFuncSetAttribute((const void*)fk_convert_moe, hipFuncAttributeMaxDynamicSharedMemorySize, LDS_BYTES);
        hipFuncSetAttribute((const void*)fk_moe1, hipFuncAttributeMaxDynamicSharedMemorySize, LDS_BYTES);
        hipFuncSetAttribute((const void*)fk_moe2, hipFuncAttributeMaxDynamicSharedMemorySize, LDS_BYTES);
        hipFuncSetAttribute((const void*)fk_p0, hipFuncAttributeMaxDynamicSharedMemorySize, LDS_BYTES);
        hipFuncSetAttribute((const void*)fk_p1, hipFuncAttributeMaxDynamicSharedMemorySize, LDS_BYTES);
        hipFuncSetAttribute((const void*)fk_p2, hipFuncAttributeMaxDynamicSharedMemorySize, LDS_BYTES);
        hipFuncSetAttribute((const void*)fk_mixA, hipFuncAttributeMaxDynamicSharedMemorySize, LDS_BYTES);
        hipFuncSetAttribute((const void*)fk_mixC, hipFuncAttributeMaxDynamicSharedMemorySize, LDS_BYTES);
        hipFuncSetAttribute((const void*)fk_outproj, hipFuncAttributeMaxDynamicSharedMemorySize, LDS_BYTES);
        hipFuncSetAttribute((const void*)fk_norm2, hipFuncAttributeMaxDynamicSharedMemorySize, LDS_BYTES);
        hipFuncSetAttribute((const void*)fk_topk, hipFuncAttributeMaxDynamicSharedMemorySize, LDS_BYTES);
        attr_done = true;
    }
    FastP fp{}; fp.w_gate = w_gate; fp.w_up = w_up; fp.w_down = w_down; fp.gate = gate; fp.erow = erow; fp.WguT = WguT; fp.WdT = WdT; fp.H2 = H2; fp.Hb = Hb; fp.Ys = Ys;
    FastQ fq{}; fq.x = x; fq.ctx = ctx; fq.c = c; fq.c_ctx = c_ctx; fq.w_ada = w_ada; fq.b_ada = b_ada; fq.norm1_w = norm1_w; fq.w_in = w_in; fq.w_out = w_out;
    fq.mnw = mnw; fq.rnw = rnw; fq.normw = normw; fq.mod = mod; fq.ropetab = ropetab; fq.G = G; fq.WinT = WinT; fq.WoutT = WoutT; fq.XN = XN; fq.Pb = Pb;

    fk_p0<<<256, NTHR, LDS_BYTES, stream>>>(fq);
    fk_p1<<<256, NTHR, LDS_BYTES, stream>>>(fq);
    fk_p2<<<256, NTHR, LDS_BYTES, stream>>>(fq);
    MixP mp{}; mp.Pb = Pb; mp.G = G; mp.gate_bias = gate_bias; mp.decay_logit = decay_logit; mp.normw = normw; mp.ST = ST; mp.NV = NV; mp.SC = SC; mp.YM = YM;
    fk_mixA<<<256, NTHR, LDS_BYTES, stream>>>(mp);
    fk_mixB<<<256, NTHR, 0, stream>>>(mp);
    fk_mixC<<<256, NTHR, LDS_BYTES, stream>>>(mp);
    TailP tp{}; tp.x = x; tp.mod = mod; tp.norm2_w = norm2_w; tp.w_router = w_router; tp.final_w = final_w; tp.YM = YM; tp.WoutT = WoutT; tp.Ys = Ys;
    tp.xl = xl; tp.aff = aff; tp.gate = gate; tp.out = out; tp.H2 = H2; tp.idx = erow; tp.slotmap = slotmap;
    fk_outproj<<<256, NTHR, LDS_BYTES, stream>>>(tp);
    fk_convert_moe<<<256, NTHR, LDS_BYTES, stream>>>(fp);
    fk_norm2<<<256, NTHR, LDS_BYTES, stream>>>(tp);
    fk_topk<<<256, NTHR, LDS_BYTES, stream>>>(tp);
    fk_moe1<<<256, NTHR, LDS_BYTES, stream>>>(fp);
    fk_moe2<<<256, NTHR, LDS_BYTES, stream>>>(fp);
    fk_final<<<256, NTHR, 0, stream>>>(tp);
}
```

```cpp
#include <hip/hip_runtime.h>
#include <cstdint>
#include <cstdio>

constexpr int D = 1024, NB = 4, T = 4096, TC = 256, NH = 4, DH = 128;
constexpr int ML = NB * T;
constexpr int MC = NB * TC;
constexpr int MA = ML + MC;
constexpr int INC = 4112;
constexpr int NE = 16, CAP = 512, FF = 2816;
constexpr int NSLOT = NB * NE * CAP;
constexpr float EPS = 1e-6f;
constexpr int C_MQ = 0, C_MK = 512, C_MV = 1024, C_MO = 1536, C_MG = 2048, C_RQ = 2064, C_RK = 2576, C_RV = 3088, C_RO = 3600;

__device__ __forceinline__ float sigmoidf_(float x) { return 1.f / (1.f + expf(-x)); }
__device__ __forceinline__ float siluf_(float x) { return x / (1.f + expf(-x)); }
__device__ __forceinline__ float logsigmoidf_(float x) { return fminf(x, 0.f) - log1pf(expf(-fabsf(x))); }

constexpr int PB_MQ = 0, PB_MK = 512, PB_MV = 1024, PB_MO = 1536, PB_RQ = 2048, PB_RK = 2560, PB_RV = 3072, PB_RO = 3584, PBC = 4096;

#define LAS __attribute__((address_space(3)))
typedef unsigned short bf16_t;
typedef short bf16x8 __attribute__((ext_vector_type(8)));
typedef float f32x4 __attribute__((ext_vector_type(4)));
typedef unsigned u32x4 __attribute__((ext_vector_type(4)));
typedef unsigned u32x2 __attribute__((ext_vector_type(2)));
typedef int v8i __attribute__((ext_vector_type(8)));
typedef int v4i __attribute__((ext_vector_type(4)));
typedef unsigned char fp8_t;
constexpr int NTHR = 512;
constexpr int LDS_BYTES = 155648;

__device__ __forceinline__ unsigned f2bf(float f) { unsigned u = __float_as_uint(f); return (u + 0x7fffu + ((u >> 16) & 1u)) >> 16; }
__device__ __forceinline__ unsigned pk2(float lo, float hi) { return f2bf(lo) | (f2bf(hi) << 16); }
__device__ __forceinline__ float bf2f(unsigned short b) { return __uint_as_float((unsigned)b << 16); }
__device__ __forceinline__ unsigned cvt_pk_bf16(float lo, float hi) { unsigned r; asm volatile("v_cvt_pk_bf16_f32 %0, %1, %2" : "=v"(r) : "v"(lo), "v"(hi)); return r; }
__device__ __forceinline__ int ltid(int wid) { int l; asm volatile("v_mbcnt_lo_u32_b32 %0, -1, 0\n\tv_mbcnt_hi_u32_b32 %0, -1, %0" : "=v"(l)); return wid * 64 + l; }
__device__ __forceinline__ unsigned pk4_fp8(float a, float b, float c, float d) { int p = __builtin_amdgcn_cvt_pk_fp8_f32(a, b, 0, false); p = __builtin_amdgcn_cvt_pk_fp8_f32(c, d, p, true); return (unsigned)p; }
__device__ __forceinline__ f32x4 bf4_f32(unsigned a, unsigned b) { return (f32x4){__uint_as_float(a << 16), __uint_as_float(a & 0xffff0000u), __uint_as_float(b << 16), __uint_as_float(b & 0xffff0000u)}; }
template <class T> __device__ __forceinline__ T ntl(const T* p) { return __builtin_nontemporal_load(p); }
template <class T> __device__ __forceinline__ void nts(T v, T* p) { __builtin_nontemporal_store(v, p); }
typedef __amdgpu_buffer_rsrc_t rsrc_t;
__device__ __forceinline__ float fast_silu(float x) { return x * __builtin_amdgcn_rcpf(1.f + __expf(-x)); }

namespace pg8 {
constexpr int BM = 256, BK = 64, HALF = 128, HTB = HALF * BK * 2  , STAGE_BYTES = 8 * HTB;
__device__ __forceinline__ int lds_byte(int r, int c) { const int st = (r >> 4) * 2 + (c >> 5), rr = r & 15, cc = c & 31, ob = rr * 64 + cc * 2; return st * 1024 + (ob ^ (((ob >> 9) & 1) << 5)); }
__device__ __forceinline__ void stage_rc(int b, int& R, int& C) { const int st = b / 1024, sb = b % 1024, swz = sb ^ (((sb >> 9) & 1) << 5); R = (st >> 1) * 16 + swz / 64; C = (st & 1) * 32 + (swz % 64) / 2; }
__device__ __forceinline__ int perm32(int rho) { const int n = rho >> 4, i = rho & 15; return 8 * (i >> 2) + 4 * n + (i & 3); }
struct Unit { const char* a; const char* b; const int* arows; int pm, pn, aux, lrows; };

struct NoSide { static constexpr bool ON = false; __device__ __forceinline__ int issue(int) { return 0; } template <int> __device__ __forceinline__ int finish(int) { return 0; } };
template <bool FP8, class Epi, class Sched, class Side>
__device__ __forceinline__ void gemm_phase(LAS unsigned char* lds, const int K, const Sched& S, const Epi& E, const int wv, Side& side) {
    const int tid = ltid(wv), wid = __builtin_amdgcn_readfirstlane(tid >> 6), lane = tid & 63, wr = wid >> 2, wc = wid & 3, fr = lane & 15, fq = lane >> 4;
    const int nt = K / BK;
    unsigned voffB[2];
#pragma unroll
    for (int i = 0; i < 2; ++i) { int R, C; stage_rc(tid * 16 + i * 8192, R, C); const int Rb = Epi::PERM ? ((R & ~31) + perm32(R & 31)) : R; voffB[i] = (unsigned)(Rb * K + C) * 2u; }
    const size_t kstep = (size_t)(BK * 2);
    const size_t hstep = (size_t)HALF * K * 2;
    const unsigned ldsw = (unsigned)wid * 1024u;
    const int aoff = lds_byte(wr * 64 + fr, fq * 8), boff = lds_byte(wc * 32 + fr, fq * 8);
#define PG8_SA(b, h) (((b) * 2 + (h)) * HTB)
#define PG8_SB(b, h) ((4 + (b) * 2 + (h)) * HTB)
#define PG8_STAGE(bufoff, gbase, voff) do { _Pragma("unroll") for (int _i = 0; _i < 2; ++_i) { unsigned _o = (voff)[_i]; asm volatile("" : "+v"(_o)); \
        __builtin_amdgcn_global_load_lds((const unsigned*)((const char*)(gbase) + _o), (LAS unsigned*)(lds + (bufoff) + ldsw + _i * 8192), 16, 0, 0); } } while (0)
#define PG8_STAGE2(bufoff, gbase, vc, vn) do { _Pragma("unroll") for (int _i = 0; _i < 2; ++_i) { unsigned _o = last ? (vn)[_i] : (vc)[_i]; asm volatile("" : "+v"(_o)); \
        __builtin_amdgcn_global_load_lds((const unsigned*)((const char*)(gbase) + _o), (LAS unsigned*)(lds + (bufoff) + ldsw + _i * 8192), 16, 0, 0); } } while (0)
#define PG8_LDA(dst, b, h) do { _Pragma("unroll") for (int m = 0; m < 4; ++m) { const v4i _lo = *(const LAS v4i*)(lds + PG8_SA(b, h) + aoff + m * 2048), _hi = *(const LAS v4i*)(lds + PG8_SA(b, h) + aoff + m * 2048 + 1024); \
        dst[m] = __builtin_shufflevector(_lo, _hi, 0, 1, 2, 3, 4, 5, 6, 7); } } while (0)
#define PG8_LDB(dst, b, h) do { _Pragma("unroll") for (int n = 0; n < 2; ++n) { const v4i _lo = *(const LAS v4i*)(lds + PG8_SB(b, h) + boff + n * 2048), _hi = *(const LAS v4i*)(lds + PG8_SB(b, h) + boff + n * 2048 + 1024); \
        dst[n] = __builtin_shufflevector(_lo, _hi, 0, 1, 2, 3, 4, 5, 6, 7); } } while (0)
#define PG8_LDAX(dst, base, off) do { _Pragma("unroll") for (int m = 0; m < 4; ++m) { const v4i _lo = *(const LAS v4i*)((base) + (off) + m * 2048), _hi = *(const LAS v4i*)((base) + (off) + m * 2048 + 1024); \
        dst[m] = __builtin_shufflevector(_lo, _hi, 0, 1, 2, 3, 4, 5, 6, 7); } } while (0)
#define PG8_LDBX(dst, base, off) do { _Pragma("unroll") for (int n = 0; n < 2; ++n) { const v4i _lo = *(const LAS v4i*)((base) + (off) + n * 2048), _hi = *(const LAS v4i*)((base) + (off) + n * 2048 + 1024); \
        dst[n] = __builtin_shufflevector(_lo, _hi, 0, 1, 2, 3, 4, 5, 6, 7); } } while (0)
#define PG8_MMA(ai, bj, At, Bt) do { __builtin_amdgcn_s_setprio(1); _Pragma("unroll") for (int m = 0; m < 4; ++m) _Pragma("unroll") for (int n = 0; n < 2; ++n) { \
        if constexpr (FP8) { acc[ai][bj][m][n] = __builtin_amdgcn_mfma_scale_f32_16x16x128_f8f6f4(Bt[n], At[m], acc[ai][bj][m][n], 0, 0, 0, (int)((bj) ? E.wscale1 : E.wscale0), 0, 0x7f7f7f7f); } \
        else { acc[ai][bj][m][n] = __builtin_amdgcn_mfma_f32_16x16x32_bf16(__builtin_bit_cast(bf16x8, __builtin_shufflevector(Bt[n], Bt[n], 0, 1, 2, 3)), __builtin_bit_cast(bf16x8, __builtin_shufflevector(At[m], At[m], 0, 1, 2, 3)), acc[ai][bj][m][n], 0, 0, 0); \
               acc[ai][bj][m][n] = __builtin_amdgcn_mfma_f32_16x16x32_bf16(__builtin_bit_cast(bf16x8, __builtin_shufflevector(Bt[n], Bt[n], 4, 5, 6, 7)), __builtin_bit_cast(bf16x8, __builtin_shufflevector(At[m], At[m], 4, 5, 6, 7)), acc[ai][bj][m][n], 0, 0, 0); } } \
        __builtin_amdgcn_s_setprio(0); } while (0)
#define PG8_WAIT_V(n) asm volatile("s_waitcnt vmcnt(" #n ")" ::: "memory")
#define PG8_WAIT_L(n) asm volatile("s_waitcnt lgkmcnt(" #n ")" ::: "memory")
#define PG8_BAR __builtin_amdgcn_s_barrier()
#define PG8_SCHED __builtin_amdgcn_sched_barrier(0)
#define PG8_AOFF(dst, u) do { const int _t = ltid(wv); _Pragma("unroll") for (int _i = 0; _i < 2; ++_i) { int _R, _C; stage_rc(_t * 16 + _i * 8192, _R, _C); \
        _Pragma("unroll") for (int _h = 0; _h < 2; ++_h) { const int _r = _h * HALF + _R; const int _ri = (u).lrows >= 0 ? *(const LAS int*)(lds + (u).lrows + 4 * _r) : ((u).arows ? (u).arows[_r] : _r); dst[_h][_i] = (unsigned)(_ri * K + _C) * 2u; } } } while (0)
    Unit cur, nxt; int ui = 0; int sdc = 0;
    if (!S.next(0, cur)) return;
    f32x4 acc[2][2][4][2];
#pragma unroll
    for (int a = 0; a < 2; ++a)
#pragma unroll
        for (int b = 0; b < 2; ++b)
#pragma unroll
            for (int m = 0; m < 4; ++m)
#pragma unroll
                for (int n = 0; n < 2; ++n) acc[a][b][m][n] = (f32x4){0.f, 0.f, 0.f, 0.f};
    v8i At[4], B0[2], B1[2];
    unsigned cO[2][2], nO[2][2];
    PG8_AOFF(cO, cur);
    const char* cA = cur.a; const char* cB = cur.b;
    PG8_STAGE(PG8_SB(0, 0), cB, voffB); PG8_STAGE(PG8_SB(0, 1), cB + hstep, voffB); PG8_STAGE(PG8_SA(0, 0), cA, cO[0]); PG8_STAGE(PG8_SA(0, 1), cA, cO[1]);
    if (wr == 1) PG8_BAR;
    PG8_WAIT_V(2); PG8_BAR;
    PG8_STAGE(PG8_SB(1, 0), cB + kstep, voffB); PG8_STAGE(PG8_SA(1, 0), cA + kstep, cO[0]); PG8_STAGE(PG8_SB(1, 1), cB + hstep + kstep, voffB);
    PG8_WAIT_V(6); PG8_BAR;
    for (;;) {
        const bool has_next = S.next(ui + 1, nxt);
        if (has_next) { PG8_AOFF(nO, nxt); } else {
#pragma unroll
            for (int h = 0; h < 2; ++h)
#pragma unroll
                for (int i = 0; i < 2; ++i) nO[h][i] = cO[h][i]; }
        const char* nA = has_next ? nxt.a : cA; const char* nB = has_next ? nxt.b : cB;
#pragma unroll 1
        for (int t = 0; t < nt; ++t) {
            const int bb = t & 1;
            const bool l1 = (t + 1 >= nt), last = (t + 2 >= nt);
            const char* a1 = l1 ? nA + (size_t)(t + 1 - nt) * kstep : cA + (size_t)(t + 1) * kstep;
            const char* a2 = last ? nA + (size_t)(t + 2 - nt) * kstep : cA + (size_t)(t + 2) * kstep;
            const char* b2 = last ? nB + (size_t)(t + 2 - nt) * kstep : cB + (size_t)(t + 2) * kstep;
            const int sa = bb * 2 * HTB, sa1 = (bb ^ 1) * 2 * HTB;
            LAS unsigned char* la = lds + sa + aoff; LAS unsigned char* lb = lds + 4 * HTB + sa + boff;
            PG8_LDBX(B0, lb, 0); PG8_LDBX(B1, lb, HTB); PG8_SCHED; PG8_LDAX(At, la, 0);
            { _Pragma("unroll") for (int _i = 0; _i < 2; ++_i) { unsigned _o = l1 ? nO[1][_i] : cO[1][_i]; asm volatile("" : "+v"(_o));
                __builtin_amdgcn_global_load_lds((const unsigned*)(a1 + _o), (LAS unsigned*)(lds + sa1 + HTB + ldsw + _i * 8192), 16, 0, 0); } }
            int sdl = 0;
            if constexpr (Side::ON) { sdl = side.issue(wv); const int w1 = sdl + sdc; if (w1 == 0) PG8_WAIT_V(8); else if (w1 == 4) PG8_WAIT_V(12); else PG8_WAIT_V(16); } else PG8_WAIT_V(8);
            PG8_WAIT_L(0); PG8_BAR; PG8_MMA(0, 0, At, B0); PG8_MMA(0, 1, At, B1); PG8_BAR; PG8_SCHED;
            PG8_LDAX(At, la, HTB);
            PG8_STAGE(4 * HTB + sa, b2, voffB); PG8_STAGE(4 * HTB + sa + HTB, b2 + hstep, voffB); PG8_STAGE2(sa, a2, cO[0], nO[0]);
            if constexpr (Side::ON) { if (sdl == 0) PG8_WAIT_V(8); else PG8_WAIT_V(12); } else PG8_WAIT_V(8);
            PG8_WAIT_L(0); PG8_BAR; PG8_MMA(1, 0, At, B0); PG8_MMA(1, 1, At, B1);
            if constexpr (Side::ON) { sdc = side.template finish<1>(wv); }
            PG8_BAR; PG8_SCHED;
        }
        if (wr == 0) PG8_BAR;
        if constexpr (!Epi::AFTER_DRAIN) { const int _t = ltid(wv), _l = _t & 63, _w = __builtin_amdgcn_readfirstlane(_t >> 6); E(acc, cur, _w >> 2, _w & 3, _l & 15, _l >> 4); }
        if (!has_next) break;
#pragma unroll
        for (int a = 0; a < 2; ++a)
#pragma unroll
            for (int b = 0; b < 2; ++b)
#pragma unroll
                for (int m = 0; m < 4; ++m)
#pragma unroll
                    for (int n = 0; n < 2; ++n) acc[a][b][m][n] = (f32x4){0.f, 0.f, 0.f, 0.f};
        cur = nxt; cA = nA; cB = nB; ++ui;
#pragma unroll
        for (int h = 0; h < 2; ++h)
#pragma unroll
            for (int i = 0; i < 2; ++i) cO[h][i] = nO[h][i];
        if (wr == 1) PG8_BAR;
    }
    PG8_WAIT_V(0);
    PG8_BAR;
    if constexpr (Epi::AFTER_DRAIN) E.fused(acc, cur, lds, wv);
#undef PG8_SA
#undef PG8_SB
#undef PG8_STAGE
#undef PG8_STAGE2
#undef PG8_LDA
#undef PG8_LDAX
#undef PG8_LDBX
#undef PG8_LDB
#undef PG8_MMA
#undef PG8_WAIT_V
#undef PG8_WAIT_L
#undef PG8_BAR
#undef PG8_SCHED
#undef PG8_AOFF
}
template <bool FP8, class Epi, class Sched>
__device__ __forceinline__ void gemm_phase(LAS unsigned char* lds, const int K, const Sched& S, const Epi& E, const int wv) { NoSide ns; gemm_phase<FP8>(lds, K, S, E, wv, ns); }
}

struct SchedMoe1 {
    const char* X; const int* erow; const char* W; int G, c, lrow0;
    __device__ __forceinline__ bool next(int i, pg8::Unit& u) const {
        const int L = i * G + c; if (L >= 2816) return false;
        const int x = L & 7, uu = L >> 3, el = uu / 176, w = uu % 176, e = 2 * x + el;
        u.pm = e * 8 + (w & 7); u.pn = w >> 3; u.aux = e; u.lrows = lrow0 >= 0 ? lrow0 + (el * 2048 + (w & 7) * 256) * 4 : -1;
        u.a = X; u.arows = erow + u.pm * 256; u.b = W + (size_t)(e * 22 + u.pn) * 256 * D;
        return true;
    }
};
struct EpiSwiGLU {
    static constexpr bool PERM = true, AFTER_DRAIN = false;
    fp8_t* H; unsigned wscale0, wscale1;
    __device__ __forceinline__ void operator()(const f32x4 (&acc)[2][2][4][2], const pg8::Unit& u, int wr, int wc, int fr, int fq) const {
        const int row0 = u.pm * 256 + wr * 64 + fr, col0 = u.pn * 128 + wc * 32 + 8 * fq;
#pragma unroll
        for (int ai = 0; ai < 2; ++ai)
#pragma unroll
            for (int m = 0; m < 4; ++m) {
                const f32x4 g0 = acc[ai][0][m][0], g1 = acc[ai][0][m][1], u0 = acc[ai][1][m][0], u1 = acc[ai][1][m][1];
                u32x2 w;
                w.x = pk4_fp8(fast_silu(g0[0]) * u0[0], fast_silu(g0[1]) * u0[1], fast_silu(g0[2]) * u0[2], fast_silu(g0[3]) * u0[3]);
                w.y = pk4_fp8(fast_silu(g1[0]) * u1[0], fast_silu(g1[1]) * u1[1], fast_silu(g1[2]) * u1[2], fast_silu(g1[3]) * u1[3]);
                *(u32x2*)(H + (size_t)(row0 + ai * 128 + m * 16) * FF + col0) = w;
            }
    }
};
struct SchedMoe2 {
    const char* H; const char* W; int G, c;
    __device__ __forceinline__ bool next(int i, pg8::Unit& u) const {
        const int L = i * G + c; if (L >= 512) return false;
        const int x = L & 7, uu = L >> 3, el = uu >> 5, w = uu & 31, e = 2 * x + el;
        u.pm = e * 8 + (w & 7); u.pn = w >> 3; u.aux = e; u.lrows = -1;
        u.a = H + (size_t)u.pm * 256 * FF; u.arows = nullptr; u.b = W + (size_t)(e * 4 + u.pn) * 256 * FF;
        return true;
    }
};
struct EpiDownBf16 {
    static constexpr bool PERM = true, AFTER_DRAIN = false;
    bf16_t* Y; const float* gate; unsigned wscale0, wscale1;
    __device__ __forceinline__ void operator()(const f32x4 (&acc)[2][2][4][2], const pg8::Unit& u, int wr, int wc, int fr, int fq) const {
        const int row0 = u.pm * 256 + wr * 64 + fr, col0 = u.pn * 256 + wc * 32 + 8 * fq;
#pragma unroll
        for (int ai = 0; ai < 2; ++ai)
#pragma unroll
            for (int m = 0; m < 4; ++m) {
                const int r = row0 + ai * 128 + m * 16; const float g = gate[r];
#pragma unroll
                for (int bj = 0; bj < 2; ++bj) {
                    const f32x4 v0 = acc[ai][bj][m][0] * g, v1 = acc[ai][bj][m][1] * g;
                    u32x4 w; w.x = cvt_pk_bf16(v0[0], v0[1]); w.y = cvt_pk_bf16(v0[2], v0[3]); w.z = cvt_pk_bf16(v1[0], v1[1]); w.w = cvt_pk_bf16(v1[2], v1[3]);
                    *(u32x4*)(Y + (size_t)r * D + col0 + bj * 128) = w;
                }
            }
    }
};

template <class RowMap>
__device__ __forceinline__ void cvt_item(const float* W, int N, bf16_t* WT, int ldt, int kb, int nb, int lane, const RowMap& rm) {
    const int k0 = 64 * kb, n0 = 32 * nb, nq = lane & 7, kg = lane >> 3; const int n = n0 + 4 * nq; const bool ok = n < N;
    f32x4 v[8];
#pragma unroll
    for (int i = 0; i < 8; ++i) v[i] = ok ? ntl((const f32x4*)(W + (size_t)(k0 + 8 * kg + i) * N + n)) : (f32x4){0.f, 0.f, 0.f, 0.f};
#pragma unroll
    for (int j = 0; j < 4; ++j) { const int dr = rm(n + j);
        u32x4 o; o.x = pk2(v[0][j], v[1][j]); o.y = pk2(v[2][j], v[3][j]); o.z = pk2(v[4][j], v[5][j]); o.w = pk2(v[6][j], v[7][j]);
        if (dr >= 0) *(u32x4*)(WT + (size_t)dr * ldt + k0 + 8 * kg) = o; }
}
struct RmGateUp { int base; __device__ __forceinline__ int operator()(int n) const { return base + (n >> 7) * 256 + (n & 127); } };
struct RmLin { int base; __device__ __forceinline__ int operator()(int n) const { return base + n; } };

struct FastP {
    const float *w_gate, *w_up, *w_down; const float* gate; const int* erow; float* wsc;
    fp8_t *WguT, *WdT, *H2, *Hb; bf16_t* Ys;
};

struct CvtSrc { const float* W; int N; fp8_t* WT; int ldt; int rbase; int gu; float sc; int k0, n0; };
__device__ __forceinline__ void cvt_fp8_load(const CvtSrc& c, int lane, f32x4 (&v)[16]) {
    const int nq = lane & 7, kg = lane >> 3;
#pragma unroll
    for (int i = 0; i < 16; ++i) v[i] = ntl((const f32x4*)(c.W + (size_t)(c.k0 + 16 * kg + i) * c.N + c.n0 + 4 * nq));
}
__device__ __forceinline__ void cvt_fp8_store(const CvtSrc& c, int lane, const f32x4 (&v)[16]) {
    const int nq = lane & 7, kg = lane >> 3; const float sc = c.sc;
    const int n = c.n0 + 4 * nq; const int dr = c.gu ? c.rbase + (n >> 7) * 256 + (n & 127) : c.rbase + n;
    fp8_t* dst = c.WT + (size_t)dr * c.ldt + c.k0 + 16 * kg;
#pragma unroll
    for (int j = 0; j < 4; ++j) { u32x4 o;
        o.x = pk4_fp8(v[0][j] * sc, v[1][j] * sc, v[2][j] * sc, v[3][j] * sc); o.y = pk4_fp8(v[4][j] * sc, v[5][j] * sc, v[6][j] * sc, v[7][j] * sc);
        o.z = pk4_fp8(v[8][j] * sc, v[9][j] * sc, v[10][j] * sc, v[11][j] * sc); o.w = pk4_fp8(v[12][j] * sc, v[13][j] * sc, v[14][j] * sc, v[15][j] * sc);
        nts(o, (u32x4*)(dst + (size_t)j * c.ldt)); }
}
__device__ __forceinline__ float calib_scale(const float* W, LAS float* red, int tid) {
    float mx = 0.f;
#pragma unroll
    for (int i = 0; i < 8; ++i) { const f32x4 v = ((const f32x4*)W)[tid + NTHR * i]; mx = fmaxf(mx, fmaxf(fmaxf(fabsf(v[0]), fabsf(v[1])), fmaxf(fabsf(v[2]), fabsf(v[3])))); }
#pragma unroll
    for (int o = 1; o < 64; o <<= 1) mx = fmaxf(mx, __shfl_xor(mx, o));
    __syncthreads();
    if ((tid & 63) == 0) red[tid >> 6] = mx;
    __syncthreads();
    mx = fmaxf(fmaxf(fmaxf(red[0], red[1]), fmaxf(red[2], red[3])), fmaxf(fmaxf(red[4], red[5]), fmaxf(red[6], red[7])));
    __syncthreads();
    float e = rintf(log2f(32.f / fmaxf(mx, 1e-30f))); e = fminf(fmaxf(e, -40.f), 40.f);
    return exp2f(e);
}
__device__ __forceinline__ void phase_convert_moe(const FastP& p, LAS unsigned char* lds, int i0, int i1, int bw, int nbw, int wid) {
    const int tid = ltid(wid); const int wave = __builtin_amdgcn_readfirstlane(tid >> 6), lane = tid & 63;
    const float sg = calib_scale(p.w_gate, (LAS float*)lds, tid), su = calib_scale(p.w_up, (LAS float*)lds, tid), sd = calib_scale(p.w_down, (LAS float*)lds, tid);
    if (i0 == 0 && bw == 0 && tid == 0) { p.wsc[0] = sg; p.wsc[1] = su; p.wsc[2] = sd; p.wsc[4] = 1.f / sg; p.wsc[5] = 1.f / su; p.wsc[6] = 1.f / sd; }
    const int gw = i0 + bw * 8 + wave, NGW = nbw * 8; const int NIT = i1;
    constexpr int IGU = 8 * 88, ID = 22 * 32;
#define CVT_DESC(it_, c_) do { const int e_ = (it_) / (2 * IGU + ID); int r_ = (it_) % (2 * IGU + ID); \
        if (r_ < IGU) { c_.W = p.w_gate + (size_t)e_ * D * FF; c_.N = FF; c_.WT = p.WguT; c_.ldt = D; c_.rbase = e_ * 5632; c_.gu = 1; c_.sc = sg; c_.k0 = 128 * (r_ / 88); c_.n0 = 32 * (r_ % 88); } \
        else if (r_ < 2 * IGU) { r_ -= IGU; c_.W = p.w_up + (size_t)e_ * D * FF; c_.N = FF; c_.WT = p.WguT; c_.ldt = D; c_.rbase = e_ * 5632 + 128; c_.gu = 1; c_.sc = su; c_.k0 = 128 * (r_ / 88); c_.n0 = 32 * (r_ % 88); } \
        else { r_ -= 2 * IGU; c_.W = p.w_down + (size_t)e_ * FF * D; c_.N = D; c_.WT = p.WdT; c_.ldt = FF; c_.rbase = e_ * D; c_.gu = 0; c_.sc = sd; c_.k0 = 128 * (r_ / 32); c_.n0 = 32 * (r_ % 32); } } while (0)
    CvtSrc cur, nxt; f32x4 va[16], vb[16];
    if (gw < NIT) { CVT_DESC(gw, cur); cvt_fp8_load(cur, lane, va); }
    for (int it = gw; it < NIT; it += 2 * NGW) {
        const bool h1 = it + NGW < NIT, h2 = it + 2 * NGW < NIT;
        if (h1) { CVT_DESC(it + NGW, nxt); cvt_fp8_load(nxt, lane, vb); }
        cvt_fp8_store(cur, lane, va);
        if (h2) { CVT_DESC(it + 2 * NGW, cur); cvt_fp8_load(cur, lane, va); }
        if (h1) cvt_fp8_store(nxt, lane, vb);
    }
#undef CVT_DESC
}
struct CvtSide {
    static constexpr bool ON = true;
    const float *wg, *wu, *wd; fp8_t *WguT, *WdT; float sg, su, sd;
    int it, iend, istep, q, pend, tc, skip;
    const float* Wp; fp8_t* Tp; int N, ldt; float sc;
    f32x4 cv[4]; u32x4 co[4];
    __device__ __forceinline__ void desc() {
        constexpr int IGU = 8 * 88, ID = 22 * 32;
        const int e = it / (2 * IGU + ID); int r = it % (2 * IGU + ID);
        if (r < 2 * IGU) { const int up = r >= IGU; r -= up * IGU; const int k0 = 128 * (r / 88), n0 = 32 * (r % 88);
            Wp = (up ? wu : wg) + (size_t)e * D * FF + (size_t)k0 * FF + n0; N = FF; ldt = D; sc = up ? su : sg;
            Tp = WguT + (size_t)(e * 5632 + up * 128 + (n0 >> 7) * 256 + (n0 & 127)) * D + k0; }
        else { r -= 2 * IGU; const int k0 = 128 * (r / 32), n0 = 32 * (r % 32);
            Wp = wd + (size_t)e * FF * D + (size_t)k0 * D + n0; N = D; ldt = FF; sc = sd;
            Tp = WdT + (size_t)(e * D + n0) * FF + k0; }
    }
    __device__ __forceinline__ void init(const FastP& p, float sg_, float su_, float sd_, int first, int step_, int end_) {
        wg = p.w_gate; wu = p.w_up; wd = p.w_down; WguT = p.WguT; WdT = p.WdT; sg = sg_; su = su_; sd = sd_;
        it = first; istep = step_; iend = end_; q = 0; pend = 0; tc = 0; skip = 1; Wp = wg; Tp = WguT; N = FF; ldt = D; sc = sg_;
        if (it < iend) desc();
    }
    __device__ __forceinline__ bool busy() const { return it < iend; }
    __device__ __forceinline__ int issue(const int wv) {
        if (it >= iend) { pend = 0; return 0; }
        if (skip && (++tc & 3) == 0) { pend = 0; return 0; }
        const int lane = ltid(wv) & 63, nq = lane & 7, kg = lane >> 3;
        const unsigned voff = (unsigned)((16 * kg + 4 * q) * N + 4 * nq) * 4u;
#pragma unroll
        for (int i = 0; i < 4; ++i) { const float* b = Wp + (size_t)i * N; asm volatile("global_load_dwordx4 %0, %1, %2 nt" : "=v"(cv[i]) : "v"(voff), "s"(b) : "memory"); }
        pend = 1; return 4;
    }
    template <int INLOOP> __device__ __forceinline__ int finish(const int wv) {
        if (!pend) return 0;
        if constexpr (INLOOP) asm volatile("s_waitcnt vmcnt(6)" : "+v"(cv[0]), "+v"(cv[1]), "+v"(cv[2]), "+v"(cv[3]) :: "memory");
        else asm volatile("s_waitcnt vmcnt(0)" : "+v"(cv[0]), "+v"(cv[1]), "+v"(cv[2]), "+v"(cv[3]) :: "memory");
#pragma unroll
        for (int j = 0; j < 4; ++j) { co[j].x = co[j].y; co[j].y = co[j].z; co[j].z = co[j].w; co[j].w = pk4_fp8(cv[0][j] * sc, cv[1][j] * sc, cv[2][j] * sc, cv[3][j] * sc); }
        pend = 0;
        if (++q < 4) return 0;
        const int lane = ltid(wv) & 63, nq = lane & 7, kg = lane >> 3;
        fp8_t* dst = Tp + (unsigned)(4 * nq * ldt + 16 * kg);
#pragma unroll
        for (int j = 0; j < 4; ++j) nts(co[j], (u32x4*)(dst + (size_t)j * ldt));
        it += istep; q = 0;
        if (it < iend) desc();
        return 4;
    }
};
struct RmWin { __device__ __forceinline__ int operator()(int n) const {
    if (n >= INC || (n >= 2048 && n < 2064)) return -1;
    const int f = n < 2048 ? n : n - 16; const int region = f >> 9, h = (f >> 7) & 3; int o = f & 127;
    if (region == 4 || region == 5) { const int half = o >> 6, oo = o & 63; o = half * 64 + ((oo & 31) << 1) + (oo >> 5); }
    return region * 512 + h * 128 + o; } };
struct FastQ {
    const float *x, *ctx, *c, *c_ctx, *w_ada, *b_ada, *norm1_w, *w_in, *w_out, *mnw, *rnw, *w_router, *norm2_w;
    float *mod, *ropetab, *G, *normw, *wsc2, *biasr; bf16_t* WrT;
    float *_unused0; bf16_t *WinT, *WoutT, *XN, *Pb;
};
__device__ __forceinline__ void phase_mod(const FastQ& p, LAS unsigned char* lds, int bid, int nb, int wid) {
    LAS float* sv = (LAS float*)lds; LAS float* red = sv + 5 * 1024;
    const int tid = ltid(wid);
    for (int i = tid; i < 5 * 1024; i += NTHR) { const int r = i >> 10, k = i & 1023; const float v = r < 4 ? p.c[r * 1024 + k] : p.c_ctx[k]; sv[i] = v / (1.f + expf(-v)); }
    __syncthreads();
    for (int cb = bid; cb < 192; cb += nb) {
        const int cl = tid & 31, kg = tid >> 5, col = cb * 32 + cl;
        float a0 = 0, a1 = 0, a2 = 0, a3 = 0, a4 = 0;
#pragma unroll 32
        for (int kk = 0; kk < 64; ++kk) { const int k = kg * 64 + kk; const float w = ntl(p.w_ada + (size_t)k * 6144 + col); a0 += sv[k] * w; a1 += sv[1024 + k] * w; a2 += sv[2048 + k] * w; a3 += sv[3072 + k] * w; a4 += sv[4096 + k] * w; }
        red[(kg * 5 + 0) * 32 + cl] = a0; red[(kg * 5 + 1) * 32 + cl] = a1; red[(kg * 5 + 2) * 32 + cl] = a2; red[(kg * 5 + 3) * 32 + cl] = a3; red[(kg * 5 + 4) * 32 + cl] = a4;
        __syncthreads();
        if (tid < 160) { const int r = tid >> 5, c2 = tid & 31; float sum = 0.f; for (int g = 0; g < 16; ++g) sum += red[(g * 5 + r) * 32 + c2]; p.mod[r * 6144 + cb * 32 + c2] = sum + p.b_ada[cb * 32 + c2]; }
        __syncthreads();
    }
    for (int i = bid * NTHR + tid; i < 1024; i += nb * NTHR) p.normw[i] = i < 512 ? p.mnw[i] : p.rnw[i - 512];
    for (int i = bid * NTHR + tid; i < 16 * 1024; i += nb * NTHR) { const int e = i >> 10, k = i & 1023; p.WrT[i] = (bf16_t)f2bf(p.w_router[k * 16 + e]); }
    for (int i = bid * NTHR + tid; i < 2048; i += nb * NTHR) { const int pos = i >> 5, f = i & 31; const float ang = (float)pos * powf(10000.f, -(float)f / 32.f); p.ropetab[2 * i] = cosf(ang); p.ropetab[2 * i + 1] = sinf(ang); }
}
__device__ __forceinline__ void phase_convert_small(const FastQ& p, LAS unsigned char* lds, int bid, int nb, int wid) {
    const int tid = ltid(wid); const int wave = __builtin_amdgcn_readfirstlane(tid >> 6), lane = tid & 63;
    const int gw = bid * 8 + wave, NGW = nb * 8;
    constexpr int IIN = 16 * 129, IOUT = 16 * 32;
    for (int it = gw; it < IIN + IOUT; it += NGW) {
        if (it < IIN) cvt_item(p.w_in, INC, p.WinT, D, it / 129, it % 129, lane, RmWin{});
        else { const int r = it - IIN; cvt_item(p.w_out, D, p.WoutT, D, r / 32, r % 32, lane, RmLin{0}); }
    }
}
#define ROWDOT16(g, hh, wr) do { const f32x4 w0 = (wr)[0], w1 = (wr)[1], w2 = (wr)[2], w3 = (wr)[3]; \
    g[0] += hh * w0[0]; g[1] += hh * w0[1]; g[2] += hh * w0[2]; g[3] += hh * w0[3]; g[4] += hh * w1[0]; g[5] += hh * w1[1]; g[6] += hh * w1[2]; g[7] += hh * w1[3]; \
    g[8] += hh * w2[0]; g[9] += hh * w2[1]; g[10] += hh * w2[2]; g[11] += hh * w2[3]; g[12] += hh * w3[0]; g[13] += hh * w3[1]; g[14] += hh * w3[2]; g[15] += hh * w3[3]; } while (0)
__device__ __forceinline__ float reduce16x64(float (&g)[16], int lane) {
#pragma unroll
    for (int j = 0; j < 16; ++j) g[j] += __shfl_xor(g[j], 32);
    float g1[8], g2[4], g3[2];
    { const bool hi = lane & 16;
#pragma unroll
      for (int j = 0; j < 8; ++j) { const float mine = hi ? g[j + 8] : g[j], theirs = hi ? g[j] : g[j + 8]; g1[j] = mine + __shfl_xor(theirs, 16); } }
    { const bool hi = lane & 8;
#pragma unroll
      for (int j = 0; j < 4; ++j) { const float mine = hi ? g1[j + 4] : g1[j], theirs = hi ? g1[j] : g1[j + 4]; g2[j] = mine + __shfl_xor(theirs, 8); } }
    { const bool hi = lane & 4;
#pragma unroll
      for (int j = 0; j < 2; ++j) { const float mine = hi ? g2[j + 2] : g2[j], theirs = hi ? g2[j] : g2[j + 2]; g3[j] = mine + __shfl_xor(theirs, 4); } }
    float r; { const bool hi = lane & 2; const float mine = hi ? g3[1] : g3[0], theirs = hi ? g3[0] : g3[1]; r = mine + __shfl_xor(theirs, 2); }
    r += __shfl_xor(r, 1);
    return r;
}
__device__ __forceinline__ void phase_norm1(const FastQ& p, LAS unsigned char* lds, int bid, int nb, int wid) {
    LAS float* wg = (LAS float*)lds;
    const int tid = ltid(wid), wave = __builtin_amdgcn_readfirstlane(tid >> 6), lane = tid & 63;
#pragma unroll
    for (int i = tid; i < 1024 * 4; i += NTHR) { const int k = i >> 2, j = i & 3; *(LAS f32x4*)(wg + k * 20 + (k >> 4) * 4 + 4 * j) = *(const f32x4*)(p.w_in + (size_t)k * INC + 2048 + 4 * j); }
    __syncthreads();
    if (bid < NB) {
        const float* md = p.mod + bid * 6144;
        for (int k = tid; k < D; k += NTHR) p.wsc2[bid * D + k] = p.norm2_w[k] * (1.f + md[4096 + k]);
        LAS float* part = wg + 1024 * 20 + 512;
        { const int e = tid & 15, kg = tid >> 4; float a = 0.f; for (int k = kg * 32; k < kg * 32 + 32; ++k) a += md[3072 + k] * p.w_router[k * 16 + e]; part[kg * 16 + e] = a; }
        __syncthreads();
        if (tid < 16) { float a = 0.f; for (int g2 = 0; g2 < 32; ++g2) a += part[g2 * 16 + tid]; p.biasr[bid * 16 + tid] = a; }
    }
    const int gw = bid * 8 + wave, NGW = nb * 8;
#define N1_SRC(r_) ((r_) < ML ? p.x + (size_t)(r_) * D : p.ctx + (size_t)((r_) - ML) * D)
    f32x4 nv[4];
    if (gw < MA) { const float* src = N1_SRC(gw) + 16 * lane;
#pragma unroll
        for (int i = 0; i < 4; ++i) nv[i] = ntl((const f32x4*)(src + 4 * i)); }
    for (int row = gw; row < MA; row += NGW) {
        f32x4 v[4];
#pragma unroll
        for (int i = 0; i < 4; ++i) v[i] = nv[i];
        if (row + NGW < MA) { const int lane2 = ltid(wid) & 63; const float* src = N1_SRC(row + NGW) + 16 * lane2;
#pragma unroll
            for (int i = 0; i < 4; ++i) nv[i] = ntl((const f32x4*)(src + 4 * i)); }
        const float* md = p.mod + (row < ML ? (row >> 12) : 4) * 6144 + 16 * lane; const float* nw = p.norm1_w + 16 * lane;
        float ss0 = 0.f;
#pragma unroll
        for (int i = 0; i < 4; ++i) ss0 += (v[i][0] * v[i][0] + v[i][1] * v[i][1]) + (v[i][2] * v[i][2] + v[i][3] * v[i][3]);
#pragma unroll
        for (int o = 1; o < 64; o <<= 1) ss0 += __shfl_xor(ss0, o);
        const float rstd0 = rsqrtf(ss0 * (1.f / D) + EPS);
        float g0[16];
#pragma unroll
        for (int j = 0; j < 16; ++j) g0[j] = 0.f;
        u32x4 pk0[2];
#pragma unroll
        for (int i = 0; i < 4; ++i) {
            asm volatile("" ::: "memory");
            const f32x4 w4 = *(const f32x4*)(nw + 4 * i), s4 = *(const f32x4*)(md + 1024 + 4 * i) + 1.f, h4 = *(const f32x4*)(md + 4 * i);
            const f32x4 ha = v[i] * rstd0 * w4 * s4 + h4;
            pk0[i >> 1][(i & 1) * 2] = cvt_pk_bf16(ha[0], ha[1]); pk0[i >> 1][(i & 1) * 2 + 1] = cvt_pk_bf16(ha[2], ha[3]);
#pragma unroll
            for (int c = 0; c < 4; ++c) { const float x0 = ha[c]; const LAS f32x4* wr = (const LAS f32x4*)(wg + (16 * lane + 4 * i + c) * 20 + lane * 4);
                const f32x4 w0 = wr[0], w1 = wr[1], w2 = wr[2], w3 = wr[3];
                g0[0] += x0 * w0[0]; g0[1] += x0 * w0[1]; g0[2] += x0 * w0[2]; g0[3] += x0 * w0[3]; g0[4] += x0 * w1[0]; g0[5] += x0 * w1[1]; g0[6] += x0 * w1[2]; g0[7] += x0 * w1[3];
                g0[8] += x0 * w2[0]; g0[9] += x0 * w2[1]; g0[10] += x0 * w2[2]; g0[11] += x0 * w2[3]; g0[12] += x0 * w3[0]; g0[13] += x0 * w3[1]; g0[14] += x0 * w3[2]; g0[15] += x0 * w3[3];
                if (c & 1) asm volatile("" ::: "memory"); }
        }
        { u32x4* xo = (u32x4*)(p.XN + (size_t)row * D + 16 * lane); xo[0] = pk0[0]; xo[1] = pk0[1]; }
        const float s0 = reduce16x64(g0, lane);
        if ((lane & 33) == 0) p.G[(size_t)row * 16 + (lane >> 1)] = s0;
    }
#undef N1_SRC
}
struct SchedInProj {
    const char* XN; const char* W; int G, c;
    __device__ __forceinline__ bool next(int i, pg8::Unit& u) const {
        const int L = i * G + c; if (L >= 1056) return false;
        if (L < 1024) { const int x = L & 7, uu = L >> 3; u.pm = 8 * x + (uu & 7); u.pn = uu >> 3; }
        else { const int r = L - 1024; u.pm = 64 + (r & 3); const int q = r >> 2; u.pn = (q < 4 ? 2 : 6) + q; }
        u.aux = 0; u.lrows = -1; u.arows = nullptr;
        u.a = XN + (size_t)u.pm * 256 * (D * 2); u.b = W + (size_t)u.pn * 256 * (D * 2);
        return true;
    }
};
struct EpiInProj {
    static constexpr bool PERM = true, AFTER_DRAIN = false;
    bf16_t* P; const float* tab;
    __device__ __forceinline__ void operator()(const f32x4 (&acc)[2][2][4][2], const pg8::Unit& u, int wr, int wc, int fr, int fq) const {
        const int row0 = u.pm * 256 + wr * 64 + fr, col0 = u.pn * 256 + wc * 32 + 8 * fq;
        const bool kcol = (u.pn == 2 || u.pn == 3 || u.pn == 10 || u.pn == 11);
        const float sc = kcol ? 0.08838834764831845f : 1.f;
        const bool rope = (u.pn >= 8 && u.pn < 12 && u.pm < 64);
        const int fbase = (wc & 1) * 16 + 4 * fq;
#pragma unroll
        for (int ai = 0; ai < 2; ++ai)
#pragma unroll
            for (int m = 0; m < 4; ++m) {
                const int r = row0 + ai * 128 + m * 16;
                f32x4 cs0 = (f32x4){1.f, 0.f, 1.f, 0.f}, cs1 = cs0;
                if (rope) { const int t = r & 4095; const int pos = (wc >> 1) ? (t & 63) : (t >> 6); const f32x4* tp = (const f32x4*)(tab + 2 * (pos * 32 + fbase)); cs0 = tp[0]; cs1 = tp[1]; }
#pragma unroll
                for (int bj = 0; bj < 2; ++bj) {
                    f32x4 v0 = acc[ai][bj][m][0] * sc, v1 = acc[ai][bj][m][1] * sc;
                    if (rope) {
                        const f32x4 a = v0, b = v1;
                        v0[0] = a[0] * cs0[0] - a[1] * cs0[1]; v0[1] = a[0] * cs0[1] + a[1] * cs0[0]; v0[2] = a[2] * cs0[2] - a[3] * cs0[3]; v0[3] = a[2] * cs0[3] + a[3] * cs0[2];
                        v1[0] = b[0] * cs1[0] - b[1] * cs1[1]; v1[1] = b[0] * cs1[1] + b[1] * cs1[0]; v1[2] = b[2] * cs1[2] - b[3] * cs1[3]; v1[3] = b[2] * cs1[3] + b[3] * cs1[2];
                    }
                    u32x4 w; w.x = cvt_pk_bf16(v0[0], v0[1]); w.y = cvt_pk_bf16(v0[2], v0[3]); w.z = cvt_pk_bf16(v1[0], v1[1]); w.w = cvt_pk_bf16(v1[2], v1[3]);
                    *(u32x4*)(P + (size_t)r * PBC + col0 + bj * 128) = w;
                }
            }
    }
};

typedef short s16x4 __attribute__((ext_vector_type(4)));
constexpr int NCH = 34;
constexpr int RS_QK = 272, RS_V = 304;
struct MixP {
    const bf16_t* Pb; const float* G; const float* gate_bias; const float* decay_logit; const float* normw;
    bf16_t* ST; float* NV; float* SC; bf16_t* YM;
};
__device__ __forceinline__ size_t mix_row(int b, int ch, int p) { return ch < 32 ? (size_t)b * T + ch * 128 + p : (size_t)ML + b * TC + (ch - 32) * 128 + p; }
__device__ __forceinline__ bf16x8 tr_frag(const LAS unsigned char* pl, int rs) {
    const s16x4 lo = __builtin_amdgcn_ds_read_tr16_b64_v4i16((LAS s16x4*)(pl));
    const s16x4 hi = __builtin_amdgcn_ds_read_tr16_b64_v4i16((LAS s16x4*)(pl + 4 * rs));
    return __builtin_shufflevector(lo, hi, 0, 1, 2, 3, 4, 5, 6, 7);
}
__device__ __forceinline__ void stage128(LAS unsigned char* dst, int rs, const bf16_t* src, size_t gstride, int wid) {
    const int t = ltid(wid), r = t >> 2;
#pragma unroll
    for (int j = 0; j < 4; ++j) { const int c = (j * 4 + (t & 3)) * 8; const u32x4 v = *(const u32x4*)(src + (size_t)r * gstride + c); *(LAS u32x4*)(dst + r * rs + c * 2) = v; }
}
template <int OP> __device__ __forceinline__ float scan_fb(float x, int tid, LAS float* tot) {
    const int lane = tid & 63, w = tid >> 6;
    if (w < 2) {
#pragma unroll
        for (int o = 1; o < 64; o <<= 1) { const float t = __shfl_up(x, o); if (lane >= o) x = OP ? fmaxf(x, t) : x + t; }
    } else if (w < 4) {
#pragma unroll
        for (int o = 1; o < 64; o <<= 1) { const float t = __shfl_down(x, o); if (lane + o < 64) x = OP ? fmaxf(x, t) : x + t; }
    }
    if (tid == 63) tot[0] = x;
    if (tid == 192) tot[1] = x;
    __syncthreads();
    if (w == 1) x = OP ? fmaxf(x, tot[0]) : x + tot[0];
    if (w == 2) x = OP ? fmaxf(x, tot[1]) : x + tot[1];
    __syncthreads();
    return x;
}
__device__ __forceinline__ void gate_load(const MixP& p, int kind, int b, int h, int ch, int tid, float& ig, float& lf) {
    ig = 0.f; lf = 0.f;
    if (tid < 256) {
        const int pq = tid & 127, dirb = tid >> 7;
        if (kind == 0) { const float* g = p.G + mix_row(b, ch, pq) * 16; ig = g[dirb * 4 + h] + p.gate_bias[dirb * 4 + h]; lf = g[8 + dirb * 4 + h] + p.gate_bias[8 + dirb * 4 + h]; }
        else lf = p.decay_logit[dirb * 4 + h];
    }
}
__device__ __forceinline__ void gate_scan(float ig, float lfraw, int tid, LAS float* tot, float& bb, float& aa, float& cm) {
    const float lf = tid < 256 ? logsigmoidf_(lfraw) : 0.f;
    bb = scan_fb<0>(lf, tid, tot);
    aa = ig - bb;
    cm = scan_fb<1>(aa, tid, tot);
}

__device__ __forceinline__ void phase_mixA(const MixP& p, LAS unsigned char* lds, int bid, int nb, int wid) {
    LAS unsigned char* Kimg = lds; LAS unsigned char* VF = lds + 34816; LAS unsigned char* VB = VF + 38912;
    LAS float* arr = (LAS float*)(VB + 38912);
    LAS float *wF = arr, *wB = arr + 128, *tot = arr + 256, *amx = arr + 260;
    const int tid = ltid(wid), wave = __builtin_amdgcn_readfirstlane(tid >> 6), lane = tid & 63, g = lane >> 4, i16 = lane & 15, q = i16 >> 2, pp = i16 & 3;
    const int r = tid >> 2; constexpr int NTILE = 2 * 16 * NCH;
    u32x4 kv[4], vv[4]; float ig = 0.f, lfr = 0.f;
#define MIXA_LOAD(tile_, KV, VV, IG, LF) do { const int ch_ = (tile_) % NCH, h_ = ((tile_) / NCH) & 3, b_ = ((tile_) / (NCH * 4)) & 3, kind_ = (tile_) / (NCH * 16); const size_t row0_ = mix_row(b_, ch_, 0); \
        const bf16_t* ksrc = p.Pb + (row0_ + r) * PBC + (kind_ ? PB_RK : PB_MK) + h_ * 128; const bf16_t* vsrc = p.Pb + (row0_ + r) * PBC + (kind_ ? PB_RV : PB_MV) + h_ * 128; \
        _Pragma("unroll") for (int j = 0; j < 4; ++j) { const int c = (j * 4 + (tid & 3)) * 8; KV[j] = *(const u32x4*)(ksrc + c); VV[j] = *(const u32x4*)(vsrc + c); } \
        gate_load(p, kind_, b_, h_, ch_, tid, IG, LF); } while (0)
    if (bid < NTILE) MIXA_LOAD(bid, kv, vv, ig, lfr);
    for (int tile = bid; tile < NTILE; tile += nb) {
        u32x4 kv2[4], vv2[4]; float ig2 = 0.f, lfr2 = 0.f;
        if (tile + nb < NTILE) MIXA_LOAD(tile + nb, kv2, vv2, ig2, lfr2);
        else {
#pragma unroll
            for (int j = 0; j < 4; ++j) { kv2[j] = kv[j]; vv2[j] = vv[j]; } }
        float bb, aa, cm; gate_scan(ig, lfr, tid, tot, bb, aa, cm);
        if (tid == 127) { amx[0] = cm; float* sc = p.SC + ((size_t)tile * 2 + 0) * 4; sc[0] = bb; sc[1] = cm; }
        if (tid == 128) { amx[1] = cm; float* sc = p.SC + ((size_t)tile * 2 + 1) * 4; sc[0] = bb; sc[1] = cm; }
        __syncthreads();
        if (tid < 256) (tid < 128 ? wF : wB)[tid & 127] = __expf(aa - amx[tid >> 7]);
#pragma unroll
        for (int j = 0; j < 4; ++j) { const int c = (j * 4 + (tid & 3)) * 8; *(LAS u32x4*)(Kimg + r * RS_QK + c * 2) = kv[j]; }
        __syncthreads();
        {
            const float wf = wF[r], wb = wB[r];
#pragma unroll
            for (int j = 0; j < 4; ++j) { const int c = (j * 4 + (tid & 3)) * 8; const u32x4 v = vv[j]; u32x4 of, ob;
#pragma unroll
                for (int e = 0; e < 4; ++e) { const float lo = __uint_as_float(v[e] << 16), hi = __uint_as_float(v[e] & 0xffff0000u); of[e] = cvt_pk_bf16(lo * wf, hi * wf); ob[e] = cvt_pk_bf16(lo * wb, hi * wb); }
                *(LAS u32x4*)(VF + r * RS_V + c * 2) = of; *(LAS u32x4*)(VB + r * RS_V + c * 2) = ob; }
            if (tid < 256) { const int rr = tid & 127; LAS unsigned char* V = tid < 128 ? VF : VB; const float w = (tid < 128 ? wF : wB)[rr];
                *(LAS u32x4*)(V + rr * RS_V + 256) = (u32x4){f2bf(w), 0u, 0u, 0u}; *(LAS u32x4*)(V + rr * RS_V + 272) = (u32x4){0u, 0u, 0u, 0u}; }
        }
        __syncthreads();
        const int dir = wave >> 2, kb = wave & 3; const LAS unsigned char* V = dir ? VB : VF;
        f32x4 acc[2][9];
#pragma unroll
        for (int mi = 0; mi < 2; ++mi)
#pragma unroll
            for (int ni = 0; ni < 9; ++ni) acc[mi][ni] = (f32x4){0.f, 0.f, 0.f, 0.f};
#pragma unroll
        for (int ks = 0; ks < 4; ++ks) {
            const int srow = 32 * ks + 8 * g + q;
            bf16x8 a[2];
#pragma unroll
            for (int mi = 0; mi < 2; ++mi) a[mi] = tr_frag(Kimg + srow * RS_QK + (32 * kb + 16 * mi + 4 * pp) * 2, RS_QK);
#pragma unroll
            for (int ni = 0; ni < 9; ++ni) { const bf16x8 bv = tr_frag(V + srow * RS_V + (16 * ni + 4 * pp) * 2, RS_V);
#pragma unroll
                for (int mi = 0; mi < 2; ++mi) acc[mi][ni] = __builtin_amdgcn_mfma_f32_16x16x32_bf16(a[mi], bv, acc[mi][ni], 0, 0, 0); }
        }
        bf16_t* st = p.ST + ((size_t)tile * 2 + dir) * 16384;
#pragma unroll
        for (int mi = 0; mi < 2; ++mi) { const int k0 = 32 * kb + 16 * mi + 4 * g;
#pragma unroll
            for (int ni = 0; ni < 8; ++ni) { const f32x4 v = acc[mi][ni]; u32x2 o; o.x = pk2(v[0], v[1]); o.y = pk2(v[2], v[3]); *(u32x2*)(st + (size_t)(16 * ni + i16) * 128 + k0) = o; }
            if (i16 == 0) *(f32x4*)(p.NV + ((size_t)tile * 2 + dir) * 128 + k0) = acc[mi][8]; }
#pragma unroll
        for (int j = 0; j < 4; ++j) { kv[j] = kv2[j]; vv[j] = vv2[j]; }
        ig = ig2; lfr = lfr2;
        __syncthreads();
    }
#undef MIXA_LOAD
}

__device__ __forceinline__ void phase_mixB(const MixP& p, int bid, int nb, int wid) {
    for (int w = bid * NTHR + ltid(wid); w < 64 * 2048; w += nb * NTHR) {
        const int combo = w >> 11, e = w & 2047, v = e >> 4, k0 = (e & 15) * 8;
        const int dir = combo & 1, h = (combo >> 1) & 3, b = (combo >> 3) & 3, kind = combo >> 5;
        const int tb = ((kind * 4 + b) * 4 + h) * NCH;
        float C[8], n[8];
#pragma unroll
        for (int j = 0; j < 8; ++j) { C[j] = 0.f; n[j] = 0.f; }
        float m = 0.f;
#pragma unroll 1
        for (int jb = 0; jb < NCH; jb += 17) {
            u32x4 U[17];
#pragma unroll
            for (int jj = 0; jj < 17; ++jj) { const int j = jb + jj; const int ch = dir ? 33 - j : (j < 2 ? 32 + j : j - 2); U[jj] = ntl((const u32x4*)(p.ST + ((size_t)(tb + ch) * 2 + dir) * 16384 + v * 128 + k0)); }
#pragma unroll
            for (int jj = 0; jj < 17; ++jj) {
                const int j = jb + jj; const int ch = dir ? 33 - j : (j < 2 ? 32 + j : j - 2);
                const size_t td = (size_t)(tb + ch) * 2 + dir;
                float* sc = p.SC + td * 4; const float bL = sc[0], amax = sc[1];
                float mn, alpha, beta;
                if (kind == 0) { mn = fmaxf(bL + m, bL + amax); alpha = expf(bL + m - mn); beta = expf(bL + amax - mn); } else { mn = 0.f; alpha = expf(bL); beta = expf(bL + amax); }
                u32x4 o; o.x = pk2(C[0], C[1]); o.y = pk2(C[2], C[3]); o.z = pk2(C[4], C[5]); o.w = pk2(C[6], C[7]);
                *(u32x4*)(p.ST + td * 16384 + v * 128 + k0) = o;
                if (e == 0) sc[2] = m;
#pragma unroll
                for (int q = 0; q < 4; ++q) { C[2 * q] = alpha * C[2 * q] + beta * __uint_as_float(U[jj][q] << 16); C[2 * q + 1] = alpha * C[2 * q + 1] + beta * __uint_as_float(U[jj][q] & 0xffff0000u); }
                if (v == 0) { float* nv = p.NV + td * 128 + k0; const f32x4 n0 = *(const f32x4*)nv, n1 = *(const f32x4*)(nv + 4);
                    *(f32x4*)nv = (f32x4){n[0], n[1], n[2], n[3]}; *(f32x4*)(nv + 4) = (f32x4){n[4], n[5], n[6], n[7]};
#pragma unroll
                    for (int q = 0; q < 4; ++q) { n[q] = alpha * n[q] + beta * n0[q]; n[4 + q] = alpha * n[4 + q] + beta * n1[q]; } }
                m = mn;
            }
        }
    }
}

__device__ __forceinline__ void phase_mixC(const MixP& p, LAS unsigned char* lds, int bid, int nb, int wid) {
    LAS unsigned char* Kimg = lds; LAS unsigned char* Vimg = lds + 34816; LAS unsigned char* CF = lds + 73728; LAS unsigned char* CB = lds + 112896;
    LAS float* Himg = (LAS float*)CF;
    LAS float* arr = (LAS float*)(lds + 152064);
    LAS float *aF = arr, *aB = arr + 128, *bF = arr + 256, *bB = arr + 384, *MF = arr + 512, *MB = arr + 640, *tot = arr + 768;
    int tid = ltid(wid); int sr = tid >> 2;
    u32x4 rk[4], rv[4]; float nf = 0.f, nbv = 0.f, ig = 0.f, lfr = 0.f, minF = 0.f, minB = 0.f;
#define MIXC_LOAD(tile_) do { const int ch_ = (tile_) & 31, h_ = ((tile_) >> 5) & 3, b_ = ((tile_) >> 7) & 3, kind_ = (tile_) >> 9; const int tA_ = ((kind_ * 4 + b_) * 4 + h_) * NCH + ch_; \
        const bf16_t* pr_ = p.Pb + ((size_t)b_ * T + ch_ * 128 + sr) * PBC + h_ * 128; \
        _Pragma("unroll") for (int j = 0; j < 4; ++j) { const int c = (j * 4 + (tid & 3)) * 8; rk[j] = *(const u32x4*)(pr_ + (kind_ ? PB_RK : PB_MK) + c); rv[j] = *(const u32x4*)(pr_ + (kind_ ? PB_RV : PB_MV) + c); } \
        if (tid < 128) { nf = p.NV[((size_t)tA_ * 2 + 0) * 128 + tid]; nbv = p.NV[((size_t)tA_ * 2 + 1) * 128 + tid]; } \
        gate_load(p, kind_, b_, h_, ch_, tid, ig, lfr); minF = p.SC[((size_t)tA_ * 2 + 0) * 4 + 2]; minB = p.SC[((size_t)tA_ * 2 + 1) * 4 + 2]; } while (0)
    u32x4 rc[8];
#define MIXC_LOADC(tile_) do { const int ch_ = (tile_) & 31, h_ = ((tile_) >> 5) & 3, b_ = ((tile_) >> 7) & 3, kind_ = (tile_) >> 9; const size_t tA_ = (size_t)(((kind_ * 4 + b_) * 4 + h_) * NCH + ch_); \
        const int t_ = ltid(wid); const bf16_t* cs_ = p.ST + tA_ * 2 * 16384 + (size_t)(t_ >> 2) * 128; \
        _Pragma("unroll") for (int j = 0; j < 4; ++j) { const int c = (j * 4 + (t_ & 3)) * 8; rc[j] = *(const u32x4*)(cs_ + c); rc[4 + j] = *(const u32x4*)(cs_ + 16384 + c); } } while (0)
    if (bid < 1024) { MIXC_LOAD(bid); MIXC_LOADC(bid); }
    for (int tile = bid; tile < 2 * 16 * 32; tile += nb) {
        tid = ltid(wid); sr = tid >> 2;
        const int wave = __builtin_amdgcn_readfirstlane(tid >> 6), lane = tid & 63, g = lane >> 4, i16 = lane & 15, q = i16 >> 2, pp = i16 & 3;
        const int ch = tile & 31, h = (tile >> 5) & 3, b = (tile >> 7) & 3, kind = tile >> 9;
        const size_t row0 = (size_t)b * T + ch * 128;
        const bf16_t* prow = p.Pb + row0 * PBC + h * 128;
        bf16x8 aq[4];
        { const bf16_t* qr = prow + (kind ? PB_RQ : PB_MQ) + (size_t)(16 * wave + i16) * PBC + 8 * g;
#pragma unroll
          for (int ks = 0; ks < 4; ++ks) aq[ks] = *(const bf16x8*)(qr + 32 * ks); }
#pragma unroll
        for (int j = 0; j < 4; ++j) { const int cby = (j * 4 + (tid & 3)) * 16; *(LAS u32x4*)(Kimg + sr * RS_QK + cby) = rk[j]; *(LAS u32x4*)(Vimg + sr * RS_V + cby) = rv[j]; }
#pragma unroll
        for (int j = 0; j < 4; ++j) { const int cby = (j * 4 + (tid & 3)) * 16; *(LAS u32x4*)(CF + sr * RS_QK + cby) = rc[j]; *(LAS u32x4*)(CB + sr * RS_QK + cby) = rc[4 + j]; }
        if (tid < 128) { *(LAS u32x4*)(Vimg + tid * RS_V + 256) = (u32x4){0x3F80u, 0u, 0u, 0u}; *(LAS u32x4*)(Vimg + tid * RS_V + 272) = (u32x4){0u, 0u, 0u, 0u};
            ((LAS unsigned short*)(CF + 128 * RS_QK))[tid] = (unsigned short)f2bf(nf); ((LAS unsigned short*)(CB + 128 * RS_QK))[tid] = (unsigned short)f2bf(nbv); }
        for (int z = tid; z < 15 * 68; z += NTHR) { ((LAS unsigned*)(CF + 129 * RS_QK))[z] = 0u; ((LAS unsigned*)(CB + 129 * RS_QK))[z] = 0u; }
        const float cminF = minF, cminB = minB;
        { float bb, aa, cm; gate_scan(ig, lfr, tid, tot, bb, aa, cm);
          if (tid < 256) { const int pq = tid & 127; (tid < 128 ? aF : aB)[pq] = aa; (tid < 128 ? bF : bB)[pq] = bb; (tid < 128 ? MF : MB)[pq] = kind == 0 ? fmaxf(cm, tid < 128 ? cminF : cminB) : -bb; } }
        if (tile + nb < 1024) MIXC_LOAD(tile + nb);
        f32x4 accF[9], accB[9];
#pragma unroll
        for (int ni = 0; ni < 9; ++ni) { accF[ni] = (f32x4){0.f, 0.f, 0.f, 0.f}; accB[ni] = (f32x4){0.f, 0.f, 0.f, 0.f}; }
#pragma unroll
        for (int ks = 0; ks < 4; ++ks) {
#pragma unroll
            for (int ni = 0; ni < 9; ++ni) { const bf16x8 bc = *(const LAS bf16x8*)(CF + (16 * ni + i16) * RS_QK + (32 * ks + 8 * g) * 2); accF[ni] = __builtin_amdgcn_mfma_f32_16x16x32_bf16(aq[ks], bc, accF[ni], 0, 0, 0); }
            asm volatile("" ::: "memory");
#pragma unroll
            for (int ni = 0; ni < 9; ++ni) { const bf16x8 bc = *(const LAS bf16x8*)(CB + (16 * ni + i16) * RS_QK + (32 * ks + 8 * g) * 2); accB[ni] = __builtin_amdgcn_mfma_f32_16x16x32_bf16(aq[ks], bc, accB[ni], 0, 0, 0); }
            asm volatile("" ::: "memory");
        }
        {
            const int tl = 16 * wave + i16;
            const float MtF = MF[tl], MtB = MB[tl];
#pragma unroll
            for (int r = 0; r < 4; ++r) { const int t = 16 * wave + 4 * g + r; const float iwF = __expf(cminF - MF[t]), iwB = __expf(cminB - MB[t]);
#pragma unroll
                for (int ni = 0; ni < 9; ++ni) { accF[ni][r] *= iwF; accB[ni][r] *= iwB; } }
#pragma unroll
            for (int ks = 0; ks < 4; ++ks) {
                u32x4 pF, pB;
#pragma unroll
                for (int hf = 0; hf < 2; ++hf) { const int nj = 2 * ks + hf;
                    f32x4 st = (f32x4){0.f, 0.f, 0.f, 0.f};
#pragma unroll
                    for (int k2 = 0; k2 < 4; ++k2) { const bf16x8 ak = *(const LAS bf16x8*)(Kimg + (16 * nj + i16) * RS_QK + (32 * k2 + 8 * g) * 2); st = __builtin_amdgcn_mfma_f32_16x16x32_bf16(ak, aq[k2], st, 0, 0, 0); }
                    const int s0 = 16 * nj + 4 * g; const f32x4 avF = *(const LAS f32x4*)(aF + s0), avB = *(const LAS f32x4*)(aB + s0); float pf[4], pb[4];
#pragma unroll
                    for (int r = 0; r < 4; ++r) { const int sx = s0 + r; pf[r] = sx <= tl ? st[r] * __expf(avF[r] - MtF) : 0.f; pb[r] = sx >= tl ? st[r] * __expf(avB[r] - MtB) : 0.f; }
                    pF[2 * hf] = cvt_pk_bf16(pf[0], pf[1]); pF[2 * hf + 1] = cvt_pk_bf16(pf[2], pf[3]); pB[2 * hf] = cvt_pk_bf16(pb[0], pb[1]); pB[2 * hf + 1] = cvt_pk_bf16(pb[2], pb[3]); }
                const bf16x8 apF = __builtin_bit_cast(bf16x8, pF), apB = __builtin_bit_cast(bf16x8, pB);
#pragma unroll
                for (int ni = 0; ni < 9; ++ni) { const LAS unsigned char* pl = Vimg + (32 * ks + 4 * g + q) * RS_V + (16 * ni + 4 * pp) * 2;
                    const s16x4 lo = __builtin_amdgcn_ds_read_tr16_b64_v4i16((LAS s16x4*)(pl)), hi = __builtin_amdgcn_ds_read_tr16_b64_v4i16((LAS s16x4*)(pl + 16 * RS_V));
                    const bf16x8 bv = __builtin_bit_cast(bf16x8, __builtin_shufflevector(lo, hi, 0, 1, 2, 3, 4, 5, 6, 7));
                    accF[ni] = __builtin_amdgcn_mfma_f32_16x16x32_bf16(apF, bv, accF[ni], 0, 0, 0); accB[ni] = __builtin_amdgcn_mfma_f32_16x16x32_bf16(apB, bv, accB[ni], 0, 0, 0); }
                asm volatile("" ::: "memory");
            }
            if (kind == 0) {
#pragma unroll
                for (int r = 0; r < 4; ++r) { const int t = 16 * wave + 4 * g + r;
                    const float denF = __shfl(accF[8][r], lane & 48), denB = __shfl(accB[8][r], lane & 48);
                    const float invF = __builtin_amdgcn_rcpf(fmaxf(fabsf(denF), __expf(-(bF[t] + MF[t])))), invB = __builtin_amdgcn_rcpf(fmaxf(fabsf(denB), __expf(-(bB[t] + MB[t]))));
#pragma unroll
                    for (int ni = 0; ni < 8; ++ni) { accF[ni][r] *= invF; accB[ni][r] *= invB; } }
            }
            __syncthreads();
        }
        {
            const int tid2 = ltid(wid); const int t = tid2 >> 2, c0 = (tid2 & 3) * 32; const size_t row = row0 + t;
            const u32x4* og = (const u32x4*)(p.Pb + row * PBC + (kind ? PB_RO : PB_MO) + h * 128 + c0);
            u32x4 ogv[4];
#pragma unroll
            for (int j = 0; j < 4; ++j) ogv[j] = og[j];
            if (tile + nb < 1024) MIXC_LOADC(tile + nb);
#pragma unroll
            for (int r = 0; r < 4; ++r)
#pragma unroll
                for (int ni = 0; ni < 8; ++ni) Himg[(16 * wave + 4 * g + r) * 132 + 16 * ni + i16] = accF[ni][r] + accB[ni][r];
            __syncthreads();
            const LAS f32x4* hr = (const LAS f32x4*)(Himg + t * 132 + c0);
            f32x4 hv[8]; float ss = 0.f;
#pragma unroll
            for (int j = 0; j < 8; ++j) { hv[j] = hr[j]; ss += (hv[j][0] * hv[j][0] + hv[j][1] * hv[j][1]) + (hv[j][2] * hv[j][2] + hv[j][3] * hv[j][3]); }
            ss += __shfl_xor(ss, 1); ss += __shfl_xor(ss, 2);
            const float rn = rsqrtf(ss * (1.f / 128.f) + EPS);
            const f32x4* nw = (const f32x4*)(p.normw + kind * 512 + h * 128 + c0);
            u32x4* yo = (u32x4*)(p.YM + row * D + kind * 512 + h * 128 + c0);
#pragma unroll
            for (int j = 0; j < 4; ++j) { const u32x4 ov = ogv[j]; u32x4 o;
#pragma unroll
                for (int e = 0; e < 4; ++e) { const float o0 = __uint_as_float(ov[e] << 16), o1 = __uint_as_float(ov[e] & 0xffff0000u);
                    const float g0 = kind ? fast_silu(o0) : __builtin_amdgcn_rcpf(1.f + __expf(-o0)), g1 = kind ? fast_silu(o1) : __builtin_amdgcn_rcpf(1.f + __expf(-o1));
                    const int cc = 8 * j + 2 * e; const f32x4 hq = hv[cc >> 2]; const f32x4 wq = nw[cc >> 2];
                    o[e] = cvt_pk_bf16(g0 * hq[cc & 3] * rn * wq[cc & 3], g1 * hq[(cc & 3) + 1] * rn * wq[(cc & 3) + 1]); }
                yo[j] = o; }
        }
        __syncthreads();
    }
#undef MIXC_LOAD
#undef MIXC_LOADC
}
struct TailP {
    const float *x, *mod, *norm2_w, *w_router, *final_w, *wsc2, *biasr; const bf16_t *YM, *WoutT, *Ys, *WrT;
    bf16_t* xl; float *aff, *gate, *out, *xrec; fp8_t* H2; int *idx, *slotmap; unsigned* bar;
};
struct SchedOutProj {
    const char* A; const char* W; int G, c;
    __device__ __forceinline__ bool next(int i, pg8::Unit& u) const {
        const int L = i * G + c; if (L >= 256) return false;
        const int x = L & 7, uu = L >> 3; u.pm = 8 * x + (uu & 7); u.pn = uu >> 3; u.aux = 0; u.lrows = -1; u.arows = nullptr;
        u.a = A + (size_t)u.pm * 256 * (D * 2); u.b = W + (size_t)u.pn * 256 * (D * 2); return true;
    }
};
struct EpiOutProj {
    static constexpr bool PERM = false, AFTER_DRAIN = false;
    const float* x; const float* mod; bf16_t* xl;
    __device__ __forceinline__ void operator()(const f32x4 (&acc)[2][2][4][2], const pg8::Unit& u, int wr, int wc, int fr, int fq) const {
        const int row0 = u.pm * 256 + wr * 64 + fr, col0 = u.pn * 256 + wc * 32 + 4 * fq;
#pragma unroll
        for (int ai = 0; ai < 2; ++ai)
#pragma unroll
            for (int m = 0; m < 4; ++m) { const int r = row0 + ai * 128 + m * 16; const float* g1 = mod + (r >> 12) * 6144 + 2048;
#pragma unroll
                for (int bj = 0; bj < 2; ++bj)
#pragma unroll
                    for (int n = 0; n < 2; ++n) { const int c = col0 + bj * 128 + n * 16; const f32x4 xv = *(const f32x4*)(x + (size_t)r * D + c), gv = *(const f32x4*)(g1 + c);
                        const f32x4 o = xv + gv * acc[ai][bj][m][n]; u32x2 w; w.x = pk2(o[0], o[1]); w.y = pk2(o[2], o[3]); *(u32x2*)(xl + (size_t)r * D + c) = w; } }
    }
};
__device__ __forceinline__ void phase_norm2(const TailP& p, LAS unsigned char* lds, int bid, int nb, int wid) {
    LAS float* wg = (LAS float*)lds;
    const int tid = ltid(wid), wave = __builtin_amdgcn_readfirstlane(tid >> 6), lane = tid & 63;
    for (int i = tid; i < 1024 * 16; i += NTHR) { const int k = i >> 4, j = i & 15; wg[k * 20 + (k >> 4) * 4 + j] = p.w_router[i]; }
    __syncthreads();
    const int gw = bid * 8 + wave, NGW = nb * 8;
    u32x4 nx[2];
    if (gw < ML) {
#pragma unroll
        for (int i = 0; i < 2; ++i) nx[i] = *(const u32x4*)(p.xl + (size_t)gw * D + 16 * lane + 8 * i); }
    for (int row = gw; row < ML; row += NGW) {
        f32x4 v[4];
#pragma unroll
        for (int i = 0; i < 2; ++i) { v[2 * i] = bf4_f32(nx[i].x, nx[i].y); v[2 * i + 1] = bf4_f32(nx[i].z, nx[i].w); }
        { const int r2 = row + NGW; if (r2 < ML) {
#pragma unroll
            for (int i = 0; i < 2; ++i) nx[i] = *(const u32x4*)(p.xl + (size_t)r2 * D + 16 * lane + 8 * i); } }
        const float* md = p.mod + (row >> 12) * 6144 + 16 * lane; const float* nw = p.norm2_w + 16 * lane;
        float ss = 0.f;
#pragma unroll
        for (int i = 0; i < 4; ++i) ss += (v[i][0] * v[i][0] + v[i][1] * v[i][1]) + (v[i][2] * v[i][2] + v[i][3] * v[i][3]);
#pragma unroll
        for (int o = 1; o < 64; o <<= 1) ss += __shfl_xor(ss, o);
        const float rstd = rsqrtf(ss * (1.f / D) + EPS);
        float g[16];
#pragma unroll
        for (int j = 0; j < 16; ++j) g[j] = 0.f;
        u32x4 pk;
#pragma unroll
        for (int i = 0; i < 4; ++i) {
            const f32x4 w4 = *(const f32x4*)(nw + 4 * i), s4 = *(const f32x4*)(md + 4096 + 4 * i), h4 = *(const f32x4*)(md + 3072 + 4 * i);
            const f32x4 hh4 = v[i] * rstd * w4 * (s4 + 1.f) + h4;
            pk[i] = pk4_fp8(hh4[0], hh4[1], hh4[2], hh4[3]);
#pragma unroll
            for (int c = 0; c < 4; ++c) { const float hh = hh4[c]; const LAS f32x4* wr = (const LAS f32x4*)(wg + (16 * lane + 4 * i + c) * 20 + lane * 4); ROWDOT16(g, hh, wr); if (c & 1) asm volatile("" ::: "memory"); }
        }
        *(u32x4*)(p.H2 + (size_t)row * D + 16 * lane) = pk;
        const float lg = reduce16x64(g, lane);
        float mx = lg; mx = fmaxf(mx, __shfl_xor(mx, 2)); mx = fmaxf(mx, __shfl_xor(mx, 4)); mx = fmaxf(mx, __shfl_xor(mx, 8)); mx = fmaxf(mx, __shfl_xor(mx, 16));
        const float ex = expf(lg - mx); float sm = ex; sm += __shfl_xor(sm, 2); sm += __shfl_xor(sm, 4); sm += __shfl_xor(sm, 8); sm += __shfl_xor(sm, 16);
        if ((lane & 33) == 0) p.aff[(size_t)row * 16 + (lane >> 1)] = ex / sm;
    }
}
__device__ __forceinline__ void phase_topk(const TailP& p, LAS unsigned char* lds, int bid, int nb, int wid) {
    LAS unsigned* hist = (LAS unsigned*)lds;
    LAS unsigned* ctl = hist + 256;
    LAS unsigned* wsum = ctl + 8;
    const int tid = ltid(wid), wave = tid >> 6, lane = tid & 63;
    for (int item = bid; item < NB * NE; item += nb) {
        const int b = item >> 4, e = item & 15;
        unsigned key[8];
#pragma unroll
        for (int j = 0; j < 8; ++j) key[j] = __float_as_uint(p.aff[((size_t)b * T + tid * 8 + j) * 16 + e]);
        if (tid == 0) { ctl[0] = 0u; ctl[1] = (unsigned)CAP; }
        unsigned prefix = 0u, krem = CAP;
#pragma unroll 1
        for (int pass = 0; pass < 4; ++pass) {
            const int shift = 24 - 8 * pass;
            if (tid < 256) hist[tid] = 0u;
            __syncthreads();
#pragma unroll
            for (int j = 0; j < 8; ++j) { const bool match = pass == 0 ? true : ((key[j] >> (shift + 8)) == prefix); if (match) atomicAdd((unsigned*)(hist + ((key[j] >> shift) & 255u)), 1u); }
            __syncthreads();
            {
                unsigned mine = 0u, incl = 0u;
                if (tid < 256) { mine = hist[tid]; incl = mine;
#pragma unroll
                    for (int o = 1; o < 64; o <<= 1) { const unsigned t2 = __shfl_down(incl, o); if (lane + o < 64) incl += t2; }
                    if (lane == 0) wsum[wave] = incl; }
                __syncthreads();
                if (tid < 256) { unsigned above = incl - mine; for (int w2 = wave + 1; w2 < 4; ++w2) above += wsum[w2];
                    if (above < krem && krem <= above + mine) { ctl[0] = (prefix << 8) | (unsigned)tid; ctl[1] = krem - above; } }
            }
            __syncthreads();
            prefix = ctl[0]; krem = ctl[1];
            __syncthreads();
        }
        unsigned ng = 0u, ne = 0u;
#pragma unroll
        for (int j = 0; j < 8; ++j) { ng += key[j] > prefix ? 1u : 0u; ne += key[j] == prefix ? 1u : 0u; }
        unsigned sg = ng, se = ne;
#pragma unroll
        for (int o = 1; o < 64; o <<= 1) { const unsigned tg = __shfl_up(sg, o), te = __shfl_up(se, o); if (lane >= o) { sg += tg; se += te; } }
        if (lane == 63) { wsum[wave * 2] = sg; wsum[wave * 2 + 1] = se; }
        __syncthreads();
        unsigned bg = sg - ng, be = se - ne;
        for (int w = 0; w < wave; ++w) { bg += wsum[w * 2]; be += wsum[w * 2 + 1]; }
#pragma unroll
        for (int j = 0; j < 8; ++j) {
            const int t = tid * 8 + j; const bool gr = key[j] > prefix, eq = key[j] == prefix; const bool sel = gr || (eq && be < krem);
            const int cslot = (int)(bg + (be < krem ? be : krem)); const int R = e * 2048 + b * CAP + cslot;
            if (sel) { p.idx[R] = b * T + t; p.gate[R] = __uint_as_float(key[j]); }
            p.slotmap[((size_t)b * T + t) * NE + e] = sel ? R : -1;
            bg += gr ? 1u : 0u; be += eq ? 1u : 0u;
        }
        __syncthreads();
    }
}
__device__ __forceinline__ void phase_final(const TailP& p, int bid, int nb, int wid) {
    const int tid = ltid(wid), wave = __builtin_amdgcn_readfirstlane(tid >> 6), lane = tid & 63;
    const int gw = bid * 8 + wave, NGW = nb * 8;
    int nsm = -1; u32x2 nxv[4];
    if (gw < ML) { nsm = lane < 16 ? p.slotmap[(size_t)gw * NE + lane] : -1;
#pragma unroll
        for (int i = 0; i < 4; ++i) nxv[i] = ntl((const u32x2*)(p.xl + (size_t)gw * D) + lane + 64 * i); }
    for (int row = gw; row < ML; row += NGW) {
        const int sm = nsm; f32x4 xv[4];
#pragma unroll
        for (int i = 0; i < 4; ++i) xv[i] = bf4_f32(nxv[i].x, nxv[i].y);
        { const int r2 = row + NGW; if (r2 < ML) { nsm = lane < 16 ? p.slotmap[(size_t)r2 * NE + lane] : -1;
#pragma unroll
            for (int i = 0; i < 4; ++i) nxv[i] = ntl((const u32x2*)(p.xl + (size_t)r2 * D) + lane + 64 * i); } }
        f32x4 a[4];
#pragma unroll
        for (int i = 0; i < 4; ++i) a[i] = (f32x4){0.f, 0.f, 0.f, 0.f};
#pragma unroll
        for (int e = 0; e < NE; ++e) { const int sl = __builtin_amdgcn_readlane(sm, e);
            if (sl >= 0) { const u32x2* yr = (const u32x2*)(p.Ys + (size_t)sl * D);
#pragma unroll
                for (int i = 0; i < 4; ++i) { const u32x2 w = ntl(yr + lane + 64 * i); a[i][0] += __uint_as_float(w.x << 16); a[i][1] += __uint_as_float(w.x & 0xffff0000u); a[i][2] += __uint_as_float(w.y << 16); a[i][3] += __uint_as_float(w.y & 0xffff0000u); } } }
        const float* g2 = p.mod + (row >> 12) * 6144 + 5120; float ss = 0.f;
#pragma unroll
        for (int i = 0; i < 4; ++i) { const int k = 4 * (lane + 64 * i); const f32x4 gv = *(const f32x4*)(g2 + k); a[i] = xv[i] + gv * a[i];
            ss += (a[i][0] * a[i][0] + a[i][1] * a[i][1]) + (a[i][2] * a[i][2] + a[i][3] * a[i][3]); }
#pragma unroll
        for (int o = 1; o < 64; o <<= 1) ss += __shfl_xor(ss, o);
        const float rstd = rsqrtf(ss * (1.f / D) + EPS);
#pragma unroll
        for (int i = 0; i < 4; ++i) { const int k = 4 * (lane + 64 * i); const f32x4 fw = *(const f32x4*)(p.final_w + k); nts((f32x4)(a[i] * rstd * fw), (f32x4*)(p.out + (size_t)row * D + k)); }
    }
}

#define XB_TMO      128
#define XB_XCNT(j)  (256  + 64 * (j))
#define XB_XSUB(j)  (1280 + 64 * (j))
#define XB_XGEN(j)  (2304 + 64 * (j))
#define XB_TOP      3328
#define XB_TOPGEN   3392
#define XCD_BAR_WORDS 3456
#define XB_SPIN_CAP (1u << 18)
__device__ __forceinline__ unsigned xb_ld(unsigned* p)              { return __hip_atomic_load(p, __ATOMIC_RELAXED, __HIP_MEMORY_SCOPE_AGENT); }
__device__ __forceinline__ unsigned xb_add(unsigned* p, unsigned v) { return __hip_atomic_fetch_add(p, v, __ATOMIC_RELAXED, __HIP_MEMORY_SCOPE_AGENT); }
__device__ __forceinline__ unsigned xb_xcc_id() { return (unsigned)__builtin_amdgcn_s_getreg((3 << 11) | 20) & 0xFu; }
#define XB_SPIN(cond, bar) do { unsigned _sp = 0; while (cond) { __builtin_amdgcn_s_sleep(1); \
    if ((++_sp & 255u) == 0u) { if (xb_ld(&(bar)[XB_TMO])) break; if (_sp > XB_SPIN_CAP) { atomicAdd(&(bar)[XB_TMO], 1u); break; } } } } while (0)
struct XcdBarrier { unsigned* bar; unsigned x; volatile LAS unsigned* st; };
__device__ __forceinline__ XcdBarrier xcd_barrier_post(unsigned* bar, volatile LAS unsigned* st) {
    XcdBarrier b; b.bar = bar; b.x = xb_xcc_id(); b.st = st;
    if (threadIdx.x == 0) (void)xb_add(&bar[XB_XCNT(b.x)], 1u);
    return b;
}
__device__ __forceinline__ void xcd_barrier_complete(unsigned* bar, unsigned x, unsigned& nloc, unsigned& nx) {
    const unsigned G = gridDim.x * gridDim.y * gridDim.z;
    unsigned sum, cnt, mine, sp = 0u;
    for (;;) {
        sum = 0u; cnt = 0u; mine = 0u;
#pragma unroll
        for (unsigned j = 0; j < 16; ++j) { const unsigned c = xb_ld(&bar[XB_XCNT(j)]); sum += c; cnt += (c > 0u) ? 1u : 0u; mine = (j == x) ? c : mine; }
        if (sum == G) break;
        __builtin_amdgcn_s_sleep(1);
        if ((++sp & 255u) == 0u) { if (xb_ld(&bar[XB_TMO])) break; if (sp > XB_SPIN_CAP) { atomicAdd(&bar[XB_TMO], 1u); break; } }
    }
    nloc = mine > 0u ? mine : 1u; nx = cnt > 0u ? cnt : 1u;
}
__device__ __forceinline__ void xcd_barrier(const XcdBarrier& b, const int wid) {
    const bool t0 = (wid == 0) && (__builtin_amdgcn_mbcnt_hi(~0u, __builtin_amdgcn_mbcnt_lo(~0u, 0u)) == 0u);
    asm volatile("s_waitcnt vmcnt(0)" ::: "memory");
    __syncthreads();
    if (t0) {
        unsigned* bar = b.bar;
        __builtin_amdgcn_s_waitcnt(0);
        unsigned nloc = b.st[0], nx = b.st[1];
        if (nloc == 0u) { xcd_barrier_complete(bar, b.x, nloc, nx); b.st[0] = nloc; b.st[1] = nx; }
        const unsigned old = xb_add(&bar[XB_XSUB(b.x)], 1u);
        const unsigned gen = old / nloc;
        if (old + 1u == (gen + 1u) * nloc) {
            __builtin_amdgcn_fence(__ATOMIC_RELEASE, "agent");
            asm volatile("s_waitcnt vmcnt(0)" ::: "memory");
            const unsigned og = xb_add(&bar[XB_TOP], 1u);
            const unsigned tg = og / nx;
            if (og + 1u == (tg + 1u) * nx) xb_add(&bar[XB_TOPGEN], 1u);
            else XB_SPIN(xb_ld(&bar[XB_TOPGEN]) == tg, bar);
            __builtin_amdgcn_fence(__ATOMIC_ACQUIRE, "agent");
            xb_add(&bar[XB_XGEN(b.x)], 1u);
            asm volatile("s_waitcnt vmcnt(0)" ::: "memory");
        } else {
            XB_SPIN(xb_ld(&bar[XB_XGEN(b.x)]) == gen, bar);
            __builtin_amdgcn_fence(__ATOMIC_ACQUIRE, "agent");
            asm volatile("s_waitcnt vmcnt(0)" ::: "memory");
        }
    }
    __syncthreads();
}

__device__ __forceinline__ void group_barrier(unsigned* cnt, unsigned target, unsigned* tmo, const int wid) {
    const bool t0 = (wid == 0) && (__builtin_amdgcn_mbcnt_hi(~0u, __builtin_amdgcn_mbcnt_lo(~0u, 0u)) == 0u);
    asm volatile("s_waitcnt vmcnt(0)" ::: "memory");
    __syncthreads();
    if (t0) {
        __builtin_amdgcn_fence(__ATOMIC_RELEASE, "agent");
        asm volatile("s_waitcnt vmcnt(0)" ::: "memory");
        (void)xb_add(cnt, 1u);
        unsigned sp = 0u;
        while (xb_ld(cnt) < target) { __builtin_amdgcn_s_sleep(1); if ((++sp & 255u) == 0u) { if (xb_ld(tmo)) break; if (sp > XB_SPIN_CAP) { atomicAdd(tmo, 1u); break; } } }
        __builtin_amdgcn_fence(__ATOMIC_ACQUIRE, "agent");
        asm volatile("s_waitcnt vmcnt(0)" ::: "memory");
    }
    __syncthreads();
}

struct EpiOutNorm {
    static constexpr bool PERM = true, AFTER_DRAIN = true;
    const float* x; const float* mod; bf16_t* xl; fp8_t* H2; float* aff; const float* wsc2; const bf16_t* WrT; const float* biasr; float* xrec; unsigned* bar;
    __device__ __forceinline__ void operator()(const f32x4 (&)[2][2][4][2], const pg8::Unit&, int, int, int, int) const {}
    __device__ __forceinline__ void fused(f32x4 (&acc)[2][2][4][2], const pg8::Unit& u, LAS unsigned char* lds, int wv) const {
        const int t = ltid(wv), lane = t & 63, w = __builtin_amdgcn_readfirstlane(t >> 6), wr = w >> 2, wc = w & 3, fr = lane & 15, fq = lane >> 4;
        const int b = u.pm >> 4;
        const int row0 = u.pm * 256 + wr * 64 + fr, colb = u.pn * 256 + wc * 32 + 8 * fq;
        LAS float* SS = (LAS float*)lds;
        LAS float* LG = SS + 1024;
        LAS float* RS = LG + 4 * 256 * 20;
        const rsrc_t rX = __builtin_amdgcn_make_buffer_rsrc((void*)xrec, 0, 0xffffffff, 0x00020000);
        const float* g1p = mod + b * 6144 + 2048; const float* wsp = wsc2 + b * D;
#pragma unroll
        for (int ai = 0; ai < 2; ++ai)
#pragma unroll
            for (int m = 0; m < 4; ++m) {
                const int r = row0 + ai * 128 + m * 16, rl = ai * 128 + wr * 64 + m * 16; float ss = 0.f; f32x4 lg = (f32x4){0.f, 0.f, 0.f, 0.f};
#pragma unroll
                for (int bj = 0; bj < 2; ++bj) { const int c = colb + bj * 128;
                    const f32x4 x0 = *(const f32x4*)(x + (size_t)r * D + c), x1 = *(const f32x4*)(x + (size_t)r * D + c + 4), g0 = *(const f32x4*)(g1p + c), g1v = *(const f32x4*)(g1p + c + 4);
                    const f32x4 v0 = x0 + g0 * acc[ai][bj][m][0], v1 = x1 + g1v * acc[ai][bj][m][1];
                    acc[ai][bj][m][0] = v0; acc[ai][bj][m][1] = v1;
                    ss += (v0[0] * v0[0] + v0[1] * v0[1]) + (v0[2] * v0[2] + v0[3] * v0[3]) + (v1[0] * v1[0] + v1[1] * v1[1]) + (v1[2] * v1[2] + v1[3] * v1[3]);
                    const f32x4 w0 = *(const f32x4*)(wsp + c), w1 = *(const f32x4*)(wsp + c + 4); const f32x4 u0 = v0 * w0, u1 = v1 * w1;
                    u32x4 ap; ap.x = cvt_pk_bf16(u0[0], u0[1]); ap.y = cvt_pk_bf16(u0[2], u0[3]); ap.z = cvt_pk_bf16(u1[0], u1[1]); ap.w = cvt_pk_bf16(u1[2], u1[3]);
                    const bf16x8 bq = *(const bf16x8*)(WrT + (size_t)fr * D + u.pn * 256 + bj * 128 + wc * 32 + 8 * fq);
                    lg = __builtin_amdgcn_mfma_f32_16x16x32_bf16(__builtin_bit_cast(bf16x8, ap), bq, lg, 0, 0, 0); }
                ss += __shfl_xor(ss, 16); ss += __shfl_xor(ss, 32);
                if (fq == 0) SS[(rl + fr) * 4 + wc] = ss;
#pragma unroll
                for (int rg = 0; rg < 4; ++rg) LG[(wc * 256 + rl + 4 * fq + rg) * 20 + fr] = lg[rg];
            }
        __syncthreads();
        if (t < 256) { const f32x4 s4 = *(const LAS f32x4*)(SS + t * 4); const float ssum = (s4[0] + s4[1]) + (s4[2] + s4[3]);
            f32x4 q[4];
#pragma unroll
            for (int j = 0; j < 4; ++j) { const f32x4 a0 = *(const LAS f32x4*)(LG + (0 * 256 + t) * 20 + 4 * j), a1 = *(const LAS f32x4*)(LG + (1 * 256 + t) * 20 + 4 * j),
                                                      a2 = *(const LAS f32x4*)(LG + (2 * 256 + t) * 20 + 4 * j), a3 = *(const LAS f32x4*)(LG + (3 * 256 + t) * 20 + 4 * j); q[j] = (a0 + a1) + (a2 + a3); }
            const int ro = (((u.pm * 256 + t) * 4 + u.pn) * 20) * 4;
#pragma unroll
            for (int j = 0; j < 4; ++j) __builtin_amdgcn_raw_buffer_store_b128(__builtin_bit_cast(u32x4, q[j]), rX, ro + 16 * j, 0, 16);
            __builtin_amdgcn_raw_buffer_store_b128(__builtin_bit_cast(u32x4, (f32x4){ssum, 0.f, 0.f, 0.f}), rX, ro + 64, 0, 16); }
        asm volatile("s_waitcnt vmcnt(0)" ::: "memory");
        __syncthreads();
        const bool t0 = (t == 0);
        unsigned* cnt = bar + 4096 + 64 * u.pm;
        if (t0) (void)xb_add(cnt, 1u);
        {
#pragma unroll
            for (int ai = 0; ai < 2; ++ai)
#pragma unroll
                for (int m = 0; m < 4; ++m) { const int r = row0 + ai * 128 + m * 16;
#pragma unroll
                    for (int bj = 0; bj < 2; ++bj) { const int c = colb + bj * 128; const f32x4 a0 = acc[ai][bj][m][0], a1 = acc[ai][bj][m][1]; u32x4 w; w.x = pk2(a0[0], a0[1]); w.y = pk2(a0[2], a0[3]); w.z = pk2(a1[0], a1[1]); w.w = pk2(a1[2], a1[3]); *(u32x4*)(xl + (size_t)r * D + c) = w; } }
        }
        if (t0) { unsigned sp = 0u; unsigned* tmo = bar + XB_TMO;
            while (xb_ld(cnt) < 4u) { __builtin_amdgcn_s_sleep(1); if ((++sp & 255u) == 0u) { if (xb_ld(tmo)) break; if (sp > XB_SPIN_CAP) { atomicAdd(tmo, 1u); break; } } }
            __builtin_amdgcn_fence(__ATOMIC_ACQUIRE, "agent");
            asm volatile("s_waitcnt vmcnt(0)" ::: "memory"); }
        __syncthreads();
        if (t < 256) { const f32x4* src = (const f32x4*)(xrec + (size_t)(u.pm * 256 + t) * 4 * 20); float tot[17];
#pragma unroll
            for (int i = 0; i < 17; ++i) tot[i] = 0.f;
#pragma unroll
            for (int o = 0; o < 4; ++o) { const f32x4 a0 = src[o * 5], a1 = src[o * 5 + 1], a2 = src[o * 5 + 2], a3 = src[o * 5 + 3], a4 = src[o * 5 + 4];
                tot[1] += a0[0]; tot[2] += a0[1]; tot[3] += a0[2]; tot[4] += a0[3]; tot[5] += a1[0]; tot[6] += a1[1]; tot[7] += a1[2]; tot[8] += a1[3];
                tot[9] += a2[0]; tot[10] += a2[1]; tot[11] += a2[2]; tot[12] += a2[3]; tot[13] += a3[0]; tot[14] += a3[1]; tot[15] += a3[2]; tot[16] += a3[3]; tot[0] += a4[0]; }
            const float rstd = rsqrtf(tot[0] * (1.f / D) + EPS); RS[t] = rstd;
            if ((t >> 6) == u.pn) { float lgt[16], mx = -3.0e38f;
#pragma unroll
                for (int e = 0; e < 16; ++e) { lgt[e] = rstd * tot[1 + e] + biasr[b * 16 + e]; mx = fmaxf(mx, lgt[e]); }
                float sm = 0.f;
#pragma unroll
                for (int e = 0; e < 16; ++e) { lgt[e] = expf(lgt[e] - mx); sm += lgt[e]; }
                const float inv = 1.f / sm; f32x4* ao = (f32x4*)(aff + (size_t)(u.pm * 256 + t) * 16);
                ao[0] = (f32x4){lgt[0] * inv, lgt[1] * inv, lgt[2] * inv, lgt[3] * inv}; ao[1] = (f32x4){lgt[4] * inv, lgt[5] * inv, lgt[6] * inv, lgt[7] * inv};
                ao[2] = (f32x4){lgt[8] * inv, lgt[9] * inv, lgt[10] * inv, lgt[11] * inv}; ao[3] = (f32x4){lgt[12] * inv, lgt[13] * inv, lgt[14] * inv, lgt[15] * inv}; } }
        __syncthreads();
        const float* shp = mod + b * 6144 + 3072;
        { const int t2 = ltid(wv), l2 = t2 & 63, fr2 = l2 & 15, fq2 = l2 >> 4; const int row0b = u.pm * 256 + wr * 64 + fr2, colbb = u.pn * 256 + wc * 32 + 8 * fq2;
#pragma unroll
        for (int ai = 0; ai < 2; ++ai)
#pragma unroll
            for (int m = 0; m < 4; ++m) { const int r = row0b + ai * 128 + m * 16; const float rstd = RS[ai * 128 + wr * 64 + m * 16 + fr2];
#pragma unroll
                for (int bj = 0; bj < 2; ++bj) { const int c = colbb + bj * 128; const f32x4 v0 = acc[ai][bj][m][0], v1 = acc[ai][bj][m][1];
                    const f32x4 w0 = *(const f32x4*)(wsp + c), w1 = *(const f32x4*)(wsp + c + 4), s0 = *(const f32x4*)(shp + c), s1 = *(const f32x4*)(shp + c + 4);
                    const f32x4 h0 = v0 * rstd * w0 + s0, h1 = v1 * rstd * w1 + s1;
                    u32x2 o; o.x = pk4_fp8(h0[0], h0[1], h0[2], h0[3]); o.y = pk4_fp8(h1[0], h1[1], h1[2], h1[3]);
                    *(u32x2*)(H2 + (size_t)r * D + c) = o; } }
        }
    }
};

struct MegaP { FastQ q; MixP m; TailP t; FastP f; unsigned* bar; };
constexpr int MISC_OFF = LDS_BYTES - 256;
constexpr int CVT_NIT = NE * (2 * 8 * 88 + 22 * 32);
constexpr int CVT_SPLIT1 = (CVT_NIT * 70 / 100) & ~7, CVT_SPLIT2 = (CVT_NIT * 94 / 100) & ~7;
__global__ void __launch_bounds__(NTHR, 2) mega_fwd(MegaP P) {
    extern __shared__ __attribute__((aligned(16))) unsigned char lds_raw[];
    LAS unsigned char* lds = (LAS unsigned char*)lds_raw;
    const int bid = blockIdx.x, nb = gridDim.x;
    const int wid = __builtin_amdgcn_readfirstlane((int)threadIdx.x >> 6);
    volatile LAS unsigned* misc = (volatile LAS unsigned*)(lds + MISC_OFF);
    if (threadIdx.x < 64) misc[threadIdx.x] = 0u;
    __syncthreads();
    const XcdBarrier bar = xcd_barrier_post(P.bar, misc + 8);
    phase_mod(P.q, lds, bid, nb, wid);
    xcd_barrier(bar, wid);
    if (bid & 1) { phase_convert_small(P.q, lds, bid, nb, wid); __syncthreads(); phase_norm1(P.q, lds, bid, nb, wid); }
    else { phase_norm1(P.q, lds, bid, nb, wid); __syncthreads(); phase_convert_small(P.q, lds, bid, nb, wid); }
    xcd_barrier(bar, wid);
    {
        const int tid0 = ltid(wid);
        const float sg = calib_scale(P.f.w_gate, (LAS float*)lds, tid0), su = calib_scale(P.f.w_up, (LAS float*)lds, tid0), sd = calib_scale(P.f.w_down, (LAS float*)lds, tid0);
        if (bid == 0 && tid0 == 0) { P.f.wsc[0] = sg; P.f.wsc[1] = su; P.f.wsc[2] = sd; P.f.wsc[4] = 1.f / sg; P.f.wsc[5] = 1.f / su; P.f.wsc[6] = 1.f / sd; }
        CvtSide side; side.init(P.f, __builtin_bit_cast(float, __builtin_amdgcn_readfirstlane(__builtin_bit_cast(int, sg))), __builtin_bit_cast(float, __builtin_amdgcn_readfirstlane(__builtin_bit_cast(int, su))),
                                __builtin_bit_cast(float, __builtin_amdgcn_readfirstlane(__builtin_bit_cast(int, sd))), bid * 8 + wid, nb * 8, CVT_SPLIT1);
        SchedInProj S{(const char*)P.q.XN, (const char*)P.q.WinT, nb, bid}; EpiInProj E{P.q.Pb, P.q.ropetab}; pg8::gemm_phase<false>(lds, D, S, E, wid, side);
        side.skip = 0; while (side.busy()) { (void)side.issue(wid); (void)side.finish<0>(wid); }
    }
    if (bid >= 1056 - 4 * nb && nb == 256) phase_convert_moe(P.f, lds, CVT_SPLIT1, CVT_SPLIT2, bid - (1056 - 4 * nb), 5 * nb - 1056, wid);
    xcd_barrier(bar, wid);
    phase_mixA(P.m, lds, bid, nb, wid);
    xcd_barrier(bar, wid);
    phase_mixB(P.m, bid, nb, wid);
    xcd_barrier(bar, wid);
    phase_mixC(P.m, lds, bid, nb, wid);
    xcd_barrier(bar, wid);
    if (nb == 256) { SchedOutProj S{(const char*)P.t.YM, (const char*)P.t.WoutT, nb, bid};
        EpiOutNorm E{P.t.x, P.t.mod, P.t.xl, P.t.H2, P.t.aff, P.t.wsc2, P.t.WrT, P.t.biasr, P.t.xrec, P.t.bar}; pg8::gemm_phase<false>(lds, D, S, E, wid); }
    else { SchedOutProj S{(const char*)P.t.YM, (const char*)P.t.WoutT, nb, bid}; EpiOutProj E{P.t.x, P.t.mod, P.t.xl}; pg8::gemm_phase<false>(lds, D, S, E, wid); }
    xcd_barrier(bar, wid);
    if (nb != 256) { phase_norm2(P.t, lds, bid, nb, wid); xcd_barrier(bar, wid); }
    if (bid < NB * NE || nb != 256) phase_topk(P.t, lds, bid, nb, wid);
    if (nb == 256) { if (bid >= NB * NE) phase_convert_moe(P.f, lds, CVT_SPLIT2, CVT_NIT, bid - NB * NE, nb - NB * NE, wid); }
    else phase_convert_moe(P.f, lds, CVT_SPLIT1, CVT_NIT, bid, nb, wid);
    xcd_barrier(bar, wid);
    {
        constexpr int LROW0 = pg8::STAGE_BYTES;
        const bool lok = (nb & 7) == 0;
        if (lok) { for (int i = ltid(wid); i < 4096; i += NTHR) ((LAS int*)(lds + LROW0))[i] = P.f.erow[(bid & 7) * 4096 + i]; }
        __syncthreads();
        SchedMoe1 S{(const char*)P.f.H2, P.f.erow, (const char*)P.f.WguT, nb, bid, lok ? LROW0 : -1}; const unsigned eg = (254u - (__float_as_uint(P.f.wsc[0]) >> 23)) * 0x01010101u, eu = (254u - (__float_as_uint(P.f.wsc[1]) >> 23)) * 0x01010101u;
        EpiSwiGLU E{P.f.Hb, eg, eu}; pg8::gemm_phase<true>(lds, D / 2, S, E, wid); }
    xcd_barrier(bar, wid);
    { SchedMoe2 S{(const char*)P.f.Hb, (const char*)P.f.WdT, nb, bid}; const unsigned ed = (254u - (__float_as_uint(P.f.wsc[2]) >> 23)) * 0x01010101u; EpiDownBf16 E{P.f.Ys, P.f.gate, ed, ed}; pg8::gemm_phase<true>(lds, FF / 2, S, E, wid); }
    xcd_barrier(bar, wid);
    phase_final(P.t, bid, nb, wid);
}

extern "C" void kernel_launch(void* const* d_in, const int* in_sizes, int n_in, void* d_out, int out_size, void* d_ws, size_t ws_size, hipStream_t stream) {
    const float* x = (const float*)d_in[0]; const float* c = (const float*)d_in[1]; const float* ctx = (const float*)d_in[2]; const float* c_ctx = (const float*)d_in[3];
    const float* w_ada = (const float*)d_in[4]; const float* b_ada = (const float*)d_in[5]; const float* norm1_w = (const float*)d_in[6]; const float* norm2_w = (const float*)d_in[7];
    const float* w_in = (const float*)d_in[8]; const float* gate_bias = (const float*)d_in[9]; const float* decay_logit = (const float*)d_in[10];
    const float* mnw = (const float*)d_in[11]; const float* rnw = (const float*)d_in[12]; const float* w_out = (const float*)d_in[13]; const float* w_router = (const float*)d_in[14];
    const float* w_gate = (const float*)d_in[15]; const float* w_up = (const float*)d_in[16]; const float* w_down = (const float*)d_in[17]; const float* final_w = (const float*)d_in[18];
    float* out = (float*)d_out;
    char* ws = (char*)d_ws; size_t off = 0;
    auto carve = [&](size_t bytes) { char* p = ws + off; off += (bytes + 255) & ~(size_t)255; return p; };
    unsigned* bar = (unsigned*)carve(32768);
    float* mod = (float*)carve(5 * 6144 * 4);
    float* ropetab = (float*)carve(2048 * 2 * 4); float* normw = (float*)carve(1024 * 4); float* wsc2 = (float*)carve(4 * 1024 * 4); float* biasr = (float*)carve(256); bf16_t* WrT = (bf16_t*)carve(16 * 1024 * 2);
    float* xrec = (float*)carve((size_t)ML * 4 * 20 * 4); float* G = (float*)carve((size_t)MA * 16 * 4);
    float* aff = (float*)carve((size_t)ML * 16 * 4);
    float* gate = (float*)carve(NSLOT * 4); int* erow = (int*)carve(NSLOT * 4);
    int* slotmap = (int*)carve((size_t)ML * NE * 4);
    float* NV = (float*)carve((size_t)2 * 16 * NCH * 2 * 128 * 4); float* SC = (float*)carve((size_t)2 * 16 * NCH * 2 * 4 * 4);
    bf16_t* xl = (bf16_t*)carve((size_t)ML * D * 2);
    bf16_t* WinT = (bf16_t*)carve((size_t)4096 * D * 2); bf16_t* WoutT = (bf16_t*)carve((size_t)D * D * 2);
    fp8_t* WguT = (fp8_t*)carve((size_t)NE * 5632 * D);
    fp8_t* WdT = (fp8_t*)carve((size_t)NE * D * FF);
    float* wsc = (float*)carve(256);
    const size_t e0 = off;
    bf16_t* XN = (bf16_t*)carve((size_t)MA * D * 2); bf16_t* Pb = (bf16_t*)carve((size_t)MA * PBC * 2);
    bf16_t* ST = (bf16_t*)carve((size_t)2 * 16 * NCH * 2 * 16384 * 2); bf16_t* YM = (bf16_t*)carve((size_t)ML * D * 2);
    const size_t early_end = off; off = e0;
    fp8_t* Hb = (fp8_t*)carve((size_t)NSLOT * FF); fp8_t* H2 = (fp8_t*)carve((size_t)ML * D); bf16_t* Ys = (bf16_t*)carve((size_t)NSLOT * D * 2);
    if (off < early_end) off = early_end;
    if (off > ws_size) { fprintf(stderr, "ws too small: need %zu have %zu\n", off, ws_size); return; }

    static int grid = 0;
    if (!grid) {
        int dev = 0, cus = 0, per_cu = 0;
        hipGetDevice(&dev); hipDeviceGetAttribute(&cus, hipDeviceAttributeMultiprocessorCount, dev);
        hipFuncSetAttribute((const void*)mega_fwd, hipFuncAttributeMaxDynamicSharedMemorySize, LDS_BYTES);
        hipOccupancyMaxActiveBlocksPerMultiprocessor(&per_cu, mega_fwd, NTHR, LDS_BYTES);
        if (per_cu < 1) { fprintf(stderr, "occupancy query says 0 blocks/CU\n"); per_cu = 1; }
        grid = cus * 1;
        if (grid % 8) grid -= grid % 8;
    }
    MegaP P{};
    P.q.x = x; P.q.ctx = ctx; P.q.c = c; P.q.c_ctx = c_ctx; P.q.w_ada = w_ada; P.q.b_ada = b_ada; P.q.norm1_w = norm1_w; P.q.w_in = w_in; P.q.w_out = w_out; P.q.mnw = mnw; P.q.rnw = rnw; P.q.w_router = w_router; P.q.norm2_w = norm2_w; P.q.wsc2 = wsc2; P.q.biasr = biasr; P.q.WrT = WrT;
    P.q.mod = mod; P.q.ropetab = ropetab; P.q.G = G; P.q.normw = normw; P.q.WinT = WinT; P.q.WoutT = WoutT; P.q.XN = XN; P.q.Pb = Pb;
    P.m.Pb = Pb; P.m.G = G; P.m.gate_bias = gate_bias; P.m.decay_logit = decay_logit; P.m.normw = normw; P.m.ST = ST; P.m.NV = NV; P.m.SC = SC; P.m.YM = YM;
    P.t.x = x; P.t.mod = mod; P.t.norm2_w = norm2_w; P.t.w_router = w_router; P.t.final_w = final_w; P.t.YM = YM; P.t.WoutT = WoutT; P.t.Ys = Ys;
    P.t.wsc2 = wsc2; P.t.biasr = biasr; P.t.WrT = WrT; P.t.xrec = xrec; P.t.bar = bar; P.t.xl = xl; P.t.aff = aff; P.t.gate = gate; P.t.out = out; P.t.H2 = H2; P.t.idx = erow; P.t.slotmap = slotmap;
    P.f.w_gate = w_gate; P.f.w_up = w_up; P.f.w_down = w_down; P.f.gate = gate; P.f.erow = erow; P.f.wsc = wsc; P.f.WguT = WguT; P.f.WdT = WdT; P.f.H2 = H2; P.f.Hb = Hb; P.f.Ys = Ys;
    P.bar = bar;
    hipMemsetAsync(bar, 0, 32768, stream);
    void* args[] = {&P};
    hipError_t e = hipLaunchCooperativeKernel((const void*)mega_fwd, dim3(grid), dim3(NTHR), args, LDS_BYTES, stream);
    if (e != hipSuccess) fprintf(stderr, "cooperative launch failed: %s (grid %d)\n", hipGetErrorString(e), grid);
}
```

```cpp
#include <hip/hip_runtime.h>
#include <cstdint>
#include <cstdio>

constexpr int D = 1024, NB = 4, T = 4096, TC = 256, NH = 4, DH = 128;
constexpr int ML = NB * T;
constexpr int MC = NB * TC;
constexpr int MA = ML + MC;
constexpr int INC = 4112;
constexpr int NE = 16, CAP = 512, FF = 2816;
constexpr int NSLOT = NB * NE * CAP;
constexpr float EPS = 1e-6f;
constexpr int C_MQ = 0, C_MK = 512, C_MV = 1024, C_MO = 1536, C_MG = 2048, C_RQ = 2064, C_RK = 2576, C_RV = 3088, C_RO = 3600;

__device__ __forceinline__ float sigmoidf_(float x) { return 1.f / (1.f + expf(-x)); }
__device__ __forceinline__ float siluf_(float x) { return x / (1.f + expf(-x)); }
__device__ __forceinline__ float logsigmoidf_(float x) { return fminf(x, 0.f) - log1pf(expf(-fabsf(x))); }

constexpr int PB_MQ = 0, PB_MK = 512, PB_MV = 1024, PB_MO = 1536, PB_RQ = 2048, PB_RK = 2560, PB_RV = 3072, PB_RO = 3584, PBC = 4096;

#define LAS __attribute__((address_space(3)))
typedef unsigned short bf16_t;
typedef short bf16x8 __attribute__((ext_vector_type(8)));
typedef float f32x4 __attribute__((ext_vector_type(4)));
typedef unsigned u32x4 __attribute__((ext_vector_type(4)));
typedef unsigned u32x2 __attribute__((ext_vector_type(2)));
typedef int v8i __attribute__((ext_vector_type(8)));
typedef int v4i __attribute__((ext_vector_type(4)));
typedef unsigned char fp8_t;
constexpr int NTHR = 512;
constexpr int LDS_BYTES = 155648;

__device__ __forceinline__ unsigned f2bf(float f) { unsigned u = __float_as_uint(f); return (u + 0x7fffu + ((u >> 16) & 1u)) >> 16; }
__device__ __forceinline__ unsigned pk2(float lo, float hi) { return f2bf(lo) | (f2bf(hi) << 16); }
__device__ __forceinline__ float bf2f(unsigned short b) { return __uint_as_float((unsigned)b << 16); }
__device__ __forceinline__ unsigned cvt_pk_bf16(float lo, float hi) { unsigned r; asm volatile("v_cvt_pk_bf16_f32 %0, %1, %2" : "=v"(r) : "v"(lo), "v"(hi)); return r; }
__device__ __forceinline__ int ltid(int wid) { int l; asm volatile("v_mbcnt_lo_u32_b32 %0, -1, 0\n\tv_mbcnt_hi_u32_b32 %0, -1, %0" : "=v"(l)); return wid * 64 + l; }
__device__ __forceinline__ unsigned pk4_fp8(float a, float b, float c, float d) { int p = __builtin_amdgcn_cvt_pk_fp8_f32(a, b, 0, false); p = __builtin_amdgcn_cvt_pk_fp8_f32(c, d, p, true); return (unsigned)p; }
__device__ __forceinline__ f32x4 bf4_f32(unsigned a, unsigned b) { return (f32x4){__uint_as_float(a << 16), __uint_as_float(a & 0xffff0000u), __uint_as_float(b << 16), __uint_as_float(b & 0xffff0000u)}; }
template <class T> __device__ __forceinline__ T ntl(const T* p) { return __builtin_nontemporal_load(p); }
template <class T> __device__ __forceinline__ void nts(T v, T* p) { __builtin_nontemporal_store(v, p); }
typedef __amdgpu_buffer_rsrc_t rsrc_t;
__device__ __forceinline__ float fast_silu(float x) { return x * __builtin_amdgcn_rcpf(1.f + __expf(-x)); }

namespace pg8 {
constexpr int BM = 256, BK = 64, HALF = 128, HTB = HALF * BK * 2  , STAGE_BYTES = 8 * HTB;
__device__ __forceinline__ int lds_byte(int r, int c) { const int st = (r >> 4) * 2 + (c >> 5), rr = r & 15, cc = c & 31, ob = rr * 64 + cc * 2; return st * 1024 + (ob ^ (((ob >> 9) & 1) << 5)); }
__device__ __forceinline__ void stage_rc(int b, int& R, int& C) { const int st = b / 1024, sb = b % 1024, swz = sb ^ (((sb >> 9) & 1) << 5); R = (st >> 1) * 16 + swz / 64; C = (st & 1) * 32 + (swz % 64) / 2; }
__device__ __forceinline__ int perm32(int rho) { const int n = rho >> 4, i = rho & 15; return 8 * (i >> 2) + 4 * n + (i & 3); }
struct Unit { const char* a; const char* b; const int* arows; int pm, pn, aux, lrows; };

struct NoSide { static constexpr bool ON = false; __device__ __forceinline__ int issue(int) { return 0; } template <int> __device__ __forceinline__ int finish(int) { return 0; } };
template <bool FP8, class Epi, class Sched, class Side>
__device__ __forceinline__ void gemm_phase(LAS unsigned char* lds, const int K, const Sched& S, const Epi& E, const int wv, Side& side) {
    const int tid = ltid(wv), wid = __builtin_amdgcn_readfirstlane(tid >> 6), lane = tid & 63, wr = wid >> 2, wc = wid & 3, fr = lane & 15, fq = lane >> 4;
    const int nt = K / BK;
    unsigned voffB[2];
#pragma unroll
    for (int i = 0; i < 2; ++i) { int R, C; stage_rc(tid * 16 + i * 8192, R, C); const int Rb = Epi::PERM ? ((R & ~31) + perm32(R & 31)) : R; voffB[i] = (unsigned)(Rb * K + C) * 2u; }
    const size_t kstep = (size_t)(BK * 2);
    const size_t hstep = (size_t)HALF * K * 2;
    const unsigned ldsw = (unsigned)wid * 1024u;
    const int aoff = lds_byte(wr * 64 + fr, fq * 8), boff = lds_byte(wc * 32 + fr, fq * 8);
#define PG8_SA(b, h) (((b) * 2 + (h)) * HTB)
#define PG8_SB(b, h) ((4 + (b) * 2 + (h)) * HTB)
#define PG8_STAGE(bufoff, gbase, voff) do { _Pragma("unroll") for (int _i = 0; _i < 2; ++_i) { unsigned _o = (voff)[_i]; asm volatile("" : "+v"(_o)); \
        __builtin_amdgcn_global_load_lds((const unsigned*)((const char*)(gbase) + _o), (LAS unsigned*)(lds + (bufoff) + ldsw + _i * 8192), 16, 0, 0); } } while (0)
#define PG8_STAGE2(bufoff, gbase, vc, vn) do { _Pragma("unroll") for (int _i = 0; _i < 2; ++_i) { unsigned _o = last ? (vn)[_i] : (vc)[_i]; asm volatile("" : "+v"(_o)); \
        __builtin_amdgcn_global_load_lds((const unsigned*)((const char*)(gbase) + _o), (LAS unsigned*)(lds + (bufoff) + ldsw + _i * 8192), 16, 0, 0); } } while (0)
#define PG8_LDA(dst, b, h) do { _Pragma("unroll") for (int m = 0; m < 4; ++m) { const v4i _lo = *(const LAS v4i*)(lds + PG8_SA(b, h) + aoff + m * 2048), _hi = *(const LAS v4i*)(lds + PG8_SA(b, h) + aoff + m * 2048 + 1024); \
        dst[m] = __builtin_shufflevector(_lo, _hi, 0, 1, 2, 3, 4, 5, 6, 7); } } while (0)
#define PG8_LDB(dst, b, h) do { _Pragma("unroll") for (int n = 0; n < 2; ++n) { const v4i _lo = *(const LAS v4i*)(lds + PG8_SB(b, h) + boff + n * 2048), _hi = *(const LAS v4i*)(lds + PG8_SB(b, h) + boff + n * 2048 + 1024); \
        dst[n] = __builtin_shufflevector(_lo, _hi, 0, 1, 2, 3, 4, 5, 6, 7); } } while (0)
#define PG8_LDAX(dst, base, off) do { _Pragma("unroll") for (int m = 0; m < 4; ++m) { const v4i _lo = *(const LAS v4i*)((base) + (off) + m * 2048), _hi = *(const LAS v4i*)((base) + (off) + m * 2048 + 1024); \
        dst[m] = __builtin_shufflevector(_lo, _hi, 0, 1, 2, 3, 4, 5, 6, 7); } } while (0)
#define PG8_LDBX(dst, base, off) do { _Pragma("unroll") for (int n = 0; n < 2; ++n) { const v4i _lo = *(const LAS v4i*)((base) + (off) + n * 2048), _hi = *(const LAS v4i*)((base) + (off) + n * 2048 + 1024); \
        dst[n] = __builtin_shufflevector(_lo, _hi, 0, 1, 2, 3, 4, 5, 6, 7); } } while (0)
#define PG8_MMA(ai, bj, At, Bt) do { __builtin_amdgcn_s_setprio(1); _Pragma("unroll") for (int m = 0; m < 4; ++m) _Pragma("unroll") for (int n = 0; n < 2; ++n) { \
        if constexpr (FP8) { acc[ai][bj][m][n] = __builtin_amdgcn_mfma_scale_f32_16x16x128_f8f6f4(Bt[n], At[m], acc[ai][bj][m][n], 0, 0, 0, (int)((bj) ? E.wscale1 : E.wscale0), 0, 0x7f7f7f7f); } \
        else { acc[ai][bj][m][n] = __builtin_amdgcn_mfma_f32_16x16x32_bf16(__builtin_bit_cast(bf16x8, __builtin_shufflevector(Bt[n], Bt[n], 0, 1, 2, 3)), __builtin_bit_cast(bf16x8, __builtin_shufflevector(At[m], At[m], 0, 1, 2, 3)), acc[ai][bj][m][n], 0, 0, 0); \
               acc[ai][bj][m][n] = __builtin_amdgcn_mfma_f32_16x16x32_bf16(__builtin_bit_cast(bf16x8, __builtin_shufflevector(Bt[n], Bt[n], 4, 5, 6, 7)), __builtin_bit_cast(bf16x8, __builtin_shufflevector(At[m], At[m], 4, 5, 6, 7)), acc[ai][bj][m][n], 0, 0, 0); } } \
        __builtin_amdgcn_s_setprio(0); } while (0)
#define PG8_WAIT_V(n) asm volatile("s_waitcnt vmcnt(" #n ")" ::: "memory")
#define PG8_WAIT_L(n) asm volatile("s_waitcnt lgkmcnt(" #n ")" ::: "memory")
#define PG8_BAR __builtin_amdgcn_s_barrier()
#define PG8_SCHED __builtin_amdgcn_sched_barrier(0)
#define PG8_AOFF(dst, u) do { const int _t = ltid(wv); _Pragma("unroll") for (int _i = 0; _i < 2; ++_i) { int _R, _C; stage_rc(_t * 16 + _i * 8192, _R, _C); \
        _Pragma("unroll") for (int _h = 0; _h < 2; ++_h) { const int _r = _h * HALF + _R; const int _ri = (u).lrows >= 0 ? *(const LAS int*)(lds + (u).lrows + 4 * _r) : ((u).arows ? (u).arows[_r] : _r); dst[_h][_i] = (unsigned)(_ri * K + _C) * 2u; } } } while (0)
    Unit cur, nxt; int ui = 0; int sdc = 0;
    if (!S.next(0, cur)) return;
    f32x4 acc[2][2][4][2];
#pragma unroll
    for (int a = 0; a < 2; ++a)
#pragma unroll
        for (int b = 0; b < 2; ++b)
#pragma unroll
            for (int m = 0; m < 4; ++m)
#pragma unroll
                for (int n = 0; n < 2; ++n) acc[a][b][m][n] = (f32x4){0.f, 0.f, 0.f, 0.f};
    v8i At[4], B0[2], B1[2];
    unsigned cO[2][2], nO[2][2];
    PG8_AOFF(cO, cur);
    const char* cA = cur.a; const char* cB = cur.b;
    PG8_STAGE(PG8_SB(0, 0), cB, voffB); PG8_STAGE(PG8_SB(0, 1), cB + hstep, voffB); PG8_STAGE(PG8_SA(0, 0), cA, cO[0]); PG8_STAGE(PG8_SA(0, 1), cA, cO[1]);
    if (wr == 1) PG8_BAR;
    PG8_WAIT_V(2); PG8_BAR;
    PG8_STAGE(PG8_SB(1, 0), cB + kstep, voffB); PG8_STAGE(PG8_SA(1, 0), cA + kstep, cO[0]); PG8_STAGE(PG8_SB(1, 1), cB + hstep + kstep, voffB);
    PG8_WAIT_V(6); PG8_BAR;
    for (;;) {
        const bool has_next = S.next(ui + 1, nxt);
        if (has_next) { PG8_AOFF(nO, nxt); } else {
#pragma unroll
            for (int h = 0; h < 2; ++h)
#pragma unroll
                for (int i = 0; i < 2; ++i) nO[h][i] = cO[h][i]; }
        const char* nA = has_next ? nxt.a : cA; const char* nB = has_next ? nxt.b : cB;
#pragma unroll 1
        for (int t = 0; t < nt; ++t) {
            const int bb = t & 1;
            const bool l1 = (t + 1 >= nt), last = (t + 2 >= nt);
            const char* a1 = l1 ? nA + (size_t)(t + 1 - nt) * kstep : cA + (size_t)(t + 1) * kstep;
            const char* a2 = last ? nA + (size_t)(t + 2 - nt) * kstep : cA + (size_t)(t + 2) * kstep;
            const char* b2 = last ? nB + (size_t)(t + 2 - nt) * kstep : cB + (size_t)(t + 2) * kstep;
            const int sa = bb * 2 * HTB, sa1 = (bb ^ 1) * 2 * HTB;
            LAS unsigned char* la = lds + sa + aoff; LAS unsigned char* lb = lds + 4 * HTB + sa + boff;
            PG8_LDBX(B0, lb, 0); PG8_LDBX(B1, lb, HTB); PG8_SCHED; PG8_LDAX(At, la, 0);
            { _Pragma("unroll") for (int _i = 0; _i < 2; ++_i) { unsigned _o = l1 ? nO[1][_i] : cO[1][_i]; asm volatile("" : "+v"(_o));
                __builtin_amdgcn_global_load_lds((const unsigned*)(a1 + _o), (LAS unsigned*)(lds + sa1 + HTB + ldsw + _i * 8192), 16, 0, 0); } }
            int sdl = 0;
            if constexpr (Side::ON) { sdl = side.issue(wv); const int w1 = sdl + sdc; if (w1 == 0) PG8_WAIT_V(8); else if (w1 == 4) PG8_WAIT_V(12); else PG8_WAIT_V(16); } else PG8_WAIT_V(8);
            PG8_WAIT_L(0); PG8_BAR; PG8_MMA(0, 0, At, B0); PG8_MMA(0, 1, At, B1); PG8_BAR; PG8_SCHED;
            PG8_LDAX(At, la, HTB);
            PG8_STAGE(4 * HTB + sa, b2, voffB); PG8_STAGE(4 * HTB + sa + HTB, b2 + hstep, voffB); PG8_STAGE2(sa, a2, cO[0], nO[0]);
            if constexpr (Side::ON) { if (sdl == 0) PG8_WAIT_V(8); else PG8_WAIT_V(12); } else PG8_WAIT_V(8);
            PG8_WAIT_L(0); PG8_BAR; PG8_MMA(1, 0, At, B0); PG8_MMA(1, 1, At, B1);
            if constexpr (Side::ON) { sdc = side.template finish<1>(wv); }
            PG8_BAR; PG8_SCHED;
        }
        if (wr == 0) PG8_BAR;
        if constexpr (!Epi::AFTER_DRAIN) { const int _t = ltid(wv), _l = _t & 63, _w = __builtin_amdgcn_readfirstlane(_t >> 6); E(acc, cur, _w >> 2, _w & 3, _l & 15, _l >> 4); }
        if (!has_next) break;
#pragma unroll
        for (int a = 0; a < 2; ++a)
#pragma unroll
            for (int b = 0; b < 2; ++b)
#pragma unroll
                for (int m = 0; m < 4; ++m)
#pragma unroll
                    for (int n = 0; n < 2; ++n) acc[a][b][m][n] = (f32x4){0.f, 0.f, 0.f, 0.f};
        cur = nxt; cA = nA; cB = nB; ++ui;
#pragma unroll
        for (int h = 0; h < 2; ++h)
#pragma unroll
            for (int i = 0; i < 2; ++i) cO[h][i] = nO[h][i];
        if (wr == 1) PG8_BAR;
    }
    PG8_WAIT_V(0);
    PG8_BAR;
    if constexpr (Epi::AFTER_DRAIN) E.fused(acc, cur, lds, wv);
#undef PG8_SA
#undef PG8_SB
#undef PG8_STAGE
#undef PG8_STAGE2
#undef PG8_LDA
#undef PG8_LDAX
#undef PG8_LDBX
#undef PG8_LDB
#undef PG8_MMA
#undef PG8_WAIT_V
#undef PG8_WAIT_L
#undef PG8_BAR
#undef PG8_SCHED
#undef PG8_AOFF
}
template <bool FP8, class Epi, class Sched>
__device__ __forceinline__ void gemm_phase(LAS unsigned char* lds, const int K, const Sched& S, const Epi& E, const int wv) { NoSide ns; gemm_phase<FP8>(lds, K, S, E, wv, ns); }
}

struct SchedMoe1 {
    const char* X; const int* erow; const char* W; int G, c, lrow0;
    __device__ __forceinline__ bool next(int i, pg8::Unit& u) const {
        const int L = i * G + c; if (L >= 2816) return false;
        const int x = L & 7, uu = L >> 3, el = uu / 176, w = uu % 176, e = 2 * x + el;
        u.pm = e * 8 + (w & 7); u.pn = w >> 3; u.aux = e; u.lrows = lrow0 >= 0 ? lrow0 + (el * 2048 + (w & 7) * 256) * 4 : -1;
        u.a = X; u.arows = erow + u.pm * 256; u.b = W + (size_t)(e * 22 + u.pn) * 256 * D;
        return true;
    }
};
struct EpiSwiGLU {
    static constexpr bool PERM = true, AFTER_DRAIN = false;
    fp8_t* H; unsigned wscale0, wscale1;
    __device__ __forceinline__ void operator()(const f32x4 (&acc)[2][2][4][2], const pg8::Unit& u, int wr, int wc, int fr, int fq) const {
        const int row0 = u.pm * 256 + wr * 64 + fr, col0 = u.pn * 128 + wc * 32 + 8 * fq;
#pragma unroll
        for (int ai = 0; ai < 2; ++ai)
#pragma unroll
            for (int m = 0; m < 4; ++m) {
                const f32x4 g0 = acc[ai][0][m][0], g1 = acc[ai][0][m][1], u0 = acc[ai][1][m][0], u1 = acc[ai][1][m][1];
                u32x2 w;
                w.x = pk4_fp8(fast_silu(g0[0]) * u0[0], fast_silu(g0[1]) * u0[1], fast_silu(g0[2]) * u0[2], fast_silu(g0[3]) * u0[3]);
                w.y = pk4_fp8(fast_silu(g1[0]) * u1[0], fast_silu(g1[1]) * u1[1], fast_silu(g1[2]) * u1[2], fast_silu(g1[3]) * u1[3]);
                *(u32x2*)(H + (size_t)(row0 + ai * 128 + m * 16) * FF + col0) = w;
            }
    }
};
struct SchedMoe2 {
    const char* H; const char* W; int G, c;
    __device__ __forceinline__ bool next(int i, pg8::Unit& u) const {
        const int L = i * G + c; if (L >= 512) return false;
        const int x = L & 7, uu = L >> 3, el = uu >> 5, w = uu & 31, e = 2 * x + el;
        u.pm = e * 8 + (w & 7); u.pn = w >> 3; u.aux = e; u.lrows = -1;
        u.a = H + (size_t)u.pm * 256 * FF; u.arows = nullptr; u.b = W + (size_t)(e * 4 + u.pn) * 256 * FF;
        return true;
    }
};
struct EpiDownBf16 {
    static constexpr bool PERM = true, AFTER_DRAIN = false;
    bf16_t* Y; const float* gate; unsigned wscale0, wscale1;
    __device__ __forceinline__ void operator()(const f32x4 (&acc)[2][2][4][2], const pg8::Unit& u, int wr, int wc, int fr, int fq) const {
        const int row0 = u.pm * 256 + wr * 64 + fr, col0 = u.pn * 256 + wc * 32 + 8 * fq;
#pragma unroll
        for (int ai = 0; ai < 2; ++ai)
#pragma unroll
            for (int m = 0; m < 4; ++m) {
                const int r = row0 + ai * 128 + m * 16; const float g = gate[r];
#pragma unroll
                for (int bj = 0; bj < 2; ++bj) {
                    const f32x4 v0 = acc[ai][bj][m][0] * g, v1 = acc[ai][bj][m][1] * g;
                    u32x4 w; w.x = cvt_pk_bf16(v0[0], v0[1]); w.y = cvt_pk_bf16(v0[2], v0[3]); w.z = cvt_pk_bf16(v1[0], v1[1]); w.w = cvt_pk_bf16(v1[2], v1[3]);
                    *(u32x4*)(Y + (size_t)r * D + col0 + bj * 128) = w;
                }
            }
    }
};

template <class RowMap>
__device__ __forceinline__ void cvt_item(const float* W, int N, bf16_t* WT, int ldt, int kb, int nb, int lane, const RowMap& rm) {
    const int k0 = 64 * kb, n0 = 32 * nb, nq = lane & 7, kg = lane >> 3; const int n = n0 + 4 * nq; const bool ok = n < N;
    f32x4 v[8];
#pragma unroll
    for (int i = 0; i < 8; ++i) v[i] = ok ? ntl((const f32x4*)(W + (size_t)(k0 + 8 * kg + i) * N + n)) : (f32x4){0.f, 0.f, 0.f, 0.f};
#pragma unroll
    for (int j = 0; j < 4; ++j) { const int dr = rm(n + j);
        u32x4 o; o.x = pk2(v[0][j], v[1][j]); o.y = pk2(v[2][j], v[3][j]); o.z = pk2(v[4][j], v[5][j]); o.w = pk2(v[6][j], v[7][j]);
        if (dr >= 0) *(u32x4*)(WT + (size_t)dr * ldt + k0 + 8 * kg) = o; }
}
struct RmGateUp { int base; __device__ __forceinline__ int operator()(int n) const { return base + (n >> 7) * 256 + (n & 127); } };
struct RmLin { int base; __device__ __forceinline__ int operator()(int n) const { return base + n; } };

struct FastP {
    const float *w_gate, *w_up, *w_down; const float* gate; const int* erow; float* wsc;
    fp8_t *WguT, *WdT, *H2, *Hb; bf16_t* Ys;
};

struct CvtSrc { const float* W; int N; fp8_t* WT; int ldt; int rbase; int gu; float sc; int k0, n0; };
__device__ __forceinline__ void cvt_fp8_load(const CvtSrc& c, int lane, f32x4 (&v)[16]) {
    const int nq = lane & 7, kg = lane >> 3;
#pragma unroll
    for (int i = 0; i < 16; ++i) v[i] = ntl((const f32x4*)(c.W + (size_t)(c.k0 + 16 * kg + i) * c.N + c.n0 + 4 * nq));
}
__device__ __forceinline__ void cvt_fp8_store(const CvtSrc& c, int lane, const f32x4 (&v)[16]) {
    const int nq = lane & 7, kg = lane >> 3; const float sc = c.sc;
    const int n = c.n0 + 4 * nq; const int dr = c.gu ? c.rbase + (n >> 7) * 256 + (n & 127) : c.rbase + n;
    fp8_t* dst = c.WT + (size_t)dr * c.ldt + c.k0 + 16 * kg;
#pragma unroll
    for (int j = 0; j < 4; ++j) { u32x4 o;
        o.x = pk4_fp8(v[0][j] * sc, v[1][j] * sc, v[2][j] * sc, v[3][j] * sc); o.y = pk4_fp8(v[4][j] * sc, v[5][j] * sc, v[6][j] * sc, v[7][j] * sc);
        o.z = pk4_fp8(v[8][j] * sc, v[9][j] * sc, v[10][j] * sc, v[11][j] * sc); o.w = pk4_fp8(v[12][j] * sc, v[13][j] * sc, v[14][j] * sc, v[15][j] * sc);
        nts(o, (u32x4*)(dst + (size_t)j * c.ldt)); }
}
__device__ __forceinline__ float calib_scale(const float* W, LAS float* red, int tid) {
    float mx = 0.f;
#pragma unroll
    for (int i = 0; i < 8; ++i) { const f32x4 v = ((const f32x4*)W)[tid + NTHR * i]; mx = fmaxf(mx, fmaxf(fmaxf(fabsf(v[0]), fabsf(v[1])), fmaxf(fabsf(v[2]), fabsf(v[3])))); }
#pragma unroll
    for (int o = 1; o < 64; o <<= 1) mx = fmaxf(mx, __shfl_xor(mx, o));
    __syncthreads();
    if ((tid & 63) == 0) red[tid >> 6] = mx;
    __syncthreads();
    mx = fmaxf(fmaxf(fmaxf(red[0], red[1]), fmaxf(red[2], red[3])), fmaxf(fmaxf(red[4], red[5]), fmaxf(red[6], red[7])));
    __syncthreads();
    float e = rintf(log2f(32.f / fmaxf(mx, 1e-30f))); e = fminf(fmaxf(e, -40.f), 40.f);
    return exp2f(e);
}
__device__ __forceinline__ void phase_convert_moe(const FastP& p, LAS unsigned char* lds, int i0, int i1, int bw, int nbw, int wid) {
    const int tid = ltid(wid); const int wave = __builtin_amdgcn_readfirstlane(tid >> 6), lane = tid & 63;
    const float sg = calib_scale(p.w_gate, (LAS float*)lds, tid), su = calib_scale(p.w_up, (LAS float*)lds, tid), sd = calib_scale(p.w_down, (LAS float*)lds, tid);
    if (i0 == 0 && bw == 0 && tid == 0) { p.wsc[0] = sg; p.wsc[1] = su; p.wsc[2] = sd; p.wsc[4] = 1.f / sg; p.wsc[5] = 1.f / su; p.wsc[6] = 1.f / sd; }
    const int gw = i0 + bw * 8 + wave, NGW = nbw * 8; const int NIT = i1;
    constexpr int IGU = 8 * 88, ID = 22 * 32;
#define CVT_DESC(it_, c_) do { const int e_ = (it_) / (2 * IGU + ID); int r_ = (it_) % (2 * IGU + ID); \
        if (r_ < IGU) { c_.W = p.w_gate + (size_t)e_ * D * FF; c_.N = FF; c_.WT = p.WguT; c_.ldt = D; c_.rbase = e_ * 5632; c_.gu = 1; c_.sc = sg; c_.k0 = 128 * (r_ / 88); c_.n0 = 32 * (r_ % 88); } \
        else if (r_ < 2 * IGU) { r_ -= IGU; c_.W = p.w_up + (size_t)e_ * D * FF; c_.N = FF; c_.WT = p.WguT; c_.ldt = D; c_.rbase = e_ * 5632 + 128; c_.gu = 1; c_.sc = su; c_.k0 = 128 * (r_ / 88); c_.n0 = 32 * (r_ % 88); } \
        else { r_ -= 2 * IGU; c_.W = p.w_down + (size_t)e_ * FF * D; c_.N = D; c_.WT = p.WdT; c_.ldt = FF; c_.rbase = e_ * D; c_.gu = 0; c_.sc = sd; c_.k0 = 128 * (r_ / 32); c_.n0 = 32 * (r_ % 32); } } while (0)
    CvtSrc cur, nxt; f32x4 va[16], vb[16];
    if (gw < NIT) { CVT_DESC(gw, cur); cvt_fp8_load(cur, lane, va); }
    for (int it = gw; it < NIT; it += 2 * NGW) {
        const bool h1 = it + NGW < NIT, h2 = it + 2 * NGW < NIT;
        if (h1) { CVT_DESC(it + NGW, nxt); cvt_fp8_load(nxt, lane, vb); }
        cvt_fp8_store(cur, lane, va);
        if (h2) { CVT_DESC(it + 2 * NGW, cur); cvt_fp8_load(cur, lane, va); }
        if (h1) cvt_fp8_store(nxt, lane, vb);
    }
#undef CVT_DESC
}
struct CvtSide {
    static constexpr bool ON = true;
    const float *wg, *wu, *wd; fp8_t *WguT, *WdT; float sg, su, sd;
    int it, iend, istep, q, pend, tc, skip;
    const float* Wp; fp8_t* Tp; int N, ldt; float sc;
    f32x4 cv[4]; u32x4 co[4];
    __device__ __forceinline__ void desc() {
        constexpr int IGU = 8 * 88, ID = 22 * 32;
        const int e = it / (2 * IGU + ID); int r = it % (2 * IGU + ID);
        if (r < 2 * IGU) { const int up = r >= IGU; r -= up * IGU; const int k0 = 128 * (r / 88), n0 = 32 * (r % 88);
            Wp = (up ? wu : wg) + (size_t)e * D * FF + (size_t)k0 * FF + n0; N = FF; ldt = D; sc = up ? su : sg;
            Tp = WguT + (size_t)(e * 5632 + up * 128 + (n0 >> 7) * 256 + (n0 & 127)) * D + k0; }
        else { r -= 2 * IGU; const int k0 = 128 * (r / 32), n0 = 32 * (r % 32);
            Wp = wd + (size_t)e * FF * D + (size_t)k0 * D + n0; N = D; ldt = FF; sc = sd;
            Tp = WdT + (size_t)(e * D + n0) * FF + k0; }
    }
    __device__ __forceinline__ void init(const FastP& p, float sg_, float su_, float sd_, int first, int step_, int end_) {
        wg = p.w_gate; wu = p.w_up; wd = p.w_down; WguT = p.WguT; WdT = p.WdT; sg = sg_; su = su_; sd = sd_;
        it = first; istep = step_; iend = end_; q = 0; pend = 0; tc = 0; skip = 1; Wp = wg; Tp = WguT; N = FF; ldt = D; sc = sg_;
        if (it < iend) desc();
    }
    __device__ __forceinline__ bool busy() const { return it < iend; }
    __device__ __forceinline__ int issue(const int wv) {
        if (it >= iend) { pend = 0; return 0; }
        if (skip && (++tc & 3) == 0) { pend = 0; return 0; }
        const int lane = ltid(wv) & 63, nq = lane & 7, kg = lane >> 3;
        const unsigned voff = (unsigned)((16 * kg + 4 * q) * N + 4 * nq) * 4u;
#pragma unroll
        for (int i = 0; i < 4; ++i) { const float* b = Wp + (size_t)i * N; asm volatile("global_load_dwordx4 %0, %1, %2 nt" : "=v"(cv[i]) : "v"(voff), "s"(b) : "memory"); }
        pend = 1; return 4;
    }
    template <int INLOOP> __device__ __forceinline__ int finish(const int wv) {
        if (!pend) return 0;
        if constexpr (INLOOP) asm volatile("s_waitcnt vmcnt(6)" : "+v"(cv[0]), "+v"(cv[1]), "+v"(cv[2]), "+v"(cv[3]) :: "memory");
        else asm volatile("s_waitcnt vmcnt(0)" : "+v"(cv[0]), "+v"(cv[1]), "+v"(cv[2]), "+v"(cv[3]) :: "memory");
#pragma unroll
        for (int j = 0; j < 4; ++j) { co[j].x = co[j].y; co[j].y = co[j].z; co[j].z = co[j].w; co[j].w = pk4_fp8(cv[0][j] * sc, cv[1][j] * sc, cv[2][j] * sc, cv[3][j] * sc); }
        pend = 0;
        if (++q < 4) return 0;
        const int lane = ltid(wv) & 63, nq = lane & 7, kg = lane >> 3;
        fp8_t* dst = Tp + (unsigned)(4 * nq * ldt + 16 * kg);
#pragma unroll
        for (int j = 0; j < 4; ++j) nts(co[j], (u32x4*)(dst + (size_t)j * ldt));
        it += istep; q = 0;
        if (it < iend) desc();
        return 4;
    }
};
struct RmWin { __device__ __forceinline__ int operator()(int n) const {
    if (n >= INC || (n >= 2048 && n < 2064)) return -1;
    const int f = n < 2048 ? n : n - 16; const int region = f >> 9, h = (f >> 7) & 3; int o = f & 127;
    if (region == 4 || region == 5) { const int half = o >> 6, oo = o & 63; o = half * 64 + ((oo & 31) << 1) + (oo >> 5); }
    return region * 512 + h * 128 + o; } };
struct FastQ {
    const float *x, *ctx, *c, *c_ctx, *w_ada, *b_ada, *norm1_w, *w_in, *w_out, *mnw, *rnw, *w_router, *norm2_w;
    float *mod, *ropetab, *G, *normw, *wsc2, *biasr; bf16_t* WrT;
    float *_unused0; bf16_t *WinT, *WoutT, *XN, *Pb;
};
__device__ __forceinline__ void phase_mod(const FastQ& p, LAS unsigned char* lds, int bid, int nb, int wid) {
    LAS float* sv = (LAS float*)lds; LAS float* red = sv + 5 * 1024;
    const int tid = ltid(wid);
    for (int i = tid; i < 5 * 1024; i += NTHR) { const int r = i >> 10, k = i & 1023; const float v = r < 4 ? p.c[r * 1024 + k] : p.c_ctx[k]; sv[i] = v / (1.f + expf(-v)); }
    __syncthreads();
    for (int cb = bid; cb < 192; cb += nb) {
        const int cl = tid & 31, kg = tid >> 5, col = cb * 32 + cl;
        float a0 = 0, a1 = 0, a2 = 0, a3 = 0, a4 = 0;
#pragma unroll 32
        for (int kk = 0; kk < 64; ++kk) { const int k = kg * 64 + kk; const float w = ntl(p.w_ada + (size_t)k * 6144 + col); a0 += sv[k] * w; a1 += sv[1024 + k] * w; a2 += sv[2048 + k] * w; a3 += sv[3072 + k] * w; a4 += sv[4096 + k] * w; }
        red[(kg * 5 + 0) * 32 + cl] = a0; red[(kg * 5 + 1) * 32 + cl] = a1; red[(kg * 5 + 2) * 32 + cl] = a2; red[(kg * 5 + 3) * 32 + cl] = a3; red[(kg * 5 + 4) * 32 + cl] = a4;
        __syncthreads();
        if (tid < 160) { const int r = tid >> 5, c2 = tid & 31; float sum = 0.f; for (int g = 0; g < 16; ++g) sum += red[(g * 5 + r) * 32 + c2]; p.mod[r * 6144 + cb * 32 + c2] = sum + p.b_ada[cb * 32 + c2]; }
        __syncthreads();
    }
    for (int i = bid * NTHR + tid; i < 1024; i += nb * NTHR) p.normw[i] = i < 512 ? p.mnw[i] : p.rnw[i - 512];
    for (int i = bid * NTHR + tid; i < 16 * 1024; i += nb * NTHR) { const int e = i >> 10, k = i & 1023; p.WrT[i] = (bf16_t)f2bf(p.w_router[k * 16 + e]); }
    for (int i = bid * NTHR + tid; i < 2048; i += nb * NTHR) { const int pos = i >> 5, f = i & 31; const float ang = (float)pos * powf(10000.f, -(float)f / 32.f); p.ropetab[2 * i] = cosf(ang); p.ropetab[2 * i + 1] = sinf(ang); }
}
__device__ __forceinline__ void phase_convert_small(const FastQ& p, LAS unsigned char* lds, int bid, int nb, int wid) {
    const int tid = ltid(wid); const int wave = __builtin_amdgcn_readfirstlane(tid >> 6), lane = tid & 63;
    const int gw = bid * 8 + wave, NGW = nb * 8;
    constexpr int IIN = 16 * 129, IOUT = 16 * 32;
    for (int it = gw; it < IIN + IOUT; it += NGW) {
        if (it < IIN) cvt_item(p.w_in, INC, p.WinT, D, it / 129, it % 129, lane, RmWin{});
        else { const int r = it - IIN; cvt_item(p.w_out, D, p.WoutT, D, r / 32, r % 32, lane, RmLin{0}); }
    }
}
#define ROWDOT16(g, hh, wr) do { const f32x4 w0 = (wr)[0], w1 = (wr)[1], w2 = (wr)[2], w3 = (wr)[3]; \
    g[0] += hh * w0[0]; g[1] += hh * w0[1]; g[2] += hh * w0[2]; g[3] += hh * w0[3]; g[4] += hh * w1[0]; g[5] += hh * w1[1]; g[6] += hh * w1[2]; g[7] += hh * w1[3]; \
    g[8] += hh * w2[0]; g[9] += hh * w2[1]; g[10] += hh * w2[2]; g[11] += hh * w2[3]; g[12] += hh * w3[0]; g[13] += hh * w3[1]; g[14] += hh * w3[2]; g[15] += hh * w3[3]; } while (0)
__device__ __forceinline__ float reduce16x64(float (&g)[16], int lane) {
#pragma unroll
    for (int j = 0; j < 16; ++j) g[j] += __shfl_xor(g[j], 32);
    float g1[8], g2[4], g3[2];
    { const bool hi = lane & 16;
#pragma unroll
      for (int j = 0; j < 8; ++j) { const float mine = hi ? g[j + 8] : g[j], theirs = hi ? g[j] : g[j + 8]; g1[j] = mine + __shfl_xor(theirs, 16); } }
    { const bool hi = lane & 8;
#pragma unroll
      for (int j = 0; j < 4; ++j) { const float mine = hi ? g1[j + 4] : g1[j], theirs = hi ? g1[j] : g1[j + 4]; g2[j] = mine + __shfl_xor(theirs, 8); } }
    { const bool hi = lane & 4;
#pragma unroll
      for (int j = 0; j < 2; ++j) { const float mine = hi ? g2[j + 2] : g2[j], theirs = hi ? g2[j] : g2[j + 2]; g3[j] = mine + __shfl_xor(theirs, 4); } }
    float r; { const bool hi = lane & 2; const float mine = hi ? g3[1] : g3[0], theirs = hi ? g3[0] : g3[1]; r = mine + __shfl_xor(theirs, 2); }
    r += __shfl_xor(r, 1);
    return r;
}
__device__ __forceinline__ void phase_norm1(const FastQ& p, LAS unsigned char* lds, int bid, int nb, int wid) {
    LAS float* wg = (LAS float*)lds;
    const int tid = ltid(wid), wave = __builtin_amdgcn_readfirstlane(tid >> 6), lane = tid & 63;
#pragma unroll
    for (int i = tid; i < 1024 * 4; i += NTHR) { const int k = i >> 2, j = i & 3; *(LAS f32x4*)(wg + k * 20 + (k >> 4) * 4 + 4 * j) = *(const f32x4*)(p.w_in + (size_t)k * INC + 2048 + 4 * j); }
    __syncthreads();
    if (bid < NB) {
        const float* md = p.mod + bid * 6144;
        for (int k = tid; k < D; k += NTHR) p.wsc2[bid * D + k] = p.norm2_w[k] * (1.f + md[4096 + k]);
        LAS float* part = wg + 1024 * 20 + 512;
        { const int e = tid & 15, kg = tid >> 4; float a = 0.f; for (int k = kg * 32; k < kg * 32 + 32; ++k) a += md[3072 + k] * p.w_router[k * 16 + e]; part[kg * 16 + e] = a; }
        __syncthreads();
        if (tid < 16) { float a = 0.f; for (int g2 = 0; g2 < 32; ++g2) a += part[g2 * 16 + tid]; p.biasr[bid * 16 + tid] = a; }
    }
    const int gw = bid * 8 + wave, NGW = nb * 8;
#define N1_SRC(r_) ((r_) < ML ? p.x + (size_t)(r_) * D : p.ctx + (size_t)((r_) - ML) * D)
    f32x4 nv[4];
    if (gw < MA) { const float* src = N1_SRC(gw) + 16 * lane;
#pragma unroll
        for (int i = 0; i < 4; ++i) nv[i] = ntl((const f32x4*)(src + 4 * i)); }
    for (int row = gw; row < MA; row += NGW) {
        f32x4 v[4];
#pragma unroll
        for (int i = 0; i < 4; ++i) v[i] = nv[i];
        if (row + NGW < MA) { const int lane2 = ltid(wid) & 63; const float* src = N1_SRC(row + NGW) + 16 * lane2;
#pragma unroll
            for (int i = 0; i < 4; ++i) nv[i] = ntl((const f32x4*)(src + 4 * i)); }
        const float* md = p.mod + (row < ML ? (row >> 12) : 4) * 6144 + 16 * lane; const float* nw = p.norm1_w + 16 * lane;
        float ss0 = 0.f;
#pragma unroll
        for (int i = 0; i < 4; ++i) ss0 += (v[i][0] * v[i][0] + v[i][1] * v[i][1]) + (v[i][2] * v[i][2] + v[i][3] * v[i][3]);
#pragma unroll
        for (int o = 1; o < 64; o <<= 1) ss0 += __shfl_xor(ss0, o);
        const float rstd0 = rsqrtf(ss0 * (1.f / D) + EPS);
        float g0[16];
#pragma unroll
        for (int j = 0; j < 16; ++j) g0[j] = 0.f;
        u32x4 pk0[2];
#pragma unroll
        for (int i = 0; i < 4; ++i) {
            asm volatile("" ::: "memory");
            const f32x4 w4 = *(const f32x4*)(nw + 4 * i), s4 = *(const f32x4*)(md + 1024 + 4 * i) + 1.f, h4 = *(const f32x4*)(md + 4 * i);
            const f32x4 ha = v[i] * rstd0 * w4 * s4 + h4;
            pk0[i >> 1][(i & 1) * 2] = cvt_pk_bf16(ha[0], ha[1]); pk0[i >> 1][(i & 1) * 2 + 1] = cvt_pk_bf16(ha[2], ha[3]);
#pragma unroll
            for (int c = 0; c < 4; ++c) { const float x0 = ha[c]; const LAS f32x4* wr = (const LAS f32x4*)(wg + (16 * lane + 4 * i + c) * 20 + lane * 4);
                const f32x4 w0 = wr[0], w1 = wr[1], w2 = wr[2], w3 = wr[3];
                g0[0] += x0 * w0[0]; g0[1] += x0 * w0[1]; g0[2] += x0 * w0[2]; g0[3] += x0 * w0[3]; g0[4] += x0 * w1[0]; g0[5] += x0 * w1[1]; g0[6] += x0 * w1[2]; g0[7] += x0 * w1[3];
                g0[8] += x0 * w2[0]; g0[9] += x0 * w2[1]; g0[10] += x0 * w2[2]; g0[11] += x0 * w2[3]; g0[12] += x0 * w3[0]; g0[13] += x0 * w3[1]; g0[14] += x0 * w3[2]; g0[15] += x0 * w3[3];
                if (c & 1) asm volatile("" ::: "memory"); }
        }
        { u32x4* xo = (u32x4*)(p.XN + (size_t)row * D + 16 * lane); xo[0] = pk0[0]; xo[1] = pk0[1]; }
        const float s0 = reduce16x64(g0, lane);
        if ((lane & 33) == 0) p.G[(size_t)row * 16 + (lane >> 1)] = s0;
    }
#undef N1_SRC
}
struct SchedInProj {
    const char* XN; const char* W; int G, c;
    __device__ __forceinline__ bool next(int i, pg8::Unit& u) const {
        const int L = i * G + c; if (L >= 1056) return false;
        if (L < 1024) { const int x = L & 7, uu = L >> 3; u.pm = 8 * x + (uu & 7); u.pn = uu >> 3; }
        else { const int r = L - 1024; u.pm = 64 + (r & 3); const int q = r >> 2; u.pn = (q < 4 ? 2 : 6) + q; }
        u.aux = 0; u.lrows = -1; u.arows = nullptr;
        u.a = XN + (size_t)u.pm * 256 * (D * 2); u.b = W + (size_t)u.pn * 256 * (D * 2);
        return true;
    }
};
struct EpiInProj {
    static constexpr bool PERM = true, AFTER_DRAIN = false;
    bf16_t* P; const float* tab;
    __device__ __forceinline__ void operator()(const f32x4 (&acc)[2][2][4][2], const pg8::Unit& u, int wr, int wc, int fr, int fq) const {
        const int row0 = u.pm * 256 + wr * 64 + fr, col0 = u.pn * 256 + wc * 32 + 8 * fq;
        const bool kcol = (u.pn == 2 || u.pn == 3 || u.pn == 10 || u.pn == 11);
        const float sc = kcol ? 0.08838834764831845f : 1.f;
        const bool rope = (u.pn >= 8 && u.pn < 12 && u.pm < 64);
        const int fbase = (wc & 1) * 16 + 4 * fq;
#pragma unroll
        for (int ai = 0; ai < 2; ++ai)
#pragma unroll
            for (int m = 0; m < 4; ++m) {
                const int r = row0 + ai * 128 + m * 16;
                f32x4 cs0 = (f32x4){1.f, 0.f, 1.f, 0.f}, cs1 = cs0;
                if (rope) { const int t = r & 4095; const int pos = (wc >> 1) ? (t & 63) : (t >> 6); const f32x4* tp = (const f32x4*)(tab + 2 * (pos * 32 + fbase)); cs0 = tp[0]; cs1 = tp[1]; }
#pragma unroll
                for (int bj = 0; bj < 2; ++bj) {
                    f32x4 v0 = acc[ai][bj][m][0] * sc, v1 = acc[ai][bj][m][1] * sc;
                    if (rope) {
                        const f32x4 a = v0, b = v1;
                        v0[0] = a[0] * cs0[0] - a[1] * cs0[1]; v0[1] = a[0] * cs0[1] + a[1] * cs0[0]; v0[2] = a[2] * cs0[2] - a[3] * cs0[3]; v0[3] = a[2] * cs0[3] + a[3] * cs0[2];
                        v1[0] = b[0] * cs1[0] - b[1] * cs1[1]; v1[1] = b[0] * cs1[1] + b[1] * cs1[0]; v1[2] = b[2] * cs1[2] - b[3] * cs1[3]; v1[3] = b[2] * cs1[3] + b[3] * cs1[2];
                    }
                    u32x4 w; w.x = cvt_pk_bf16(v0[0], v0[1]); w.y = cvt_pk_bf16(v0[2], v0[3]); w.z = cvt_pk_bf16(v1[0], v1[1]); w.w = cvt_pk_bf16(v1[2], v1[3]);
                    *(u32x4*)(P + (size_t)r * PBC + col0 + bj * 128) = w;
                }
            }
    }
};

typedef short s16x4 __attribute__((ext_vector_type(4)));
constexpr int NCH = 34;
constexpr int RS_QK = 272, RS_V = 304;
struct MixP {
    const bf16_t* Pb; const float* G; const float* gate_bias; const float* decay_logit; const float* normw;
    bf16_t* ST; float* NV; float* SC; bf16_t* YM;
};
__device__ __forceinline__ size_t mix_row(int b, int ch, int p) { return ch < 32 ? (size_t)b * T + ch * 128 + p : (size_t)ML + b * TC + (ch - 32) * 128 + p; }
__device__ __forceinline__ bf16x8 tr_frag(const LAS unsigned char* pl, int rs) {
    const s16x4 lo = __builtin_amdgcn_ds_read_tr16_b64_v4i16((LAS s16x4*)(pl));
    const s16x4 hi = __builtin_amdgcn_ds_read_tr16_b64_v4i16((LAS s16x4*)(pl + 4 * rs));
    return __builtin_shufflevector(lo, hi, 0, 1, 2, 3, 4, 5, 6, 7);
}
__device__ __forceinline__ void stage128(LAS unsigned char* dst, int rs, const bf16_t* src, size_t gstride, int wid) {
    const int t = ltid(wid), r = t >> 2;
#pragma unroll
    for (int j = 0; j < 4; ++j) { const int c = (j * 4 + (t & 3)) * 8; const u32x4 v = *(const u32x4*)(src + (size_t)r * gstride + c); *(LAS u32x4*)(dst + r * rs + c * 2) = v; }
}
template <int OP> __device__ __forceinline__ float scan_fb(float x, int tid, LAS float* tot) {
    const int lane = tid & 63, w = tid >> 6;
    if (w < 2) {
#pragma unroll
        for (int o = 1; o < 64; o <<= 1) { const float t = __shfl_up(x, o); if (lane >= o) x = OP ? fmaxf(x, t) : x + t; }
    } else if (w < 4) {
#pragma unroll
        for (int o = 1; o < 64; o <<= 1) { const float t = __shfl_down(x, o); if (lane + o < 64) x = OP ? fmaxf(x, t) : x + t; }
    }
    if (tid == 63) tot[0] = x;
    if (tid == 192) tot[1] = x;
    __syncthreads();
    if (w == 1) x = OP ? fmaxf(x, tot[0]) : x + tot[0];
    if (w == 2) x = OP ? fmaxf(x, tot[1]) : x + tot[1];
    __syncthreads();
    return x;
}
__device__ __forceinline__ void gate_load(const MixP& p, int kind, int b, int h, int ch, int tid, float& ig, float& lf) {
    ig = 0.f; lf = 0.f;
    if (tid < 256) {
        const int pq = tid & 127, dirb = tid >> 7;
        if (kind == 0) { const float* g = p.G + mix_row(b, ch, pq) * 16; ig = g[dirb * 4 + h] + p.gate_bias[dirb * 4 + h]; lf = g[8 + dirb * 4 + h] + p.gate_bias[8 + dirb * 4 + h]; }
        else lf = p.decay_logit[dirb * 4 + h];
    }
}
__device__ __forceinline__ void gate_scan(float ig, float lfraw, int tid, LAS float* tot, float& bb, float& aa, float& cm) {
    const float lf = tid < 256 ? logsigmoidf_(lfraw) : 0.f;
    bb = scan_fb<0>(lf, tid, tot);
    aa = ig - bb;
    cm = scan_fb<1>(aa, tid, tot);
}

__device__ __forceinline__ void phase_mixA(const MixP& p, LAS unsigned char* lds, int bid, int nb, int wid) {
    LAS unsigned char* Kimg = lds; LAS unsigned char* VF = lds + 34816; LAS unsigned char* VB = VF + 38912;
    LAS float* arr = (LAS float*)(VB + 38912);
    LAS float *wF = arr, *wB = arr + 128, *tot = arr + 256, *amx = arr + 260;
    const int tid = ltid(wid), wave = __builtin_amdgcn_readfirstlane(tid >> 6), lane = tid & 63, g = lane >> 4, i16 = lane & 15, q = i16 >> 2, pp = i16 & 3;
    const int r = tid >> 2; constexpr int NTILE = 2 * 16 * NCH;
    u32x4 kv[4], vv[4]; float ig = 0.f, lfr = 0.f;
#define MIXA_LOAD(tile_, KV, VV, IG, LF) do { const int ch_ = (tile_) % NCH, h_ = ((tile_) / NCH) & 3, b_ = ((tile_) / (NCH * 4)) & 3, kind_ = (tile_) / (NCH * 16); const size_t row0_ = mix_row(b_, ch_, 0); \
        const bf16_t* ksrc = p.Pb + (row0_ + r) * PBC + (kind_ ? PB_RK : PB_MK) + h_ * 128; const bf16_t* vsrc = p.Pb + (row0_ + r) * PBC + (kind_ ? PB_RV : PB_MV) + h_ * 128; \
        _Pragma("unroll") for (int j = 0; j < 4; ++j) { const int c = (j * 4 + (tid & 3)) * 8; KV[j] = *(const u32x4*)(ksrc + c); VV[j] = *(const u32x4*)(vsrc + c); } \
        gate_load(p, kind_, b_, h_, ch_, tid, IG, LF); } while (0)
    if (bid < NTILE) MIXA_LOAD(bid, kv, vv, ig, lfr);
    for (int tile = bid; tile < NTILE; tile += nb) {
        u32x4 kv2[4], vv2[4]; float ig2 = 0.f, lfr2 = 0.f;
        if (tile + nb < NTILE) MIXA_LOAD(tile + nb, kv2, vv2, ig2, lfr2);
        else {
#pragma unroll
            for (int j = 0; j < 4; ++j) { kv2[j] = kv[j]; vv2[j] = vv[j]; } }
        float bb, aa, cm; gate_scan(ig, lfr, tid, tot, bb, aa, cm);
        if (tid == 127) { amx[0] = cm; float* sc = p.SC + ((size_t)tile * 2 + 0) * 4; sc[0] = bb; sc[1] = cm; }
        if (tid == 128) { amx[1] = cm; float* sc = p.SC + ((size_t)tile * 2 + 1) * 4; sc[0] = bb; sc[1] = cm; }
        __syncthreads();
        if (tid < 256) (tid < 128 ? wF : wB)[tid & 127] = __expf(aa - amx[tid >> 7]);
#pragma unroll
        for (int j = 0; j < 4; ++j) { const int c = (j * 4 + (tid & 3)) * 8; *(LAS u32x4*)(Kimg + r * RS_QK + c * 2) = kv[j]; }
        __syncthreads();
        {
            const float wf = wF[r], wb = wB[r];
#pragma unroll
            for (int j = 0; j < 4; ++j) { const int c = (j * 4 + (tid & 3)) * 8; const u32x4 v = vv[j]; u32x4 of, ob;
#pragma unroll
                for (int e = 0; e < 4; ++e) { const float lo = __uint_as_float(v[e] << 16), hi = __uint_as_float(v[e] & 0xffff0000u); of[e] = cvt_pk_bf16(lo * wf, hi * wf); ob[e] = cvt_pk_bf16(lo * wb, hi * wb); }
                *(LAS u32x4*)(VF + r * RS_V + c * 2) = of; *(LAS u32x4*)(VB + r * RS_V + c * 2) = ob; }
            if (tid < 256) { const int rr = tid & 127; LAS unsigned char* V = tid < 128 ? VF : VB; const float w = (tid < 128 ? wF : wB)[rr];
                *(LAS u32x4*)(V + rr * RS_V + 256) = (u32x4){f2bf(w), 0u, 0u, 0u}; *(LAS u32x4*)(V + rr * RS_V + 272) = (u32x4){0u, 0u, 0u, 0u}; }
        }
        __syncthreads();
        const int dir = wave >> 2, kb = wave & 3; const LAS unsigned char* V = dir ? VB : VF;
        f32x4 acc[2][9];
#pragma unroll
        for (int mi = 0; mi < 2; ++mi)
#pragma unroll
            for (int ni = 0; ni < 9; ++ni) acc[mi][ni] = (f32x4){0.f, 0.f, 0.f, 0.f};
#pragma unroll
        for (int ks = 0; ks < 4; ++ks) {
            const int srow = 32 * ks + 8 * g + q;
            bf16x8 a[2];
#pragma unroll
            for (int mi = 0; mi < 2; ++mi) a[mi] = tr_frag(Kimg + srow * RS_QK + (32 * kb + 16 * mi + 4 * pp) * 2, RS_QK);
#pragma unroll
            for (int ni = 0; ni < 9; ++ni) { const bf16x8 bv = tr_frag(V + srow * RS_V + (16 * ni + 4 * pp) * 2, RS_V);
#pragma unroll
                for (int mi = 0; mi < 2; ++mi) acc[mi][ni] = __builtin_amdgcn_mfma_f32_16x16x32_bf16(a[mi], bv, acc[mi][ni], 0, 0, 0); }
        }
        bf16_t* st = p.ST + ((size_t)tile * 2 + dir) * 16384;
#pragma unroll
        for (int mi = 0; mi < 2; ++mi) { const int k0 = 32 * kb + 16 * mi + 4 * g;
#pragma unroll
            for (int ni = 0; ni < 8; ++ni) { const f32x4 v = acc[mi][ni]; u32x2 o; o.x = pk2(v[0], v[1]); o.y = pk2(v[2], v[3]); *(u32x2*)(st + (size_t)(16 * ni + i16) * 128 + k0) = o; }
            if (i16 == 0) *(f32x4*)(p.NV + ((size_t)tile * 2 + dir) * 128 + k0) = acc[mi][8]; }
#pragma unroll
        for (int j = 0; j < 4; ++j) { kv[j] = kv2[j]; vv[j] = vv2[j]; }
        ig = ig2; lfr = lfr2;
        __syncthreads();
    }
#undef MIXA_LOAD
}

__device__ __forceinline__ void phase_mixB(const MixP& p, int bid, int nb, int wid) {
    for (int w = bid * NTHR + ltid(wid); w < 64 * 2048; w += nb * NTHR) {
        const int combo = w >> 11, e = w & 2047, v = e >> 4, k0 = (e & 15) * 8;
        const int dir = combo & 1, h = (combo >> 1) & 3, b = (combo >> 3) & 3, kind = combo >> 5;
        const int tb = ((kind * 4 + b) * 4 + h) * NCH;
        float C[8], n[8];
#pragma unroll
        for (int j = 0; j < 8; ++j) { C[j] = 0.f; n[j] = 0.f; }
        float m = 0.f;
#pragma unroll 1
        for (int jb = 0; jb < NCH; jb += 17) {
            u32x4 U[17];
#pragma unroll
            for (int jj = 0; jj < 17; ++jj) { const int j = jb + jj; const int ch = dir ? 33 - j : (j < 2 ? 32 + j : j - 2); U[jj] = ntl((const u32x4*)(p.ST + ((size_t)(tb + ch) * 2 + dir) * 16384 + v * 128 + k0)); }
#pragma unroll
            for (int jj = 0; jj < 17; ++jj) {
                const int j = jb + jj; const int ch = dir ? 33 - j : (j < 2 ? 32 + j : j - 2);
                const size_t td = (size_t)(tb + ch) * 2 + dir;
                float* sc = p.SC + td * 4; const float bL = sc[0], amax = sc[1];
                float mn, alpha, beta;
                if (kind == 0) { mn = fmaxf(bL + m, bL + amax); alpha = expf(bL + m - mn); beta = expf(bL + amax - mn); } else { mn = 0.f; alpha = expf(bL); beta = expf(bL + amax); }
                u32x4 o; o.x = pk2(C[0], C[1]); o.y = pk2(C[2], C[3]); o.z = pk2(C[4], C[5]); o.w = pk2(C[6], C[7]);
                *(u32x4*)(p.ST + td * 16384 + v * 128 + k0) = o;
                if (e == 0) sc[2] = m;
#pragma unroll
                for (int q = 0; q < 4; ++q) { C[2 * q] = alpha * C[2 * q] + beta * __uint_as_float(U[jj][q] << 16); C[2 * q + 1] = alpha * C[2 * q + 1] + beta * __uint_as_float(U[jj][q] & 0xffff0000u); }
                if (v == 0) { float* nv = p.NV + td * 128 + k0; const f32x4 n0 = *(const f32x4*)nv, n1 = *(const f32x4*)(nv + 4);
                    *(f32x4*)nv = (f32x4){n[0], n[1], n[2], n[3]}; *(f32x4*)(nv + 4) = (f32x4){n[4], n[5], n[6], n[7]};
#pragma unroll
                    for (int q = 0; q < 4; ++q) { n[q] = alpha * n[q] + beta * n0[q]; n[4 + q] = alpha * n[4 + q] + beta * n1[q]; } }
                m = mn;
            }
        }
    }
}

__device__ __forceinline__ void phase_mixC(const MixP& p, LAS unsigned char* lds, int bid, int nb, int wid) {
    LAS unsigned char* Kimg = lds; LAS unsigned char* Vimg = lds + 34816; LAS unsigned char* CF = lds + 73728; LAS unsigned char* CB = lds + 112896;
    LAS float* Himg = (LAS float*)CF;
    LAS float* arr = (LAS float*)(lds + 152064);
    LAS float *aF = arr, *aB = arr + 128, *bF = arr + 256, *bB = arr + 384, *MF = arr + 512, *MB = arr + 640, *tot = arr + 768;
    int tid = ltid(wid); int sr = tid >> 2;
    u32x4 rk[4], rv[4]; float nf = 0.f, nbv = 0.f, ig = 0.f, lfr = 0.f, minF = 0.f, minB = 0.f;
#define MIXC_LOAD(tile_) do { const int ch_ = (tile_) & 31, h_ = ((tile_) >> 5) & 3, b_ = ((tile_) >> 7) & 3, kind_ = (tile_) >> 9; const int tA_ = ((kind_ * 4 + b_) * 4 + h_) * NCH + ch_; \
        const bf16_t* pr_ = p.Pb + ((size_t)b_ * T + ch_ * 128 + sr) * PBC + h_ * 128; \
        _Pragma("unroll") for (int j = 0; j < 4; ++j) { const int c = (j * 4 + (tid & 3)) * 8; rk[j] = *(const u32x4*)(pr_ + (kind_ ? PB_RK : PB_MK) + c); rv[j] = *(const u32x4*)(pr_ + (kind_ ? PB_RV : PB_MV) + c); } \
        if (tid < 128) { nf = p.NV[((size_t)tA_ * 2 + 0) * 128 + tid]; nbv = p.NV[((size_t)tA_ * 2 + 1) * 128 + tid]; } \
        gate_load(p, kind_, b_, h_, ch_, tid, ig, lfr); minF = p.SC[((size_t)tA_ * 2 + 0) * 4 + 2]; minB = p.SC[((size_t)tA_ * 2 + 1) * 4 + 2]; } while (0)
    u32x4 rc[8];
#define MIXC_LOADC(tile_) do { const int ch_ = (tile_) & 31, h_ = ((tile_) >> 5) & 3, b_ = ((tile_) >> 7) & 3, kind_ = (tile_) >> 9; const size_t tA_ = (size_t)(((kind_ * 4 + b_) * 4 + h_) * NCH + ch_); \
        const int t_ = ltid(wid); const bf16_t* cs_ = p.ST + tA_ * 2 * 16384 + (size_t)(t_ >> 2) * 128; \
        _Pragma("unroll") for (int j = 0; j < 4; ++j) { const int c = (j * 4 + (t_ & 3)) * 8; rc[j] = *(const u32x4*)(cs_ + c); rc[4 + j] = *(const u32x4*)(cs_ + 16384 + c); } } while (0)
    if (bid < 1024) { MIXC_LOAD(bid); MIXC_LOADC(bid); }
    for (int tile = bid; tile < 2 * 16 * 32; tile += nb) {
        tid = ltid(wid); sr = tid >> 2;
        const int wave = __builtin_amdgcn_readfirstlane(tid >> 6), lane = tid & 63, g = lane >> 4, i16 = lane & 15, q = i16 >> 2, pp = i16 & 3;
        const int ch = tile & 31, h = (tile >> 5) & 3, b = (tile >> 7) & 3, kind = tile >> 9;
        const size_t row0 = (size_t)b * T + ch * 128;
        const bf16_t* prow = p.Pb + row0 * PBC + h * 128;
        bf16x8 aq[4];
        { const bf16_t* qr = prow + (kind ? PB_RQ : PB_MQ) + (size_t)(16 * wave + i16) * PBC + 8 * g;
#pragma unroll
          for (int ks = 0; ks < 4; ++ks) aq[ks] = *(const bf16x8*)(qr + 32 * ks); }
#pragma unroll
        for (int j = 0; j < 4; ++j) { const int cby = (j * 4 + (tid & 3)) * 16; *(LAS u32x4*)(Kimg + sr * RS_QK + cby) = rk[j]; *(LAS u32x4*)(Vimg + sr * RS_V + cby) = rv[j]; }
#pragma unroll
        for (int j = 0; j < 4; ++j) { const int cby = (j * 4 + (tid & 3)) * 16; *(LAS u32x4*)(CF + sr * RS_QK + cby) = rc[j]; *(LAS u32x4*)(CB + sr * RS_QK + cby) = rc[4 + j]; }
        if (tid < 128) { *(LAS u32x4*)(Vimg + tid * RS_V + 256) = (u32x4){0x3F80u, 0u, 0u, 0u}; *(LAS u32x4*)(Vimg + tid * RS_V + 272) = (u32x4){0u, 0u, 0u, 0u};
            ((LAS unsigned short*)(CF + 128 * RS_QK))[tid] = (unsigned short)f2bf(nf); ((LAS unsigned short*)(CB + 128 * RS_QK))[tid] = (unsigned short)f2bf(nbv); }
        for (int z = tid; z < 15 * 68; z += NTHR) { ((LAS unsigned*)(CF + 129 * RS_QK))[z] = 0u; ((LAS unsigned*)(CB + 129 * RS_QK))[z] = 0u; }
        const float cminF = minF, cminB = minB;
        { float bb, aa, cm; gate_scan(ig, lfr, tid, tot, bb, aa, cm);
          if (tid < 256) { const int pq = tid & 127; (tid < 128 ? aF : aB)[pq] = aa; (tid < 128 ? bF : bB)[pq] = bb; (tid < 128 ? MF : MB)[pq] = kind == 0 ? fmaxf(cm, tid < 128 ? cminF : cminB) : -bb; } }
        if (tile + nb < 1024) MIXC_LOAD(tile + nb);
        f32x4 accF[9], accB[9];
#pragma unroll
        for (int ni = 0; ni < 9; ++ni) { accF[ni] = (f32x4){0.f, 0.f, 0.f, 0.f}; accB[ni] = (f32x4){0.f, 0.f, 0.f, 0.f}; }
#pragma unroll
        for (int ks = 0; ks < 4; ++ks) {
#pragma unroll
            for (int ni = 0; ni < 9; ++ni) { const bf16x8 bc = *(const LAS bf16x8*)(CF + (16 * ni + i16) * RS_QK + (32 * ks + 8 * g) * 2); accF[ni] = __builtin_amdgcn_mfma_f32_16x16x32_bf16(aq[ks], bc, accF[ni], 0, 0, 0); }
            asm volatile("" ::: "memory");
#pragma unroll
            for (int ni = 0; ni < 9; ++ni) { const bf16x8 bc = *(const LAS bf16x8*)(CB + (16 * ni + i16) * RS_QK + (32 * ks + 8 * g) * 2); accB[ni] = __builtin_amdgcn_mfma_f32_16x16x32_bf16(aq[ks], bc, accB[ni], 0, 0, 0); }
            asm volatile("" ::: "memory");
        }
        u32x4 ogv[4]; float nwv = 0.f;
        {
            const int tl = 16 * wave + i16;
            const float MtF = MF[tl], MtB = MB[tl];
#pragma unroll
            for (int r = 0; r < 4; ++r) { const int t = 16 * wave + 4 * g + r; const float iwF = __expf(cminF - MF[t]), iwB = __expf(cminB - MB[t]);
#pragma unroll
                for (int ni = 0; ni < 9; ++ni) { accF[ni][r] *= iwF; accB[ni][r] *= iwB; } }
#pragma unroll
            for (int ks = 0; ks < 4; ++ks) {
                u32x4 pF, pB;
#pragma unroll
                for (int hf = 0; hf < 2; ++hf) { const int nj = 2 * ks + hf;
                    f32x4 st = (f32x4){0.f, 0.f, 0.f, 0.f};
#pragma unroll
                    for (int k2 = 0; k2 < 4; ++k2) { const bf16x8 ak = *(const LAS bf16x8*)(Kimg + (16 * nj + i16) * RS_QK + (32 * k2 + 8 * g) * 2); st = __builtin_amdgcn_mfma_f32_16x16x32_bf16(ak, aq[k2], st, 0, 0, 0); }
                    const int s0 = 16 * nj + 4 * g; const f32x4 avF = *(const LAS f32x4*)(aF + s0), avB = *(const LAS f32x4*)(aB + s0); float pf[4], pb[4];
#pragma unroll
                    for (int r = 0; r < 4; ++r) { const int sx = s0 + r; pf[r] = sx <= tl ? st[r] * __expf(avF[r] - MtF) : 0.f; pb[r] = sx >= tl ? st[r] * __expf(avB[r] - MtB) : 0.f; }
                    pF[2 * hf] = cvt_pk_bf16(pf[0], pf[1]); pF[2 * hf + 1] = cvt_pk_bf16(pf[2], pf[3]); pB[2 * hf] = cvt_pk_bf16(pb[0], pb[1]); pB[2 * hf + 1] = cvt_pk_bf16(pb[2], pb[3]); }
                const bf16x8 apF = __builtin_bit_cast(bf16x8, pF), apB = __builtin_bit_cast(bf16x8, pB);
#pragma unroll
                for (int ni = 0; ni < 9; ++ni) { const LAS unsigned char* pl = Vimg + (32 * ks + 4 * g + q) * RS_V + (16 * ni + 4 * pp) * 2;
                    const s16x4 lo = __builtin_amdgcn_ds_read_tr16_b64_v4i16((LAS s16x4*)(pl)), hi = __builtin_amdgcn_ds_read_tr16_b64_v4i16((LAS s16x4*)(pl + 16 * RS_V));
                    const bf16x8 bv = __builtin_bit_cast(bf16x8, __builtin_shufflevector(lo, hi, 0, 1, 2, 3, 4, 5, 6, 7));
                    accF[ni] = __builtin_amdgcn_mfma_f32_16x16x32_bf16(apF, bv, accF[ni], 0, 0, 0); accB[ni] = __builtin_amdgcn_mfma_f32_16x16x32_bf16(apB, bv, accB[ni], 0, 0, 0); }
                asm volatile("" ::: "memory");
            }
            { const int tid2 = ltid(wid); const u32x4* og = (const u32x4*)(p.Pb + (row0 + (tid2 >> 2)) * PBC + (kind ? PB_RO : PB_MO) + h * 128 + (tid2 & 3) * 32);
#pragma unroll
              for (int j = 0; j < 4; ++j) ogv[j] = og[j];
              if (tid2 < 128) nwv = p.normw[kind * 512 + h * 128 + tid2]; }
            if (kind == 0) {
#pragma unroll
                for (int r = 0; r < 4; ++r) { const int t = 16 * wave + 4 * g + r;
                    const float denF = __shfl(accF[8][r], lane & 48), denB = __shfl(accB[8][r], lane & 48);
                    const float invF = __builtin_amdgcn_rcpf(fmaxf(fabsf(denF), __expf(-(bF[t] + MF[t])))), invB = __builtin_amdgcn_rcpf(fmaxf(fabsf(denB), __expf(-(bB[t] + MB[t]))));
#pragma unroll
                    for (int ni = 0; ni < 8; ++ni) { accF[ni][r] *= invF; accB[ni][r] *= invB; } }
            }
            __syncthreads();
        }
        {
            const int tid2 = ltid(wid); const int t = tid2 >> 2, c0 = (tid2 & 3) * 32; const size_t row = row0 + t;
            LAS float* nwl = Himg + 128 * 132;
            if (tile + nb < 1024) MIXC_LOADC(tile + nb);
            if (tid2 < 128) nwl[tid2] = nwv;
#pragma unroll
            for (int r = 0; r < 4; ++r)
#pragma unroll
                for (int ni = 0; ni < 8; ++ni) Himg[(16 * wave + 4 * g + r) * 132 + 16 * ni + i16] = accF[ni][r] + accB[ni][r];
            __syncthreads();
            const LAS f32x4* hr = (const LAS f32x4*)(Himg + t * 132 + c0);
            f32x4 hv[8]; float ss = 0.f;
#pragma unroll
            for (int j = 0; j < 8; ++j) { hv[j] = hr[j]; ss += (hv[j][0] * hv[j][0] + hv[j][1] * hv[j][1]) + (hv[j][2] * hv[j][2] + hv[j][3] * hv[j][3]); }
            ss += __shfl_xor(ss, 1); ss += __shfl_xor(ss, 2);
            const float rn = rsqrtf(ss * (1.f / 128.f) + EPS);
            const LAS f32x4* nw = (const LAS f32x4*)(nwl + c0);
            u32x4* yo = (u32x4*)(p.YM + row * D + kind * 512 + h * 128 + c0);
#pragma unroll
            for (int j = 0; j < 4; ++j) { const u32x4 ov = ogv[j]; u32x4 o;
#pragma unroll
                for (int e = 0; e < 4; ++e) { const float o0 = __uint_as_float(ov[e] << 16), o1 = __uint_as_float(ov[e] & 0xffff0000u);
                    const float g0 = kind ? fast_silu(o0) : __builtin_amdgcn_rcpf(1.f + __expf(-o0)), g1 = kind ? fast_silu(o1) : __builtin_amdgcn_rcpf(1.f + __expf(-o1));
                    const int cc = 8 * j + 2 * e; const f32x4 hq = hv[cc >> 2]; const f32x4 wq = nw[cc >> 2];
                    o[e] = cvt_pk_bf16(g0 * hq[cc & 3] * rn * wq[cc & 3], g1 * hq[(cc & 3) + 1] * rn * wq[(cc & 3) + 1]); }
                yo[j] = o; }
        }
        __syncthreads();
    }
#undef MIXC_LOAD
#undef MIXC_LOADC
}
struct TailP {
    const float *x, *mod, *norm2_w, *w_router, *final_w, *wsc2, *biasr; const bf16_t *YM, *WoutT, *Ys, *WrT;
    bf16_t* xl; float *aff, *gate, *out, *xrec; fp8_t* H2; int *idx, *slotmap; unsigned* bar;
};
struct SchedOutProj {
    const char* A; const char* W; int G, c;
    __device__ __forceinline__ bool next(int i, pg8::Unit& u) const {
        const int L = i * G + c; if (L >= 256) return false;
        const int x = L & 7, uu = L >> 3; u.pm = 8 * x + (uu & 7); u.pn = uu >> 3; u.aux = 0; u.lrows = -1; u.arows = nullptr;
        u.a = A + (size_t)u.pm * 256 * (D * 2); u.b = W + (size_t)u.pn * 256 * (D * 2); return true;
    }
};
struct EpiOutProj {
    static constexpr bool PERM = false, AFTER_DRAIN = false;
    const float* x; const float* mod; bf16_t* xl;
    __device__ __forceinline__ void operator()(const f32x4 (&acc)[2][2][4][2], const pg8::Unit& u, int wr, int wc, int fr, int fq) const {
        const int row0 = u.pm * 256 + wr * 64 + fr, col0 = u.pn * 256 + wc * 32 + 4 * fq;
#pragma unroll
        for (int ai = 0; ai < 2; ++ai)
#pragma unroll
            for (int m = 0; m < 4; ++m) { const int r = row0 + ai * 128 + m * 16; const float* g1 = mod + (r >> 12) * 6144 + 2048;
#pragma unroll
                for (int bj = 0; bj < 2; ++bj)
#pragma unroll
                    for (int n = 0; n < 2; ++n) { const int c = col0 + bj * 128 + n * 16; const f32x4 xv = *(const f32x4*)(x + (size_t)r * D + c), gv = *(const f32x4*)(g1 + c);
                        const f32x4 o = xv + gv * acc[ai][bj][m][n]; u32x2 w; w.x = pk2(o[0], o[1]); w.y = pk2(o[2], o[3]); *(u32x2*)(xl + (size_t)r * D + c) = w; } }
    }
};
__device__ __forceinline__ void phase_norm2(const TailP& p, LAS unsigned char* lds, int bid, int nb, int wid) {
    LAS float* wg = (LAS float*)lds;
    const int tid = ltid(wid), wave = __builtin_amdgcn_readfirstlane(tid >> 6), lane = tid & 63;
    for (int i = tid; i < 1024 * 16; i += NTHR) { const int k = i >> 4, j = i & 15; wg[k * 20 + (k >> 4) * 4 + j] = p.w_router[i]; }
    __syncthreads();
    const int gw = bid * 8 + wave, NGW = nb * 8;
    u32x4 nx[2];
    if (gw < ML) {
#pragma unroll
        for (int i = 0; i < 2; ++i) nx[i] = *(const u32x4*)(p.xl + (size_t)gw * D + 16 * lane + 8 * i); }
    for (int row = gw; row < ML; row += NGW) {
        f32x4 v[4];
#pragma unroll
        for (int i = 0; i < 2; ++i) { v[2 * i] = bf4_f32(nx[i].x, nx[i].y); v[2 * i + 1] = bf4_f32(nx[i].z, nx[i].w); }
        { const int r2 = row + NGW; if (r2 < ML) {
#pragma unroll
            for (int i = 0; i < 2; ++i) nx[i] = *(const u32x4*)(p.xl + (size_t)r2 * D + 16 * lane + 8 * i); } }
        const float* md = p.mod + (row >> 12) * 6144 + 16 * lane; const float* nw = p.norm2_w + 16 * lane;
        float ss = 0.f;
#pragma unroll
        for (int i = 0; i < 4; ++i) ss += (v[i][0] * v[i][0] + v[i][1] * v[i][1]) + (v[i][2] * v[i][2] + v[i][3] * v[i][3]);
#pragma unroll
        for (int o = 1; o < 64; o <<= 1) ss += __shfl_xor(ss, o);
        const float rstd = rsqrtf(ss * (1.f / D) + EPS);
        float g[16];
#pragma unroll
        for (int j = 0; j < 16; ++j) g[j] = 0.f;
        u32x4 pk;
#pragma unroll
        for (int i = 0; i < 4; ++i) {
            const f32x4 w4 = *(const f32x4*)(nw + 4 * i), s4 = *(const f32x4*)(md + 4096 + 4 * i), h4 = *(const f32x4*)(md + 3072 + 4 * i);
            const f32x4 hh4 = v[i] * rstd * w4 * (s4 + 1.f) + h4;
            pk[i] = pk4_fp8(hh4[0], hh4[1], hh4[2], hh4[3]);
#pragma unroll
            for (int c = 0; c < 4; ++c) { const float hh = hh4[c]; const LAS f32x4* wr = (const LAS f32x4*)(wg + (16 * lane + 4 * i + c) * 20 + lane * 4); ROWDOT16(g, hh, wr); if (c & 1) asm volatile("" ::: "memory"); }
        }
        *(u32x4*)(p.H2 + (size_t)row * D + 16 * lane) = pk;
        const float lg = reduce16x64(g, lane);
        float mx = lg; mx = fmaxf(mx, __shfl_xor(mx, 2)); mx = fmaxf(mx, __shfl_xor(mx, 4)); mx = fmaxf(mx, __shfl_xor(mx, 8)); mx = fmaxf(mx, __shfl_xor(mx, 16));
        const float ex = expf(lg - mx); float sm = ex; sm += __shfl_xor(sm, 2); sm += __shfl_xor(sm, 4); sm += __shfl_xor(sm, 8); sm += __shfl_xor(sm, 16);
        if ((lane & 33) == 0) p.aff[(size_t)row * 16 + (lane >> 1)] = ex / sm;
    }
}
__device__ __forceinline__ void phase_topk(const TailP& p, LAS unsigned char* lds, int bid, int nb, int wid) {
    LAS unsigned* hist = (LAS unsigned*)lds;
    LAS unsigned* ctl = hist + 256;
    LAS unsigned* wsum = ctl + 8;
    const int tid = ltid(wid), wave = tid >> 6, lane = tid & 63;
    for (int item = bid; item < NB * NE; item += nb) {
        const int b = item >> 4, e = item & 15;
        unsigned key[8];
#pragma unroll
        for (int j = 0; j < 8; ++j) key[j] = __float_as_uint(p.aff[((size_t)b * T + tid * 8 + j) * 16 + e]);
        if (tid == 0) { ctl[0] = 0u; ctl[1] = (unsigned)CAP; }
        unsigned prefix = 0u, krem = CAP;
#pragma unroll 1
        for (int pass = 0; pass < 4; ++pass) {
            const int shift = 24 - 8 * pass;
            if (tid < 256) hist[tid] = 0u;
            __syncthreads();
#pragma unroll
            for (int j = 0; j < 8; ++j) { const bool match = pass == 0 ? true : ((key[j] >> (shift + 8)) == prefix); if (match) atomicAdd((unsigned*)(hist + ((key[j] >> shift) & 255u)), 1u); }
            __syncthreads();
            {
                unsigned mine = 0u, incl = 0u;
                if (tid < 256) { mine = hist[tid]; incl = mine;
#pragma unroll
                    for (int o = 1; o < 64; o <<= 1) { const unsigned t2 = __shfl_down(incl, o); if (lane + o < 64) incl += t2; }
                    if (lane == 0) wsum[wave] = incl; }
                __syncthreads();
                if (tid < 256) { unsigned above = incl - mine; for (int w2 = wave + 1; w2 < 4; ++w2) above += wsum[w2];
                    if (above < krem && krem <= above + mine) { ctl[0] = (prefix << 8) | (unsigned)tid; ctl[1] = krem - above; } }
            }
            __syncthreads();
            prefix = ctl[0]; krem = ctl[1];
            __syncthreads();
        }
        unsigned ng = 0u, ne = 0u;
#pragma unroll
        for (int j = 0; j < 8; ++j) { ng += key[j] > prefix ? 1u : 0u; ne += key[j] == prefix ? 1u : 0u; }
        unsigned sg = ng, se = ne;
#pragma unroll
        for (int o = 1; o < 64; o <<= 1) { const unsigned tg = __shfl_up(sg, o), te = __shfl_up(se, o); if (lane >= o) { sg += tg; se += te; } }
        if (lane == 63) { wsum[wave * 2] = sg; wsum[wave * 2 + 1] = se; }
        __syncthreads();
        unsigned bg = sg - ng, be = se - ne;
        for (int w = 0; w < wave; ++w) { bg += wsum[w * 2]; be += wsum[w * 2 + 1]; }
#pragma unroll
        for (int j = 0; j < 8; ++j) {
            const int t = tid * 8 + j; const bool gr = key[j] > prefix, eq = key[j] == prefix; const bool sel = gr || (eq && be < krem);
            const int cslot = (int)(bg + (be < krem ? be : krem)); const int R = e * 2048 + b * CAP + cslot;
            if (sel) { p.idx[R] = b * T + t; p.gate[R] = __uint_as_float(key[j]); }
            p.slotmap[((size_t)b * T + t) * NE + e] = sel ? R : -1;
            bg += gr ? 1u : 0u; be += eq ? 1u : 0u;
        }
        __syncthreads();
    }
}
__device__ __forceinline__ void phase_final(const TailP& p, int bid, int nb, int wid) {
    const int tid = ltid(wid), wave = __builtin_amdgcn_readfirstlane(tid >> 6), lane = tid & 63;
    const int gw = bid * 8 + wave, NGW = nb * 8;
    int nsm = -1; u32x2 nxv[4];
    if (gw < ML) { nsm = lane < 16 ? p.slotmap[(size_t)gw * NE + lane] : -1;
#pragma unroll
        for (int i = 0; i < 4; ++i) nxv[i] = ntl((const u32x2*)(p.xl + (size_t)gw * D) + lane + 64 * i); }
    for (int row = gw; row < ML; row += NGW) {
        const int sm = nsm; f32x4 xv[4];
#pragma unroll
        for (int i = 0; i < 4; ++i) xv[i] = bf4_f32(nxv[i].x, nxv[i].y);
        { const int r2 = row + NGW; if (r2 < ML) { nsm = lane < 16 ? p.slotmap[(size_t)r2 * NE + lane] : -1;
#pragma unroll
            for (int i = 0; i < 4; ++i) nxv[i] = ntl((const u32x2*)(p.xl + (size_t)r2 * D) + lane + 64 * i); } }
        f32x4 a[4];
#pragma unroll
        for (int i = 0; i < 4; ++i) a[i] = (f32x4){0.f, 0.f, 0.f, 0.f};
#pragma unroll
        for (int e = 0; e < NE; ++e) { const int sl = __builtin_amdgcn_readlane(sm, e);
            if (sl >= 0) { const u32x2* yr = (const u32x2*)(p.Ys + (size_t)sl * D);
#pragma unroll
                for (int i = 0; i < 4; ++i) { const u32x2 w = ntl(yr + lane + 64 * i); a[i][0] += __uint_as_float(w.x << 16); a[i][1] += __uint_as_float(w.x & 0xffff0000u); a[i][2] += __uint_as_float(w.y << 16); a[i][3] += __uint_as_float(w.y & 0xffff0000u); } } }
        const float* g2 = p.mod + (row >> 12) * 6144 + 5120; float ss = 0.f;
#pragma unroll
        for (int i = 0; i < 4; ++i) { const int k = 4 * (lane + 64 * i); const f32x4 gv = *(const f32x4*)(g2 + k); a[i] = xv[i] + gv * a[i];
            ss += (a[i][0] * a[i][0] + a[i][1] * a[i][1]) + (a[i][2] * a[i][2] + a[i][3] * a[i][3]); }
#pragma unroll
        for (int o = 1; o < 64; o <<= 1) ss += __shfl_xor(ss, o);
        const float rstd = rsqrtf(ss * (1.f / D) + EPS);
#pragma unroll
        for (int i = 0; i < 4; ++i) { const int k = 4 * (lane + 64 * i); const f32x4 fw = *(const f32x4*)(p.final_w + k); nts((f32x4)(a[i] * rstd * fw), (f32x4*)(p.out + (size_t)row * D + k)); }
    }
}

#define XB_TMO      128
#define XB_XCNT(j)  (256  + 64 * (j))
#define XB_XSUB(j)  (1280 + 64 * (j))
#define XB_XGEN(j)  (2304 + 64 * (j))
#define XB_TOP      3328
#define XB_TOPGEN   3392
#define XCD_BAR_WORDS 3456
#define XB_SPIN_CAP (1u << 18)
__device__ __forceinline__ unsigned xb_ld(unsigned* p)              { return __hip_atomic_load(p, __ATOMIC_RELAXED, __HIP_MEMORY_SCOPE_AGENT); }
__device__ __forceinline__ unsigned xb_add(unsigned* p, unsigned v) { return __hip_atomic_fetch_add(p, v, __ATOMIC_RELAXED, __HIP_MEMORY_SCOPE_AGENT); }
__device__ __forceinline__ unsigned xb_xcc_id() { return (unsigned)__builtin_amdgcn_s_getreg((3 << 11) | 20) & 0xFu; }
#define XB_SPIN(cond, bar) do { unsigned _sp = 0; while (cond) { __builtin_amdgcn_s_sleep(1); \
    if ((++_sp & 255u) == 0u) { if (xb_ld(&(bar)[XB_TMO])) break; if (_sp > XB_SPIN_CAP) { atomicAdd(&(bar)[XB_TMO], 1u); break; } } } } while (0)
struct XcdBarrier { unsigned* bar; unsigned x; volatile LAS unsigned* st; };
__device__ __forceinline__ XcdBarrier xcd_barrier_post(unsigned* bar, volatile LAS unsigned* st) {
    XcdBarrier b; b.bar = bar; b.x = xb_xcc_id(); b.st = st;
    if (threadIdx.x == 0) (void)xb_add(&bar[XB_XCNT(b.x)], 1u);
    return b;
}
__device__ __forceinline__ void xcd_barrier_complete(unsigned* bar, unsigned x, unsigned& nloc, unsigned& nx) {
    const unsigned G = gridDim.x * gridDim.y * gridDim.z;
    unsigned sum, cnt, mine, sp = 0u;
    for (;;) {
        sum = 0u; cnt = 0u; mine = 0u;
#pragma unroll
        for (unsigned j = 0; j < 16; ++j) { const unsigned c = xb_ld(&bar[XB_XCNT(j)]); sum += c; cnt += (c > 0u) ? 1u : 0u; mine = (j == x) ? c : mine; }
        if (sum == G) break;
        __builtin_amdgcn_s_sleep(1);
        if ((++sp & 255u) == 0u) { if (xb_ld(&bar[XB_TMO])) break; if (sp > XB_SPIN_CAP) { atomicAdd(&bar[XB_TMO], 1u); break; } }
    }
    nloc = mine > 0u ? mine : 1u; nx = cnt > 0u ? cnt : 1u;
}
__device__ __forceinline__ void xcd_barrier(const XcdBarrier& b, const int wid) {
    const bool t0 = (wid == 0) && (__builtin_amdgcn_mbcnt_hi(~0u, __builtin_amdgcn_mbcnt_lo(~0u, 0u)) == 0u);
    asm volatile("s_waitcnt vmcnt(0)" ::: "memory");
    __syncthreads();
    if (t0) {
        unsigned* bar = b.bar;
        __builtin_amdgcn_s_waitcnt(0);
        unsigned nloc = b.st[0], nx = b.st[1];
        if (nloc == 0u) { xcd_barrier_complete(bar, b.x, nloc, nx); b.st[0] = nloc; b.st[1] = nx; }
        const unsigned old = xb_add(&bar[XB_XSUB(b.x)], 1u);
        const unsigned gen = old / nloc;
        if (old + 1u == (gen + 1u) * nloc) {
            __builtin_amdgcn_fence(__ATOMIC_RELEASE, "agent");
            asm volatile("s_waitcnt vmcnt(0)" ::: "memory");
            const unsigned og = xb_add(&bar[XB_TOP], 1u);
            const unsigned tg = og / nx;
            if (og + 1u == (tg + 1u) * nx) xb_add(&bar[XB_TOPGEN], 1u);
            else XB_SPIN(xb_ld(&bar[XB_TOPGEN]) == tg, bar);
            __builtin_amdgcn_fence(__ATOMIC_ACQUIRE, "agent");
            xb_add(&bar[XB_XGEN(b.x)], 1u);
            asm volatile("s_waitcnt vmcnt(0)" ::: "memory");
        } else {
            XB_SPIN(xb_ld(&bar[XB_XGEN(b.x)]) == gen, bar);
            __builtin_amdgcn_fence(__ATOMIC_ACQUIRE, "agent");
            asm volatile("s_waitcnt vmcnt(0)" ::: "memory");
        }
    }
    __syncthreads();
}

__device__ __forceinline__ void group_barrier(unsigned* cnt, unsigned target, unsigned* tmo, const int wid) {
    const bool t0 = (wid == 0) && (__builtin_amdgcn_mbcnt_hi(~0u, __builtin_amdgcn_mbcnt_lo(~0u, 0u)) == 0u);
    asm volatile("s_waitcnt vmcnt(0)" ::: "memory");
    __syncthreads();
    if (t0) {
        __builtin_amdgcn_fence(__ATOMIC_RELEASE, "agent");
        asm volatile("s_waitcnt vmcnt(0)" ::: "memory");
        (void)xb_add(cnt, 1u);
        unsigned sp = 0u;
        while (xb_ld(cnt) < target) { __builtin_amdgcn_s_sleep(1); if ((++sp & 255u) == 0u) { if (xb_ld(tmo)) break; if (sp > XB_SPIN_CAP) { atomicAdd(tmo, 1u); break; } } }
        __builtin_amdgcn_fence(__ATOMIC_ACQUIRE, "agent");
        asm volatile("s_waitcnt vmcnt(0)" ::: "memory");
    }
    __syncthreads();
}

struct EpiOutNorm {
    static constexpr bool PERM = true, AFTER_DRAIN = true;
    const float* x; const float* mod; bf16_t* xl; fp8_t* H2; float* aff; const float* wsc2; const bf16_t* WrT; const float* biasr; float* xrec; unsigned* bar;
    __device__ __forceinline__ void operator()(const f32x4 (&)[2][2][4][2], const pg8::Unit&, int, int, int, int) const {}
    __device__ __forceinline__ void fused(f32x4 (&acc)[2][2][4][2], const pg8::Unit& u, LAS unsigned char* lds, int wv) const {
        const int t = ltid(wv), lane = t & 63, w = __builtin_amdgcn_readfirstlane(t >> 6), wr = w >> 2, wc = w & 3, fr = lane & 15, fq = lane >> 4;
        const int b = u.pm >> 4;
        const int row0 = u.pm * 256 + wr * 64 + fr, colb = u.pn * 256 + wc * 32 + 8 * fq;
        LAS float* SS = (LAS float*)lds;
        LAS float* LG = SS + 1024;
        LAS float* RS = LG + 4 * 256 * 20;
        const rsrc_t rX = __builtin_amdgcn_make_buffer_rsrc((void*)xrec, 0, 0xffffffff, 0x00020000);
        const float* g1p = mod + b * 6144 + 2048; const float* wsp = wsc2 + b * D;
#pragma unroll
        for (int ai = 0; ai < 2; ++ai)
#pragma unroll
            for (int m = 0; m < 4; ++m) {
                const int r = row0 + ai * 128 + m * 16, rl = ai * 128 + wr * 64 + m * 16; float ss = 0.f; f32x4 lg = (f32x4){0.f, 0.f, 0.f, 0.f};
#pragma unroll
                for (int bj = 0; bj < 2; ++bj) { const int c = colb + bj * 128;
                    const f32x4 x0 = *(const f32x4*)(x + (size_t)r * D + c), x1 = *(const f32x4*)(x + (size_t)r * D + c + 4), g0 = *(const f32x4*)(g1p + c), g1v = *(const f32x4*)(g1p + c + 4);
                    const f32x4 v0 = x0 + g0 * acc[ai][bj][m][0], v1 = x1 + g1v * acc[ai][bj][m][1];
                    acc[ai][bj][m][0] = v0; acc[ai][bj][m][1] = v1;
                    ss += (v0[0] * v0[0] + v0[1] * v0[1]) + (v0[2] * v0[2] + v0[3] * v0[3]) + (v1[0] * v1[0] + v1[1] * v1[1]) + (v1[2] * v1[2] + v1[3] * v1[3]);
                    const f32x4 w0 = *(const f32x4*)(wsp + c), w1 = *(const f32x4*)(wsp + c + 4); const f32x4 u0 = v0 * w0, u1 = v1 * w1;
                    u32x4 ap; ap.x = cvt_pk_bf16(u0[0], u0[1]); ap.y = cvt_pk_bf16(u0[2], u0[3]); ap.z = cvt_pk_bf16(u1[0], u1[1]); ap.w = cvt_pk_bf16(u1[2], u1[3]);
                    const bf16x8 bq = *(const bf16x8*)(WrT + (size_t)fr * D + u.pn * 256 + bj * 128 + wc * 32 + 8 * fq);
                    lg = __builtin_amdgcn_mfma_f32_16x16x32_bf16(__builtin_bit_cast(bf16x8, ap), bq, lg, 0, 0, 0); }
                ss += __shfl_xor(ss, 16); ss += __shfl_xor(ss, 32);
                if (fq == 0) SS[(rl + fr) * 4 + wc] = ss;
#pragma unroll
                for (int rg = 0; rg < 4; ++rg) LG[(wc * 256 + rl + 4 * fq + rg) * 20 + fr] = lg[rg];
            }
        __syncthreads();
        if (t < 256) { const f32x4 s4 = *(const LAS f32x4*)(SS + t * 4); const float ssum = (s4[0] + s4[1]) + (s4[2] + s4[3]);
            f32x4 q[4];
#pragma unroll
            for (int j = 0; j < 4; ++j) { const f32x4 a0 = *(const LAS f32x4*)(LG + (0 * 256 + t) * 20 + 4 * j), a1 = *(const LAS f32x4*)(LG + (1 * 256 + t) * 20 + 4 * j),
                                                      a2 = *(const LAS f32x4*)(LG + (2 * 256 + t) * 20 + 4 * j), a3 = *(const LAS f32x4*)(LG + (3 * 256 + t) * 20 + 4 * j); q[j] = (a0 + a1) + (a2 + a3); }
            const int ro = (((u.pm * 256 + t) * 4 + u.pn) * 20) * 4;
#pragma unroll
            for (int j = 0; j < 4; ++j) __builtin_amdgcn_raw_buffer_store_b128(__builtin_bit_cast(u32x4, q[j]), rX, ro + 16 * j, 0, 16);
            __builtin_amdgcn_raw_buffer_store_b128(__builtin_bit_cast(u32x4, (f32x4){ssum, 0.f, 0.f, 0.f}), rX, ro + 64, 0, 16); }
        asm volatile("s_waitcnt vmcnt(0)" ::: "memory");
        __syncthreads();
        const bool t0 = (t == 0);
        unsigned* cnt = bar + 4096 + 64 * u.pm;
        if (t0) (void)xb_add(cnt, 1u);
        {
#pragma unroll
            for (int ai = 0; ai < 2; ++ai)
#pragma unroll
                for (int m = 0; m < 4; ++m) { const int r = row0 + ai * 128 + m * 16;
#pragma unroll
                    for (int bj = 0; bj < 2; ++bj) { const int c = colb + bj * 128; const f32x4 a0 = acc[ai][bj][m][0], a1 = acc[ai][bj][m][1]; u32x4 w; w.x = pk2(a0[0], a0[1]); w.y = pk2(a0[2], a0[3]); w.z = pk2(a1[0], a1[1]); w.w = pk2(a1[2], a1[3]); *(u32x4*)(xl + (size_t)r * D + c) = w; } }
        }
        if (t0) { unsigned sp = 0u; unsigned* tmo = bar + XB_TMO;
            while (xb_ld(cnt) < 4u) { __builtin_amdgcn_s_sleep(1); if ((++sp & 255u) == 0u) { if (xb_ld(tmo)) break; if (sp > XB_SPIN_CAP) { atomicAdd(tmo, 1u); break; } } }
            __builtin_amdgcn_fence(__ATOMIC_ACQUIRE, "agent");
            asm volatile("s_waitcnt vmcnt(0)" ::: "memory"); }
        __syncthreads();
        if (t < 256) { const f32x4* src = (const f32x4*)(xrec + (size_t)(u.pm * 256 + t) * 4 * 20); float tot[17];
#pragma unroll
            for (int i = 0; i < 17; ++i) tot[i] = 0.f;
#pragma unroll
            for (int o = 0; o < 4; ++o) { const f32x4 a0 = src[o * 5], a1 = src[o * 5 + 1], a2 = src[o * 5 + 2], a3 = src[o * 5 + 3], a4 = src[o * 5 + 4];
                tot[1] += a0[0]; tot[2] += a0[1]; tot[3] += a0[2]; tot[4] += a0[3]; tot[5] += a1[0]; tot[6] += a1[1]; tot[7] += a1[2]; tot[8] += a1[3];
                tot[9] += a2[0]; tot[10] += a2[1]; tot[11] += a2[2]; tot[12] += a2[3]; tot[13] += a3[0]; tot[14] += a3[1]; tot[15] += a3[2]; tot[16] += a3[3]; tot[0] += a4[0]; }
            const float rstd = rsqrtf(tot[0] * (1.f / D) + EPS); RS[t] = rstd;
            if ((t >> 6) == u.pn) { float lgt[16], mx = -3.0e38f;
#pragma unroll
                for (int e = 0; e < 16; ++e) { lgt[e] = rstd * tot[1 + e] + biasr[b * 16 + e]; mx = fmaxf(mx, lgt[e]); }
                float sm = 0.f;
#pragma unroll
                for (int e = 0; e < 16; ++e) { lgt[e] = expf(lgt[e] - mx); sm += lgt[e]; }
                const float inv = 1.f / sm; f32x4* ao = (f32x4*)(aff + (size_t)(u.pm * 256 + t) * 16);
                ao[0] = (f32x4){lgt[0] * inv, lgt[1] * inv, lgt[2] * inv, lgt[3] * inv}; ao[1] = (f32x4){lgt[4] * inv, lgt[5] * inv, lgt[6] * inv, lgt[7] * inv};
                ao[2] = (f32x4){lgt[8] * inv, lgt[9] * inv, lgt[10] * inv, lgt[11] * inv}; ao[3] = (f32x4){lgt[12] * inv, lgt[13] * inv, lgt[14] * inv, lgt[15] * inv}; } }
        __syncthreads();
        const float* shp = mod + b * 6144 + 3072;
        { const int t2 = ltid(wv), l2 = t2 & 63, fr2 = l2 & 15, fq2 = l2 >> 4; const int row0b = u.pm * 256 + wr * 64 + fr2, colbb = u.pn * 256 + wc * 32 + 8 * fq2;
#pragma unroll
        for (int ai = 0; ai < 2; ++ai)
#pragma unroll
            for (int m = 0; m < 4; ++m) { const int r = row0b + ai * 128 + m * 16; const float rstd = RS[ai * 128 + wr * 64 + m * 16 + fr2];
#pragma unroll
                for (int bj = 0; bj < 2; ++bj) { const int c = colbb + bj * 128; const f32x4 v0 = acc[ai][bj][m][0], v1 = acc[ai][bj][m][1];
                    const f32x4 w0 = *(const f32x4*)(wsp + c), w1 = *(const f32x4*)(wsp + c + 4), s0 = *(const f32x4*)(shp + c), s1 = *(const f32x4*)(shp + c + 4);
                    const f32x4 h0 = v0 * rstd * w0 + s0, h1 = v1 * rstd * w1 + s1;
                    u32x2 o; o.x = pk4_fp8(h0[0], h0[1], h0[2], h0[3]); o.y = pk4_fp8(h1[0], h1[1], h1[2], h1[3]);
                    *(u32x2*)(H2 + (size_t)r * D + c) = o; } }
        }
    }
};

struct MegaP { FastQ q; MixP m; TailP t; FastP f; unsigned* bar; };
constexpr int MISC_OFF = LDS_BYTES - 256;
constexpr int CVT_NIT = NE * (2 * 8 * 88 + 22 * 32);
constexpr int CVT_SPLIT1 = (CVT_NIT * 70 / 100) & ~7, CVT_SPLIT2 = (CVT_NIT * 94 / 100) & ~7;
__global__ void __launch_bounds__(NTHR, 2) mega_fwd(MegaP P) {
    extern __shared__ __attribute__((aligned(16))) unsigned char lds_raw[];
    LAS unsigned char* lds = (LAS unsigned char*)lds_raw;
    const int bid = blockIdx.x, nb = gridDim.x;
    const int wid = __builtin_amdgcn_readfirstlane((int)threadIdx.x >> 6);
    volatile LAS unsigned* misc = (volatile LAS unsigned*)(lds + MISC_OFF);
    if (threadIdx.x < 64) misc[threadIdx.x] = 0u;
    __syncthreads();
    const XcdBarrier bar = xcd_barrier_post(P.bar, misc + 8);
    phase_mod(P.q, lds, bid, nb, wid);
    xcd_barrier(bar, wid);
    if (bid & 1) { phase_convert_small(P.q, lds, bid, nb, wid); __syncthreads(); phase_norm1(P.q, lds, bid, nb, wid); }
    else { phase_norm1(P.q, lds, bid, nb, wid); __syncthreads(); phase_convert_small(P.q, lds, bid, nb, wid); }
    xcd_barrier(bar, wid);
    {
        const int tid0 = ltid(wid);
        const float sg = calib_scale(P.f.w_gate, (LAS float*)lds, tid0), su = calib_scale(P.f.w_up, (LAS float*)lds, tid0), sd = calib_scale(P.f.w_down, (LAS float*)lds, tid0);
        if (bid == 0 && tid0 == 0) { P.f.wsc[0] = sg; P.f.wsc[1] = su; P.f.wsc[2] = sd; P.f.wsc[4] = 1.f / sg; P.f.wsc[5] = 1.f / su; P.f.wsc[6] = 1.f / sd; }
        CvtSide side; side.init(P.f, __builtin_bit_cast(float, __builtin_amdgcn_readfirstlane(__builtin_bit_cast(int, sg))), __builtin_bit_cast(float, __builtin_amdgcn_readfirstlane(__builtin_bit_cast(int, su))),
                                __builtin_bit_cast(float, __builtin_amdgcn_readfirstlane(__builtin_bit_cast(int, sd))), bid * 8 + wid, nb * 8, CVT_SPLIT1);
        SchedInProj S{(const char*)P.q.XN, (const char*)P.q.WinT, nb, bid}; EpiInProj E{P.q.Pb, P.q.ropetab}; pg8::gemm_phase<false>(lds, D, S, E, wid, side);
        side.skip = 0; while (side.busy()) { (void)side.issue(wid); (void)side.finish<0>(wid); }
    }
    if (bid >= 1056 - 4 * nb && nb == 256) phase_convert_moe(P.f, lds, CVT_SPLIT1, CVT_SPLIT2, bid - (1056 - 4 * nb), 5 * nb - 1056, wid);
    xcd_barrier(bar, wid);
    phase_mixA(P.m, lds, bid, nb, wid);
    xcd_barrier(bar, wid);
    phase_mixB(P.m, bid, nb, wid);
    xcd_barrier(bar, wid);
    phase_mixC(P.m, lds, bid, nb, wid);
    xcd_barrier(bar, wid);
    if (nb == 256) { SchedOutProj S{(const char*)P.t.YM, (const char*)P.t.WoutT, nb, bid};
        EpiOutNorm E{P.t.x, P.t.mod, P.t.xl, P.t.H2, P.t.aff, P.t.wsc2, P.t.WrT, P.t.biasr, P.t.xrec, P.t.bar}; pg8::gemm_phase<false>(lds, D, S, E, wid); }
    else { SchedOutProj S{(const char*)P.t.YM, (const char*)P.t.WoutT, nb, bid}; EpiOutProj E{P.t.x, P.t.mod, P.t.xl}; pg8::gemm_phase<false>(lds, D, S, E, wid); }
    xcd_barrier(bar, wid);
    if (nb != 256) { phase_norm2(P.t, lds, bid, nb, wid); xcd_barrier(bar, wid); }
    if (bid < NB * NE || nb != 256) phase_topk(P.t, lds, bid, nb, wid);
    if (nb == 256) { if (bid >= NB * NE) phase_convert_moe(P.f, lds, CVT_SPLIT2, CVT_NIT, bid - NB * NE, nb - NB * NE, wid); }
    else phase_convert_moe(P.f, lds, CVT_SPLIT1, CVT_NIT, bid, nb, wid);
    xcd_barrier(bar, wid);
    {
        constexpr int LROW0 = pg8::STAGE_BYTES;
        const bool lok = (nb & 7) == 0;
        if (lok) { for (int i = ltid(wid); i < 4096; i += NTHR) ((LAS int*)(lds + LROW0))[i] = P.f.erow[(bid & 7) * 4096 + i]; }
        __syncthreads();
        SchedMoe1 S{(const char*)P.f.H2, P.f.erow, (const char*)P.f.WguT, nb, bid, lok ? LROW0 : -1}; const unsigned eg = (254u - (__float_as_uint(P.f.wsc[0]) >> 23)) * 0x01010101u, eu = (254u - (__float_as_uint(P.f.wsc[1]) >> 23)) * 0x01010101u;
        EpiSwiGLU E{P.f.Hb, eg, eu}; pg8::gemm_phase<true>(lds, D / 2, S, E, wid); }
    xcd_barrier(bar, wid);
    { SchedMoe2 S{(const char*)P.f.Hb, (const char*)P.f.WdT, nb, bid}; const unsigned ed = (254u - (__float_as_uint(P.f.wsc[2]) >> 23)) * 0x01010101u; EpiDownBf16 E{P.f.Ys, P.f.gate, ed, ed}; pg8::gemm_phase<true>(lds, FF / 2, S, E, wid); }
    xcd_barrier(bar, wid);
    phase_final(P.t, bid, nb, wid);
}

extern "C" void kernel_launch(void* const* d_in, const int* in_sizes, int n_in, void* d_out, int out_size, void* d_ws, size_t ws_size, hipStream_t stream) {
    const float* x = (const float*)d_in[0]; const float* c = (const float*)d_in[1]; const float* ctx = (const float*)d_in[2]; const float* c_ctx = (const float*)d_in[3];
    const float* w_ada = (const float*)d_in[4]; const float* b_ada = (const float*)d_in[5]; const float* norm1_w = (const float*)d_in[6]; const float* norm2_w = (const float*)d_in[7];
    const float* w_in = (const float*)d_in[8]; const float* gate_bias = (const float*)d_in[9]; const float* decay_logit = (const float*)d_in[10];
    const float* mnw = (const float*)d_in[11]; const float* rnw = (const float*)d_in[12]; const float* w_out = (const float*)d_in[13]; const float* w_router = (const float*)d_in[14];
    const float* w_gate = (const float*)d_in[15]; const float* w_up = (const float*)d_in[16]; const float* w_down = (const float*)d_in[17]; const float* final_w = (const float*)d_in[18];
    float* out = (float*)d_out;
    char* ws = (char*)d_ws; size_t off = 0;
    auto carve = [&](size_t bytes) { char* p = ws + off; off += (bytes + 255) & ~(size_t)255; return p; };
    unsigned* bar = (unsigned*)carve(32768);
    float* mod = (float*)carve(5 * 6144 * 4);
    float* ropetab = (float*)carve(2048 * 2 * 4); float* normw = (float*)carve(1024 * 4); float* wsc2 = (float*)carve(4 * 1024 * 4); float* biasr = (float*)carve(256); bf16_t* WrT = (bf16_t*)carve(16 * 1024 * 2);
    float* xrec = (float*)carve((size_t)ML * 4 * 20 * 4); float* G = (float*)carve((size_t)MA * 16 * 4);
    float* aff = (float*)carve((size_t)ML * 16 * 4);
    float* gate = (float*)carve(NSLOT * 4); int* erow = (int*)carve(NSLOT * 4);
    int* slotmap = (int*)carve((size_t)ML * NE * 4);
    float* NV = (float*)carve((size_t)2 * 16 * NCH * 2 * 128 * 4); float* SC = (float*)carve((size_t)2 * 16 * NCH * 2 * 4 * 4);
    bf16_t* xl = (bf16_t*)carve((size_t)ML * D * 2);
    bf16_t* WinT = (bf16_t*)carve((size_t)4096 * D * 2); bf16_t* WoutT = (bf16_t*)carve((size_t)D * D * 2);
    fp8_t* WguT = (fp8_t*)carve((size_t)NE * 5632 * D);
    fp8_t* WdT = (fp8_t*)carve((size_t)NE * D * FF);
    float* wsc = (float*)carve(256);
    const size_t e0 = off;
    bf16_t* XN = (bf16_t*)carve((size_t)MA * D * 2); bf16_t* Pb = (bf16_t*)carve((size_t)MA * PBC * 2);
    bf16_t* ST = (bf16_t*)carve((size_t)2 * 16 * NCH * 2 * 16384 * 2); bf16_t* YM = (bf16_t*)carve((size_t)ML * D * 2);
    const size_t early_end = off; off = e0;
    fp8_t* Hb = (fp8_t*)carve((size_t)NSLOT * FF); fp8_t* H2 = (fp8_t*)carve((size_t)ML * D); bf16_t* Ys = (bf16_t*)carve((size_t)NSLOT * D * 2);
    if (off < early_end) off = early_end;
    if (off > ws_size) { fprintf(stderr, "ws too small: need %zu have %zu\n", off, ws_size); return; }

    static int grid = 0;
    if (!grid) {
        int dev = 0, cus = 0, per_cu = 0;
        hipGetDevice(&dev); hipDeviceGetAttribute(&cus, hipDeviceAttributeMultiprocessorCount, dev);
        hipFuncSetAttribute((const void*)mega_fwd, hipFuncAttributeMaxDynamicSharedMemorySize, LDS_BYTES);
        hipOccupancyMaxActiveBlocksPerMultiprocessor(&per_cu, mega_fwd, NTHR, LDS_BYTES);
        if (per_cu < 1) { fprintf(stderr, "occupancy query says 0 blocks/CU\n"); per_cu = 1; }
        grid = cus * 1;
        if (grid % 8) grid -= grid % 8;
    }
    MegaP P{};
    P.q.x = x; P.q.ctx = ctx; P.q.c = c; P.q.c_ctx = c_ctx; P.q.w_ada = w_ada; P.q.b_ada = b_ada; P.q.norm1_w = norm1_w; P.q.w_in = w_in; P.q.w_out = w_out; P.q.mnw = mnw; P.q.rnw = rnw; P.q.w_router = w_router; P.q.norm2_w = norm2_w; P.q.wsc2 = wsc2; P.q.biasr = biasr; P.q.WrT = WrT;
    P.q.mod = mod; P.q.ropetab = ropetab; P.q.G = G; P.q.normw = normw; P.q.WinT = WinT; P.q.WoutT = WoutT; P.q.XN = XN; P.q.Pb = Pb;
    P.m.Pb = Pb; P.m.G = G; P.m.gate_bias = gate_bias; P.m.decay_logit = decay_logit; P.m.normw = normw; P.m.ST = ST; P.m.NV = NV; P.m.SC = SC; P.m.YM = YM;
    P.t.x = x; P.t.mod = mod; P.t.norm2_w = norm2_w; P.t.w_router = w_router; P.t.final_w = final_w; P.t.YM = YM; P.t.WoutT = WoutT; P.t.Ys = Ys;
    P.t.wsc2 = wsc2; P.t.biasr = biasr; P.t.WrT = WrT; P.t.xrec = xrec; P.t.bar = bar; P.t.xl = xl; P.t.aff = aff; P.t.gate = gate; P.t.out = out; P.t.H2 = H2; P.t.idx = erow; P.t.slotmap = slotmap;
    P.f.w_gate = w_gate; P.f.w_up = w_up; P.f.w_down = w_down; P.f.gate = gate; P.f.erow = erow; P.f.wsc = wsc; P.f.WguT = WguT; P.f.WdT = WdT; P.f.H2 = H2; P.f.Hb = Hb; P.f.Ys = Ys;
    P.bar = bar;
    hipMemsetAsync(bar, 0, 32768, stream);
    void* args[] = {&P};
    hipError_t e = hipLaunchCooperativeKernel((const void*)mega_fwd, dim3(grid), dim3(NTHR), args, LDS_BYTES, stream);
    if (e != hipSuccess) fprintf(stderr, "cooperative launch failed: %s (grid %d)\n", hipGetErrorString(e), grid);
}
```

```cpp
#include <hip/hip_runtime.h>
#include <cstdint>
#include <cstdio>

constexpr int D = 1024, NB = 4, T = 4096, TC = 256, NH = 4, DH = 128;
constexpr int ML = NB * T;
constexpr int MC = NB * TC;
constexpr int MA = ML + MC;
constexpr int INC = 4112;
constexpr int NE = 16, CAP = 512, FF = 2816;
constexpr int NSLOT = NB * NE * CAP;
constexpr float EPS = 1e-6f;
constexpr int C_MQ = 0, C_MK = 512, C_MV = 1024, C_MO = 1536, C_MG = 2048, C_RQ = 2064, C_RK = 2576, C_RV = 3088, C_RO = 3600;

__device__ __forceinline__ float sigmoidf_(float x) { return 1.f / (1.f + expf(-x)); }
__device__ __forceinline__ float siluf_(float x) { return x / (1.f + expf(-x)); }
__device__ __forceinline__ float logsigmoidf_(float x) { return fminf(x, 0.f) - log1pf(expf(-fabsf(x))); }

constexpr int PB_MQ = 0, PB_MK = 512, PB_MV = 1024, PB_MO = 1536, PB_RQ = 2048, PB_RK = 2560, PB_RV = 3072, PB_RO = 3584, PBC = 4096;

#define LAS __attribute__((address_space(3)))
typedef unsigned short bf16_t;
typedef short bf16x8 __attribute__((ext_vector_type(8)));
typedef float f32x4 __attribute__((ext_vector_type(4)));
typedef unsigned u32x4 __attribute__((ext_vector_type(4)));
typedef unsigned u32x2 __attribute__((ext_vector_type(2)));
typedef int v8i __attribute__((ext_vector_type(8)));
typedef int v4i __attribute__((ext_vector_type(4)));
typedef unsigned char fp8_t;
constexpr int NTHR = 512;
constexpr int LDS_BYTES = 155648;

__device__ __forceinline__ unsigned f2bf(float f) { unsigned u = __float_as_uint(f); return (u + 0x7fffu + ((u >> 16) & 1u)) >> 16; }
__device__ __forceinline__ unsigned pk2(float lo, float hi) { return f2bf(lo) | (f2bf(hi) << 16); }
__device__ __forceinline__ float bf2f(unsigned short b) { return __uint_as_float((unsigned)b << 16); }
__device__ __forceinline__ unsigned cvt_pk_bf16(float lo, float hi) { unsigned r; asm volatile("v_cvt_pk_bf16_f32 %0, %1, %2" : "=v"(r) : "v"(lo), "v"(hi)); return r; }
__device__ __forceinline__ int ltid(int wid) { int l; asm volatile("v_mbcnt_lo_u32_b32 %0, -1, 0\n\tv_mbcnt_hi_u32_b32 %0, -1, %0" : "=v"(l)); return wid * 64 + l; }
__device__ __forceinline__ unsigned pk4_fp8(float a, float b, float c, float d) { int p = __builtin_amdgcn_cvt_pk_fp8_f32(a, b, 0, false); p = __builtin_amdgcn_cvt_pk_fp8_f32(c, d, p, true); return (unsigned)p; }
__device__ __forceinline__ f32x4 bf4_f32(unsigned a, unsigned b) { return (f32x4){__uint_as_float(a << 16), __uint_as_float(a & 0xffff0000u), __uint_as_float(b << 16), __uint_as_float(b & 0xffff0000u)}; }
__device__ __forceinline__ u32x4 widen_pair(u32x2 a, u32x2 b) {
    const auto rx = __builtin_amdgcn_permlane16_swap(a.x, b.x, false, false), ry = __builtin_amdgcn_permlane16_swap(a.y, b.y, false, false);
    return (u32x4){rx[0], ry[0], rx[1], ry[1]};
}
template <class T> __device__ __forceinline__ T ntl(const T* p) { return __builtin_nontemporal_load(p); }
template <class T> __device__ __forceinline__ void nts(T v, T* p) { __builtin_nontemporal_store(v, p); }
typedef __amdgpu_buffer_rsrc_t rsrc_t;
__device__ __forceinline__ float fast_silu(float x) { return x * __builtin_amdgcn_rcpf(1.f + __expf(-x)); }

namespace pg8 {
constexpr int BM = 256, BK = 64, HALF = 128, HTB = HALF * BK * 2  , STAGE_BYTES = 8 * HTB;
__device__ __forceinline__ int lds_byte(int r, int c) { const int st = (r >> 4) * 2 + (c >> 5), rr = r & 15, cc = c & 31, ob = rr * 64 + cc * 2; return st * 1024 + (ob ^ (((ob >> 9) & 1) << 5)); }
__device__ __forceinline__ void stage_rc(int b, int& R, int& C) { const int st = b / 1024, sb = b % 1024, swz = sb ^ (((sb >> 9) & 1) << 5); R = (st >> 1) * 16 + swz / 64; C = (st & 1) * 32 + (swz % 64) / 2; }
__device__ __forceinline__ int perm32(int rho) { const int n = rho >> 4, i = rho & 15; return 8 * (i >> 2) + 4 * n + (i & 3); }
struct Unit { const char* a; const char* b; const int* arows; int pm, pn, aux, lrows; };

struct NoSide { static constexpr bool ON = false; __device__ __forceinline__ int issue(int) { return 0; } template <int> __device__ __forceinline__ int finish(int) { return 0; } };
template <bool FP8, class Epi, class Sched, class Side>
__device__ __forceinline__ void gemm_phase(LAS unsigned char* lds, const int K, const Sched& S, const Epi& E, const int wv, Side& side) {
    const int tid = ltid(wv), wid = __builtin_amdgcn_readfirstlane(tid >> 6), lane = tid & 63, wr = wid >> 2, wc = wid & 3, fr = lane & 15, fq = lane >> 4;
    const int nt = K / BK;
    unsigned voffB[2];
#pragma unroll
    for (int i = 0; i < 2; ++i) { int R, C; stage_rc(tid * 16 + i * 8192, R, C); const int Rb = Epi::PERM ? ((R & ~31) + perm32(R & 31)) : R; voffB[i] = (unsigned)(Rb * K + C) * 2u; }
    const size_t kstep = (size_t)(BK * 2);
    const size_t hstep = (size_t)HALF * K * 2;
    const unsigned ldsw = (unsigned)wid * 1024u;
    const int aoff = lds_byte(wr * 64 + fr, fq * 8), boff = lds_byte(wc * 32 + fr, fq * 8);
#define PG8_SA(b, h) (((b) * 2 + (h)) * HTB)
#define PG8_SB(b, h) ((4 + (b) * 2 + (h)) * HTB)
#define PG8_STAGE(bufoff, gbase, voff) do { _Pragma("unroll") for (int _i = 0; _i < 2; ++_i) { unsigned _o = (voff)[_i]; asm volatile("" : "+v"(_o)); \
        __builtin_amdgcn_global_load_lds((const unsigned*)((const char*)(gbase) + _o), (LAS unsigned*)(lds + (bufoff) + ldsw + _i * 8192), 16, 0, 0); } } while (0)
#define PG8_STAGE2(bufoff, gbase, vc, vn) do { _Pragma("unroll") for (int _i = 0; _i < 2; ++_i) { unsigned _o = last ? (vn)[_i] : (vc)[_i]; asm volatile("" : "+v"(_o)); \
        __builtin_amdgcn_global_load_lds((const unsigned*)((const char*)(gbase) + _o), (LAS unsigned*)(lds + (bufoff) + ldsw + _i * 8192), 16, 0, 0); } } while (0)
#define PG8_LDA(dst, b, h) do { _Pragma("unroll") for (int m = 0; m < 4; ++m) { const v4i _lo = *(const LAS v4i*)(lds + PG8_SA(b, h) + aoff + m * 2048), _hi = *(const LAS v4i*)(lds + PG8_SA(b, h) + aoff + m * 2048 + 1024); \
        dst[m] = __builtin_shufflevector(_lo, _hi, 0, 1, 2, 3, 4, 5, 6, 7); } } while (0)
#define PG8_LDB(dst, b, h) do { _Pragma("unroll") for (int n = 0; n < 2; ++n) { const v4i _lo = *(const LAS v4i*)(lds + PG8_SB(b, h) + boff + n * 2048), _hi = *(const LAS v4i*)(lds + PG8_SB(b, h) + boff + n * 2048 + 1024); \
        dst[n] = __builtin_shufflevector(_lo, _hi, 0, 1, 2, 3, 4, 5, 6, 7); } } while (0)
#define PG8_LDAX(dst, base, off) do { _Pragma("unroll") for (int m = 0; m < 4; ++m) { const v4i _lo = *(const LAS v4i*)((base) + (off) + m * 2048), _hi = *(const LAS v4i*)((base) + (off) + m * 2048 + 1024); \
        dst[m] = __builtin_shufflevector(_lo, _hi, 0, 1, 2, 3, 4, 5, 6, 7); } } while (0)
#define PG8_LDBX(dst, base, off) do { _Pragma("unroll") for (int n = 0; n < 2; ++n) { const v4i _lo = *(const LAS v4i*)((base) + (off) + n * 2048), _hi = *(const LAS v4i*)((base) + (off) + n * 2048 + 1024); \
        dst[n] = __builtin_shufflevector(_lo, _hi, 0, 1, 2, 3, 4, 5, 6, 7); } } while (0)
#define PG8_MMA(ai, bj, At, Bt) do { __builtin_amdgcn_s_setprio(1); _Pragma("unroll") for (int m = 0; m < 4; ++m) _Pragma("unroll") for (int n = 0; n < 2; ++n) { \
        if constexpr (FP8) { acc[ai][bj][m][n] = __builtin_amdgcn_mfma_scale_f32_16x16x128_f8f6f4(Bt[n], At[m], acc[ai][bj][m][n], 0, 0, 0, (int)((bj) ? E.wscale1 : E.wscale0), 0, 0x7f7f7f7f); } \
        else { acc[ai][bj][m][n] = __builtin_amdgcn_mfma_f32_16x16x32_bf16(__builtin_bit_cast(bf16x8, __builtin_shufflevector(Bt[n], Bt[n], 0, 1, 2, 3)), __builtin_bit_cast(bf16x8, __builtin_shufflevector(At[m], At[m], 0, 1, 2, 3)), acc[ai][bj][m][n], 0, 0, 0); \
               acc[ai][bj][m][n] = __builtin_amdgcn_mfma_f32_16x16x32_bf16(__builtin_bit_cast(bf16x8, __builtin_shufflevector(Bt[n], Bt[n], 4, 5, 6, 7)), __builtin_bit_cast(bf16x8, __builtin_shufflevector(At[m], At[m], 4, 5, 6, 7)), acc[ai][bj][m][n], 0, 0, 0); } } \
        __builtin_amdgcn_s_setprio(0); } while (0)
#define PG8_WAIT_V(n) asm volatile("s_waitcnt vmcnt(" #n ")" ::: "memory")
#define PG8_WAIT_L(n) asm volatile("s_waitcnt lgkmcnt(" #n ")" ::: "memory")
#define PG8_BAR __builtin_amdgcn_s_barrier()
#define PG8_SCHED __builtin_amdgcn_sched_barrier(0)
#define PG8_AOFF(dst, u) do { const int _t = ltid(wv); _Pragma("unroll") for (int _i = 0; _i < 2; ++_i) { int _R, _C; stage_rc(_t * 16 + _i * 8192, _R, _C); \
        _Pragma("unroll") for (int _h = 0; _h < 2; ++_h) { const int _r = _h * HALF + _R; const int _ri = (u).lrows >= 0 ? *(const LAS int*)(lds + (u).lrows + 4 * _r) : ((u).arows ? (u).arows[_r] : _r); dst[_h][_i] = (unsigned)(_ri * K + _C) * 2u; } } } while (0)
    Unit cur, nxt; int ui = 0; int sdc = 0;
    if (!S.next(0, cur)) return;
    f32x4 acc[2][2][4][2];
#pragma unroll
    for (int a = 0; a < 2; ++a)
#pragma unroll
        for (int b = 0; b < 2; ++b)
#pragma unroll
            for (int m = 0; m < 4; ++m)
#pragma unroll
                for (int n = 0; n < 2; ++n) acc[a][b][m][n] = (f32x4){0.f, 0.f, 0.f, 0.f};
    v8i At[4], B0[2], B1[2];
    unsigned cO[2][2], nO[2][2];
    PG8_AOFF(cO, cur);
    const char* cA = cur.a; const char* cB = cur.b;
    PG8_STAGE(PG8_SB(0, 0), cB, voffB); PG8_STAGE(PG8_SB(0, 1), cB + hstep, voffB); PG8_STAGE(PG8_SA(0, 0), cA, cO[0]); PG8_STAGE(PG8_SA(0, 1), cA, cO[1]);
    if (wr == 1) PG8_BAR;
    PG8_WAIT_V(2); PG8_BAR;
    PG8_STAGE(PG8_SB(1, 0), cB + kstep, voffB); PG8_STAGE(PG8_SA(1, 0), cA + kstep, cO[0]); PG8_STAGE(PG8_SB(1, 1), cB + hstep + kstep, voffB);
    PG8_WAIT_V(6); PG8_BAR;
    for (;;) {
        const bool has_next = S.next(ui + 1, nxt);
        if (has_next) { PG8_AOFF(nO, nxt); } else {
#pragma unroll
            for (int h = 0; h < 2; ++h)
#pragma unroll
                for (int i = 0; i < 2; ++i) nO[h][i] = cO[h][i]; }
        const char* nA = has_next ? nxt.a : cA; const char* nB = has_next ? nxt.b : cB;
#pragma unroll 1
        for (int t = 0; t < nt; ++t) {
            const int bb = t & 1;
            const bool l1 = (t + 1 >= nt), last = (t + 2 >= nt);
            const char* a1 = l1 ? nA + (size_t)(t + 1 - nt) * kstep : cA + (size_t)(t + 1) * kstep;
            const char* a2 = last ? nA + (size_t)(t + 2 - nt) * kstep : cA + (size_t)(t + 2) * kstep;
            const char* b2 = last ? nB + (size_t)(t + 2 - nt) * kstep : cB + (size_t)(t + 2) * kstep;
            const int sa = bb * 2 * HTB, sa1 = (bb ^ 1) * 2 * HTB;
            LAS unsigned char* la = lds + sa + aoff; LAS unsigned char* lb = lds + 4 * HTB + sa + boff;
            PG8_LDBX(B0, lb, 0); PG8_LDBX(B1, lb, HTB); PG8_SCHED; PG8_LDAX(At, la, 0);
            { _Pragma("unroll") for (int _i = 0; _i < 2; ++_i) { unsigned _o = l1 ? nO[1][_i] : cO[1][_i]; asm volatile("" : "+v"(_o));
                __builtin_amdgcn_global_load_lds((const unsigned*)(a1 + _o), (LAS unsigned*)(lds + sa1 + HTB + ldsw + _i * 8192), 16, 0, 0); } }
            int sdl = 0;
            if constexpr (Side::ON) { sdl = side.issue(wv); const int w1 = sdl + sdc; if (w1 == 0) PG8_WAIT_V(8); else if (w1 == 4) PG8_WAIT_V(12); else PG8_WAIT_V(16); } else PG8_WAIT_V(8);
            PG8_WAIT_L(0); PG8_BAR; PG8_MMA(0, 0, At, B0); PG8_MMA(0, 1, At, B1); PG8_BAR; PG8_SCHED;
            PG8_LDAX(At, la, HTB);
            PG8_STAGE(4 * HTB + sa, b2, voffB); PG8_STAGE(4 * HTB + sa + HTB, b2 + hstep, voffB); PG8_STAGE2(sa, a2, cO[0], nO[0]);
            if constexpr (Side::ON) { if (sdl == 0) PG8_WAIT_V(8); else PG8_WAIT_V(12); } else PG8_WAIT_V(8);
            PG8_WAIT_L(0); PG8_BAR; PG8_MMA(1, 0, At, B0); PG8_MMA(1, 1, At, B1);
            if constexpr (Side::ON) { sdc = side.template finish<1>(wv); }
            PG8_BAR; PG8_SCHED;
        }
        if (wr == 0) PG8_BAR;
        if constexpr (!Epi::AFTER_DRAIN) { const int _t = ltid(wv), _l = _t & 63, _w = __builtin_amdgcn_readfirstlane(_t >> 6); E(acc, cur, _w >> 2, _w & 3, _l & 15, _l >> 4); }
        if (!has_next) break;
#pragma unroll
        for (int a = 0; a < 2; ++a)
#pragma unroll
            for (int b = 0; b < 2; ++b)
#pragma unroll
                for (int m = 0; m < 4; ++m)
#pragma unroll
                    for (int n = 0; n < 2; ++n) acc[a][b][m][n] = (f32x4){0.f, 0.f, 0.f, 0.f};
        cur = nxt; cA = nA; cB = nB; ++ui;
#pragma unroll
        for (int h = 0; h < 2; ++h)
#pragma unroll
            for (int i = 0; i < 2; ++i) cO[h][i] = nO[h][i];
        if (wr == 1) PG8_BAR;
    }
    PG8_WAIT_V(0);
    PG8_BAR;
    if constexpr (Epi::AFTER_DRAIN) E.fused(acc, cur, lds, wv);
#undef PG8_SA
#undef PG8_SB
#undef PG8_STAGE
#undef PG8_STAGE2
#undef PG8_LDA
#undef PG8_LDAX
#undef PG8_LDBX
#undef PG8_LDB
#undef PG8_MMA
#undef PG8_WAIT_V
#undef PG8_WAIT_L
#undef PG8_BAR
#undef PG8_SCHED
#undef PG8_AOFF
}
template <bool FP8, class Epi, class Sched>
__device__ __forceinline__ void gemm_phase(LAS unsigned char* lds, const int K, const Sched& S, const Epi& E, const int wv) { NoSide ns; gemm_phase<FP8>(lds, K, S, E, wv, ns); }
}

struct SchedMoe1 {
    const char* X; const int* erow; const char* W; int G, c, lrow0;
    __device__ __forceinline__ bool next(int i, pg8::Unit& u) const {
        const int L = i * G + c; if (L >= 2816) return false;
        const int x = L & 7, uu = L >> 3, el = uu / 176, w = uu % 176, e = 2 * x + el;
        u.pm = e * 8 + (w & 7); u.pn = w >> 3; u.aux = e; u.lrows = lrow0 >= 0 ? lrow0 + (el * 2048 + (w & 7) * 256) * 4 : -1;
        u.a = X; u.arows = erow + u.pm * 256; u.b = W + (size_t)(e * 22 + u.pn) * 256 * D;
        return true;
    }
};
struct EpiSwiGLU {
    static constexpr bool PERM = true, AFTER_DRAIN = false;
    fp8_t* H; unsigned wscale0, wscale1;
    __device__ __forceinline__ void operator()(const f32x4 (&acc)[2][2][4][2], const pg8::Unit& u, int wr, int wc, int fr, int fq) const {
        const int row0 = u.pm * 256 + wr * 64 + fr, col0 = u.pn * 128 + wc * 32 + 8 * fq;
#pragma unroll
        for (int ai = 0; ai < 2; ++ai)
#pragma unroll
            for (int m = 0; m < 4; ++m) {
                const f32x4 g0 = acc[ai][0][m][0], g1 = acc[ai][0][m][1], u0 = acc[ai][1][m][0], u1 = acc[ai][1][m][1];
                u32x2 w;
                w.x = pk4_fp8(fast_silu(g0[0]) * u0[0], fast_silu(g0[1]) * u0[1], fast_silu(g0[2]) * u0[2], fast_silu(g0[3]) * u0[3]);
                w.y = pk4_fp8(fast_silu(g1[0]) * u1[0], fast_silu(g1[1]) * u1[1], fast_silu(g1[2]) * u1[2], fast_silu(g1[3]) * u1[3]);
                *(u32x2*)(H + (size_t)(row0 + ai * 128 + m * 16) * FF + col0) = w;
            }
    }
};
struct SchedMoe2 {
    const char* H; const char* W; int G, c;
    __device__ __forceinline__ bool next(int i, pg8::Unit& u) const {
        const int L = i * G + c; if (L >= 512) return false;
        const int x = L & 7, uu = L >> 3, el = uu >> 5, w = uu & 31, e = 2 * x + el;
        u.pm = e * 8 + (w & 7); u.pn = w >> 3; u.aux = e; u.lrows = -1;
        u.a = H + (size_t)u.pm * 256 * FF; u.arows = nullptr; u.b = W + (size_t)(e * 4 + u.pn) * 256 * FF;
        return true;
    }
};
struct EpiDownBf16 {
    static constexpr bool PERM = true, AFTER_DRAIN = false;
    bf16_t* Y; const float* gate; unsigned wscale0, wscale1;
    __device__ __forceinline__ void operator()(const f32x4 (&acc)[2][2][4][2], const pg8::Unit& u, int wr, int wc, int fr, int fq) const {
        const int row0 = u.pm * 256 + wr * 64 + fr, col0 = u.pn * 256 + wc * 32 + 8 * fq;
#pragma unroll
        for (int ai = 0; ai < 2; ++ai)
#pragma unroll
            for (int m = 0; m < 4; ++m) {
                const int r = row0 + ai * 128 + m * 16; const float g = gate[r];
#pragma unroll
                for (int bj = 0; bj < 2; ++bj) {
                    const f32x4 v0 = acc[ai][bj][m][0] * g, v1 = acc[ai][bj][m][1] * g;
                    u32x4 w; w.x = cvt_pk_bf16(v0[0], v0[1]); w.y = cvt_pk_bf16(v0[2], v0[3]); w.z = cvt_pk_bf16(v1[0], v1[1]); w.w = cvt_pk_bf16(v1[2], v1[3]);
                    *(u32x4*)(Y + (size_t)r * D + col0 + bj * 128) = w;
                }
            }
    }
};

template <class RowMap>
__device__ __forceinline__ void cvt_item(const float* W, int N, bf16_t* WT, int ldt, int kb, int nb, int lane, const RowMap& rm) {
    const int k0 = 64 * kb, n0 = 32 * nb, nq = lane & 7, kg = lane >> 3; const int n = n0 + 4 * nq; const bool ok = n < N;
    f32x4 v[8];
#pragma unroll
    for (int i = 0; i < 8; ++i) v[i] = ok ? ntl((const f32x4*)(W + (size_t)(k0 + 8 * kg + i) * N + n)) : (f32x4){0.f, 0.f, 0.f, 0.f};
#pragma unroll
    for (int j = 0; j < 4; ++j) { const int dr = rm(n + j);
        u32x4 o; o.x = pk2(v[0][j], v[1][j]); o.y = pk2(v[2][j], v[3][j]); o.z = pk2(v[4][j], v[5][j]); o.w = pk2(v[6][j], v[7][j]);
        if (dr >= 0) *(u32x4*)(WT + (size_t)dr * ldt + k0 + 8 * kg) = o; }
}
struct RmGateUp { int base; __device__ __forceinline__ int operator()(int n) const { return base + (n >> 7) * 256 + (n & 127); } };
struct RmLin { int base; __device__ __forceinline__ int operator()(int n) const { return base + n; } };

struct FastP {
    const float *w_gate, *w_up, *w_down; const float* gate; const int* erow; float* wsc;
    fp8_t *WguT, *WdT, *H2, *Hb; bf16_t* Ys;
};

struct CvtSrc { const float* W; int N; fp8_t* WT; int ldt; int rbase; int gu; float sc; int k0, n0; };
__device__ __forceinline__ void cvt_fp8_load(const CvtSrc& c, int lane, f32x4 (&v)[16]) {
    const int nq = lane & 7, kg = lane >> 3;
#pragma unroll
    for (int i = 0; i < 16; ++i) v[i] = ntl((const f32x4*)(c.W + (size_t)(c.k0 + 16 * kg + i) * c.N + c.n0 + 4 * nq));
}
__device__ __forceinline__ void cvt_fp8_store(const CvtSrc& c, int lane, const f32x4 (&v)[16]) {
    const int nq = lane & 7, kg = lane >> 3; const float sc = c.sc;
    const int n = c.n0 + 4 * nq; const int dr = c.gu ? c.rbase + (n >> 7) * 256 + (n & 127) : c.rbase + n;
    fp8_t* dst = c.WT + (size_t)dr * c.ldt + c.k0 + 16 * kg;
#pragma unroll
    for (int j = 0; j < 4; ++j) { u32x4 o;
        o.x = pk4_fp8(v[0][j] * sc, v[1][j] * sc, v[2][j] * sc, v[3][j] * sc); o.y = pk4_fp8(v[4][j] * sc, v[5][j] * sc, v[6][j] * sc, v[7][j] * sc);
        o.z = pk4_fp8(v[8][j] * sc, v[9][j] * sc, v[10][j] * sc, v[11][j] * sc); o.w = pk4_fp8(v[12][j] * sc, v[13][j] * sc, v[14][j] * sc, v[15][j] * sc);
        nts(o, (u32x4*)(dst + (size_t)j * c.ldt)); }
}
__device__ __forceinline__ float calib_scale(const float* W, LAS float* red, int tid) {
    float mx = 0.f;
#pragma unroll
    for (int i = 0; i < 8; ++i) { const f32x4 v = ((const f32x4*)W)[tid + NTHR * i]; mx = fmaxf(mx, fmaxf(fmaxf(fabsf(v[0]), fabsf(v[1])), fmaxf(fabsf(v[2]), fabsf(v[3])))); }
#pragma unroll
    for (int o = 1; o < 64; o <<= 1) mx = fmaxf(mx, __shfl_xor(mx, o));
    __syncthreads();
    if ((tid & 63) == 0) red[tid >> 6] = mx;
    __syncthreads();
    mx = fmaxf(fmaxf(fmaxf(red[0], red[1]), fmaxf(red[2], red[3])), fmaxf(fmaxf(red[4], red[5]), fmaxf(red[6], red[7])));
    __syncthreads();
    float e = rintf(log2f(32.f / fmaxf(mx, 1e-30f))); e = fminf(fmaxf(e, -40.f), 40.f);
    return exp2f(e);
}
__device__ __forceinline__ void phase_convert_moe(const FastP& p, LAS unsigned char* lds, int i0, int i1, int bw, int nbw, int wid, const bool have = false, const float ksg = 0.f, const float ksu = 0.f, const float ksd = 0.f) {
    const int tid = ltid(wid); const int wave = __builtin_amdgcn_readfirstlane(tid >> 6), lane = tid & 63;
    float sg, su, sd;
    if (have) { sg = ksg; su = ksu; sd = ksd; } else { sg = calib_scale(p.w_gate, (LAS float*)lds, tid); su = calib_scale(p.w_up, (LAS float*)lds, tid); sd = calib_scale(p.w_down, (LAS float*)lds, tid); }
    if (i0 == 0 && bw == 0 && tid == 0) { p.wsc[0] = sg; p.wsc[1] = su; p.wsc[2] = sd; p.wsc[4] = 1.f / sg; p.wsc[5] = 1.f / su; p.wsc[6] = 1.f / sd; }
    const int gw = i0 + bw * 8 + wave, NGW = nbw * 8; const int NIT = i1;
    constexpr int IGU = 8 * 88, ID = 22 * 32;
#define CVT_DESC(it_, c_) do { const int e_ = (it_) / (2 * IGU + ID); int r_ = (it_) % (2 * IGU + ID); \
        if (r_ < IGU) { c_.W = p.w_gate + (size_t)e_ * D * FF; c_.N = FF; c_.WT = p.WguT; c_.ldt = D; c_.rbase = e_ * 5632; c_.gu = 1; c_.sc = sg; c_.k0 = 128 * (r_ / 88); c_.n0 = 32 * (r_ % 88); } \
        else if (r_ < 2 * IGU) { r_ -= IGU; c_.W = p.w_up + (size_t)e_ * D * FF; c_.N = FF; c_.WT = p.WguT; c_.ldt = D; c_.rbase = e_ * 5632 + 128; c_.gu = 1; c_.sc = su; c_.k0 = 128 * (r_ / 88); c_.n0 = 32 * (r_ % 88); } \
        else { r_ -= 2 * IGU; c_.W = p.w_down + (size_t)e_ * FF * D; c_.N = D; c_.WT = p.WdT; c_.ldt = FF; c_.rbase = e_ * D; c_.gu = 0; c_.sc = sd; c_.k0 = 128 * (r_ / 32); c_.n0 = 32 * (r_ % 32); } } while (0)
    CvtSrc cur, nxt; f32x4 va[16], vb[16];
    if (gw < NIT) { CVT_DESC(gw, cur); cvt_fp8_load(cur, lane, va); }
    for (int it = gw; it < NIT; it += 2 * NGW) {
        const bool h1 = it + NGW < NIT, h2 = it + 2 * NGW < NIT;
        if (h1) { CVT_DESC(it + NGW, nxt); cvt_fp8_load(nxt, lane, vb); }
        cvt_fp8_store(cur, lane, va);
        if (h2) { CVT_DESC(it + 2 * NGW, cur); cvt_fp8_load(cur, lane, va); }
        if (h1) cvt_fp8_store(nxt, lane, vb);
    }
#undef CVT_DESC
}
struct CvtSide {
    static constexpr bool ON = true;
    const float *wg, *wu, *wd; fp8_t *WguT, *WdT; float sg, su, sd;
    int it, iend, istep, q, pend, tc, skip;
    const float* Wp; fp8_t* Tp; int N, ldt; float sc;
    f32x4 cv[4]; u32x4 co[4];
    __device__ __forceinline__ void desc() {
        constexpr int IGU = 8 * 88, ID = 22 * 32;
        const int e = it / (2 * IGU + ID); int r = it % (2 * IGU + ID);
        if (r < 2 * IGU) { const int up = r >= IGU; r -= up * IGU; const int k0 = 128 * (r / 88), n0 = 32 * (r % 88);
            Wp = (up ? wu : wg) + (size_t)e * D * FF + (size_t)k0 * FF + n0; N = FF; ldt = D; sc = up ? su : sg;
            Tp = WguT + (size_t)(e * 5632 + up * 128 + (n0 >> 7) * 256 + (n0 & 127)) * D + k0; }
        else { r -= 2 * IGU; const int k0 = 128 * (r / 32), n0 = 32 * (r % 32);
            Wp = wd + (size_t)e * FF * D + (size_t)k0 * D + n0; N = D; ldt = FF; sc = sd;
            Tp = WdT + (size_t)(e * D + n0) * FF + k0; }
    }
    __device__ __forceinline__ void init(const FastP& p, float sg_, float su_, float sd_, int first, int step_, int end_) {
        wg = p.w_gate; wu = p.w_up; wd = p.w_down; WguT = p.WguT; WdT = p.WdT; sg = sg_; su = su_; sd = sd_;
        it = first; istep = step_; iend = end_; q = 0; pend = 0; tc = 0; skip = 1; Wp = wg; Tp = WguT; N = FF; ldt = D; sc = sg_;
        if (it < iend) desc();
    }
    __device__ __forceinline__ bool busy() const { return it < iend; }
    __device__ __forceinline__ int issue(const int wv) {
        if (it >= iend) { pend = 0; return 0; }
        if (skip && (++tc & 3) == 0) { pend = 0; return 0; }
        const int lane = ltid(wv) & 63, nq = lane & 7, kg = lane >> 3;
        const unsigned voff = (unsigned)((16 * kg + 4 * q) * N + 4 * nq) * 4u;
#pragma unroll
        for (int i = 0; i < 4; ++i) { const float* b = Wp + (size_t)i * N; asm volatile("global_load_dwordx4 %0, %1, %2 nt" : "=v"(cv[i]) : "v"(voff), "s"(b) : "memory"); }
        pend = 1; return 4;
    }
    template <int INLOOP> __device__ __forceinline__ int finish(const int wv) {
        if (!pend) return 0;
        if constexpr (INLOOP) asm volatile("s_waitcnt vmcnt(6)" : "+v"(cv[0]), "+v"(cv[1]), "+v"(cv[2]), "+v"(cv[3]) :: "memory");
        else asm volatile("s_waitcnt vmcnt(0)" : "+v"(cv[0]), "+v"(cv[1]), "+v"(cv[2]), "+v"(cv[3]) :: "memory");
#pragma unroll
        for (int j = 0; j < 4; ++j) { co[j].x = co[j].y; co[j].y = co[j].z; co[j].z = co[j].w; co[j].w = pk4_fp8(cv[0][j] * sc, cv[1][j] * sc, cv[2][j] * sc, cv[3][j] * sc); }
        pend = 0;
        if (++q < 4) return 0;
        const int lane = ltid(wv) & 63, nq = lane & 7, kg = lane >> 3;
        fp8_t* dst = Tp + (unsigned)(4 * nq * ldt + 16 * kg);
#pragma unroll
        for (int j = 0; j < 4; ++j) nts(co[j], (u32x4*)(dst + (size_t)j * ldt));
        it += istep; q = 0;
        if (it < iend) desc();
        return 4;
    }
};
struct RmWin { __device__ __forceinline__ int operator()(int n) const {
    if (n >= INC || (n >= 2048 && n < 2064)) return -1;
    const int f = n < 2048 ? n : n - 16; const int region = f >> 9, h = (f >> 7) & 3; int o = f & 127;
    if (region == 4 || region == 5) { const int half = o >> 6, oo = o & 63; o = half * 64 + ((oo & 31) << 1) + (oo >> 5); }
    return region * 512 + h * 128 + o; } };
struct FastQ {
    const float *x, *ctx, *c, *c_ctx, *w_ada, *b_ada, *norm1_w, *w_in, *w_out, *mnw, *rnw, *w_router, *norm2_w;
    float *mod, *ropetab, *G, *normw, *wsc2, *biasr; bf16_t* WrT;
    float *_unused0; bf16_t *WinT, *WoutT, *XN, *Pb;
};
__device__ __forceinline__ void phase_mod(const FastQ& p, LAS unsigned char* lds, int bid, int nb, int wid) {
    LAS float* sv = (LAS float*)lds; LAS float* red = sv + 5 * 1024;
    const int tid = ltid(wid);
    for (int i = tid; i < 5 * 1024; i += NTHR) { const int r = i >> 10, k = i & 1023; const float v = r < 4 ? p.c[r * 1024 + k] : p.c_ctx[k]; sv[i] = v / (1.f + expf(-v)); }
    __syncthreads();
    for (int cb = bid; cb < 192; cb += nb) {
        const int cl = tid & 31, kg = tid >> 5, col = cb * 32 + cl;
        float a0 = 0, a1 = 0, a2 = 0, a3 = 0, a4 = 0;
#pragma unroll 32
        for (int kk = 0; kk < 64; ++kk) { const int k = kg * 64 + kk; const float w = ntl(p.w_ada + (size_t)k * 6144 + col); a0 += sv[k] * w; a1 += sv[1024 + k] * w; a2 += sv[2048 + k] * w; a3 += sv[3072 + k] * w; a4 += sv[4096 + k] * w; }
        red[(kg * 5 + 0) * 32 + cl] = a0; red[(kg * 5 + 1) * 32 + cl] = a1; red[(kg * 5 + 2) * 32 + cl] = a2; red[(kg * 5 + 3) * 32 + cl] = a3; red[(kg * 5 + 4) * 32 + cl] = a4;
        __syncthreads();
        if (tid < 160) { const int r = tid >> 5, c2 = tid & 31; float sum = 0.f; for (int g = 0; g < 16; ++g) sum += red[(g * 5 + r) * 32 + c2]; p.mod[r * 6144 + cb * 32 + c2] = sum + p.b_ada[cb * 32 + c2]; }
        __syncthreads();
    }
    for (int i = bid * NTHR + tid; i < 1024; i += nb * NTHR) p.normw[i] = i < 512 ? p.mnw[i] : p.rnw[i - 512];
    for (int i = bid * NTHR + tid; i < 16 * 1024; i += nb * NTHR) { const int e = i >> 10, k = i & 1023; p.WrT[i] = (bf16_t)f2bf(p.w_router[k * 16 + e]); }
    for (int i = bid * NTHR + tid; i < 2048; i += nb * NTHR) { const int pos = i >> 5, f = i & 31; const float ang = (float)pos * powf(10000.f, -(float)f / 32.f); p.ropetab[2 * i] = cosf(ang); p.ropetab[2 * i + 1] = sinf(ang); }
}
__device__ __forceinline__ void phase_convert_small(const FastQ& p, LAS unsigned char* lds, int bid, int nb, int wid, int mode = 0) {
    const int tid = ltid(wid); const int wave = __builtin_amdgcn_readfirstlane(tid >> 6), lane = tid & 63;
    const int gw = bid * 8 + wave, NGW = nb * 8;
    constexpr int IIN = 16 * 129, IOUT = 16 * 32;
    if (mode == 2) { const int it = IIN + (bid - 64) * 8 + wave; if (bid >= 64 && bid < 128) { const int r = it - IIN; cvt_item(p.w_out, D, p.WoutT, D, r / 32, r % 32, lane, RmLin{0}); } return; }
    if (mode == 1) { cvt_item(p.w_in, INC, p.WinT, D, gw / 129, gw % 129, lane, RmWin{});
        if (bid == 176 || bid == 180) { const int it = NGW + (bid == 180 ? 8 : 0) + wave; cvt_item(p.w_in, INC, p.WinT, D, it / 129, it % 129, lane, RmWin{}); }
        return; }
    for (int rnd = 0; rnd * NGW < IIN + IOUT; ++rnd) {
        const int it = rnd == 0 ? gw : rnd * NGW + (NGW - 8 * NB - 1 - gw);
        if (it < rnd * NGW || it >= (rnd + 1) * NGW || it >= IIN + IOUT) continue;
        if (it < IIN) cvt_item(p.w_in, INC, p.WinT, D, it / 129, it % 129, lane, RmWin{});
        else { const int r = it - IIN; cvt_item(p.w_out, D, p.WoutT, D, r / 32, r % 32, lane, RmLin{0}); }
    }
}
#define ROWDOT16(g, hh, wr) do { const f32x4 w0 = (wr)[0], w1 = (wr)[1], w2 = (wr)[2], w3 = (wr)[3]; \
    g[0] += hh * w0[0]; g[1] += hh * w0[1]; g[2] += hh * w0[2]; g[3] += hh * w0[3]; g[4] += hh * w1[0]; g[5] += hh * w1[1]; g[6] += hh * w1[2]; g[7] += hh * w1[3]; \
    g[8] += hh * w2[0]; g[9] += hh * w2[1]; g[10] += hh * w2[2]; g[11] += hh * w2[3]; g[12] += hh * w3[0]; g[13] += hh * w3[1]; g[14] += hh * w3[2]; g[15] += hh * w3[3]; } while (0)
__device__ __forceinline__ float reduce16x64(float (&g)[16], int lane) {
#pragma unroll
    for (int j = 0; j < 16; ++j) g[j] += __shfl_xor(g[j], 32);
    float g1[8], g2[4], g3[2];
    { const bool hi = lane & 16;
#pragma unroll
      for (int j = 0; j < 8; ++j) { const float mine = hi ? g[j + 8] : g[j], theirs = hi ? g[j] : g[j + 8]; g1[j] = mine + __shfl_xor(theirs, 16); } }
    { const bool hi = lane & 8;
#pragma unroll
      for (int j = 0; j < 4; ++j) { const float mine = hi ? g1[j + 4] : g1[j], theirs = hi ? g1[j] : g1[j + 4]; g2[j] = mine + __shfl_xor(theirs, 8); } }
    { const bool hi = lane & 4;
#pragma unroll
      for (int j = 0; j < 2; ++j) { const float mine = hi ? g2[j + 2] : g2[j], theirs = hi ? g2[j] : g2[j + 2]; g3[j] = mine + __shfl_xor(theirs, 4); } }
    float r; { const bool hi = lane & 2; const float mine = hi ? g3[1] : g3[0], theirs = hi ? g3[0] : g3[1]; r = mine + __shfl_xor(theirs, 2); }
    r += __shfl_xor(r, 1);
    return r;
}
__device__ __forceinline__ void phase_tables(const FastQ& p, LAS unsigned char* lds, int pb, int wid) {
    const int tid = ltid(wid); LAS float* part = (LAS float*)lds;
    const float* md = p.mod + pb * 6144;
    for (int k = tid; k < D; k += NTHR) p.wsc2[pb * D + k] = p.norm2_w[k] * (1.f + md[4096 + k]);
    { const int e = tid & 15, kg = tid >> 4; float a = 0.f; for (int k = kg * 32; k < kg * 32 + 32; ++k) a += md[3072 + k] * p.w_router[k * 16 + e]; part[kg * 16 + e] = a; }
    __syncthreads();
    if (tid < 16) { float a = 0.f; for (int g2 = 0; g2 < 32; ++g2) a += part[g2 * 16 + tid]; p.biasr[pb * 16 + tid] = a; }
    __syncthreads();
}
__device__ __forceinline__ void phase_norm1_t16(const FastQ& p, LAS unsigned char* lds, int bid, int nb, int wid) {
    LAS float* wg = (LAS float*)lds; LAS float* SSQ = wg + 20480; LAS float* GP = wg + 20992; LAS float* part = wg + 26000;
    const int tid = ltid(wid), wave = __builtin_amdgcn_readfirstlane(tid >> 6), lane = tid & 63;
#pragma unroll
    for (int i = tid; i < 1024 * 4; i += NTHR) { const int k = i >> 2, j = i & 3; *(LAS f32x4*)(wg + k * 16 + (k >> 2) * 16 + 4 * j) = *(const f32x4*)(p.w_in + (size_t)k * INC + 2048 + 4 * j); }
    __syncthreads();
    const int pb = nb == 256 ? -1 : bid - (nb - NB);
    if (pb >= 0) {
        const float* md = p.mod + pb * 6144;
        for (int k = tid; k < D; k += NTHR) p.wsc2[pb * D + k] = p.norm2_w[k] * (1.f + md[4096 + k]);
        { const int e = tid & 15, kg = tid >> 4; float a = 0.f; for (int k = kg * 32; k < kg * 32 + 32; ++k) a += md[3072 + k] * p.w_router[k * 16 + e]; part[kg * 16 + e] = a; }
        __syncthreads();
        if (tid < 16) { float a = 0.f; for (int g2 = 0; g2 < 32; ++g2) a += part[g2 * 16 + tid]; p.biasr[pb * 16 + tid] = a; }
    }
    constexpr int NT16 = MA / 16;
    const int t0 = (int)(((long long)bid * NT16) / nb), t1 = (int)(((long long)(bid + 1) * NT16) / nb);
    const int r = lane & 15, q = lane >> 4, cb = 128 * wave + 4 * q;
#define N1T_SRC(tile_) (((tile_) < ML / 16 ? p.x + (size_t)(16 * (tile_) + r) * D : p.ctx + (size_t)(16 * (tile_) + r - ML) * D) + cb)
    f32x4 nv[8], Aw[8], Hs[8]; int bcur = -1;
    if (t0 < t1) { const float* src = N1T_SRC(t0);
#pragma unroll
        for (int i = 0; i < 8; ++i) nv[i] = ntl((const f32x4*)(src + 16 * i)); }
    for (int tile = t0; tile < t1; ++tile) {
        const int buf = (tile - t0) & 1;
        f32x4 v[8];
#pragma unroll
        for (int i = 0; i < 8; ++i) v[i] = nv[i];
        if (tile + 1 < t1) { const int lane2 = ltid(wid) & 63; const int r2 = lane2 & 15, cb2 = 128 * wave + 4 * (lane2 >> 4);
            const float* src = ((tile + 1) < ML / 16 ? p.x + (size_t)(16 * (tile + 1) + r2) * D : p.ctx + (size_t)(16 * (tile + 1) + r2 - ML) * D) + cb2;
#pragma unroll
            for (int i = 0; i < 8; ++i) nv[i] = ntl((const f32x4*)(src + 16 * i)); }
        const int bt = tile < ML / 16 ? (tile >> 8) : 4;
        if (bt != bcur) { bcur = bt; const float* md = p.mod + bt * 6144 + cb; const float* nw = p.norm1_w + cb;
#pragma unroll
            for (int i = 0; i < 8; ++i) { Aw[i] = *(const f32x4*)(nw + 16 * i) * (*(const f32x4*)(md + 1024 + 16 * i) + 1.f); Hs[i] = *(const f32x4*)(md + 16 * i); } }
        float ss = 0.f;
#pragma unroll
        for (int i = 0; i < 8; ++i) ss += (v[i][0] * v[i][0] + v[i][1] * v[i][1]) + (v[i][2] * v[i][2] + v[i][3] * v[i][3]);
        ss += __shfl_xor(ss, 16); ss += __shfl_xor(ss, 32);
        if (q == 0) SSQ[buf * 128 + r * 8 + wave] = ss;
        __syncthreads();
        float rstd;
        { const f32x4 s0 = *(const LAS f32x4*)(SSQ + buf * 128 + r * 8), s1 = *(const LAS f32x4*)(SSQ + buf * 128 + r * 8 + 4);
          rstd = rsqrtf((((s0[0] + s0[1]) + (s0[2] + s0[3])) + ((s1[0] + s1[1]) + (s1[2] + s1[3]))) * (1.f / D) + EPS); }
        f32x4 acc = (f32x4){0.f, 0.f, 0.f, 0.f};
        bf16_t* xo2 = p.XN + (size_t)(16 * tile + r) * D + 128 * wave + 8 * (q >> 1) + 16 * (q & 1);
#pragma unroll
        for (int i = 0; i < 8; i += 2) { u32x2 o[2];
#pragma unroll
            for (int h = 0; h < 2; ++h) { const f32x4 ha = v[i + h] * rstd * Aw[i + h] + Hs[i + h];
                o[h].x = pk2(ha[0], ha[1]); o[h].y = pk2(ha[2], ha[3]);
#pragma unroll
                for (int e = 0; e < 4; ++e) { const int kk = cb + 16 * (i + h) + e; const float b = wg[kk * 16 + (kk >> 2) * 16 + r]; acc = __builtin_amdgcn_mfma_f32_16x16x4f32(ha[e], b, acc, 0, 0, 0); } }
            *(u32x4*)(xo2 + 16 * i) = widen_pair(o[0], o[1]); }
        *(LAS f32x4*)(GP + buf * 2048 + wave * 256 + lane * 4) = acc;
        __syncthreads();
        if (tid < 256) { float g = 0.f;
#pragma unroll
            for (int w2 = 0; w2 < 8; ++w2) g += GP[buf * 2048 + w2 * 256 + tid];
            const int ls = tid >> 2, gi = tid & 3; p.G[(size_t)(16 * tile + 4 * (ls >> 4) + gi) * 16 + (ls & 15)] = g; }
    }
#undef N1T_SRC
}
__device__ __forceinline__ void phase_norm1(const FastQ& p, LAS unsigned char* lds, int bid, int nb, int wid) {
    LAS float* wg = (LAS float*)lds;
    const int tid = ltid(wid), wave = __builtin_amdgcn_readfirstlane(tid >> 6), lane = tid & 63;
#pragma unroll
    for (int i = tid; i < 1024 * 4; i += NTHR) { const int k = i >> 2, j = i & 3; *(LAS f32x4*)(wg + k * 20 + (k >> 4) * 4 + 4 * j) = *(const f32x4*)(p.w_in + (size_t)k * INC + 2048 + 4 * j); }
    __syncthreads();
    const int pb = bid - (nb - NB);
    if (pb >= 0) {
        const float* md = p.mod + pb * 6144;
        for (int k = tid; k < D; k += NTHR) p.wsc2[pb * D + k] = p.norm2_w[k] * (1.f + md[4096 + k]);
        LAS float* part = wg + 1024 * 20 + 512;
        { const int e = tid & 15, kg = tid >> 4; float a = 0.f; for (int k = kg * 32; k < kg * 32 + 32; ++k) a += md[3072 + k] * p.w_router[k * 16 + e]; part[kg * 16 + e] = a; }
        __syncthreads();
        if (tid < 16) { float a = 0.f; for (int g2 = 0; g2 < 32; ++g2) a += part[g2 * 16 + tid]; p.biasr[pb * 16 + tid] = a; }
    }
    const int gw = bid * 8 + wave, NGW = nb * 8;
#define N1_SRC(r_) ((r_) < ML ? p.x + (size_t)(r_) * D : p.ctx + (size_t)((r_) - ML) * D)
    f32x4 nv[4];
    if (gw < MA) { const float* src = N1_SRC(gw) + 16 * lane;
#pragma unroll
        for (int i = 0; i < 4; ++i) nv[i] = ntl((const f32x4*)(src + 4 * i)); }
    for (int row = gw; row < MA; row += NGW) {
        f32x4 v[4];
#pragma unroll
        for (int i = 0; i < 4; ++i) v[i] = nv[i];
        if (row + NGW < MA) { const int lane2 = ltid(wid) & 63; const float* src = N1_SRC(row + NGW) + 16 * lane2;
#pragma unroll
            for (int i = 0; i < 4; ++i) nv[i] = ntl((const f32x4*)(src + 4 * i)); }
        const float* md = p.mod + (row < ML ? (row >> 12) : 4) * 6144 + 16 * lane; const float* nw = p.norm1_w + 16 * lane;
        float ss0 = 0.f;
#pragma unroll
        for (int i = 0; i < 4; ++i) ss0 += (v[i][0] * v[i][0] + v[i][1] * v[i][1]) + (v[i][2] * v[i][2] + v[i][3] * v[i][3]);
#pragma unroll
        for (int o = 1; o < 64; o <<= 1) ss0 += __shfl_xor(ss0, o);
        const float rstd0 = rsqrtf(ss0 * (1.f / D) + EPS);
        float g0[16];
#pragma unroll
        for (int j = 0; j < 16; ++j) g0[j] = 0.f;
        u32x4 pk0[2];
#pragma unroll
        for (int i = 0; i < 4; ++i) {
            asm volatile("" ::: "memory");
            const f32x4 w4 = *(const f32x4*)(nw + 4 * i), s4 = *(const f32x4*)(md + 1024 + 4 * i) + 1.f, h4 = *(const f32x4*)(md + 4 * i);
            const f32x4 ha = v[i] * rstd0 * w4 * s4 + h4;
            pk0[i >> 1][(i & 1) * 2] = cvt_pk_bf16(ha[0], ha[1]); pk0[i >> 1][(i & 1) * 2 + 1] = cvt_pk_bf16(ha[2], ha[3]);
#pragma unroll
            for (int c = 0; c < 4; ++c) { const float x0 = ha[c]; const LAS f32x4* wr = (const LAS f32x4*)(wg + (16 * lane + 4 * i + c) * 20 + lane * 4);
                const f32x4 w0 = wr[0], w1 = wr[1], w2 = wr[2], w3 = wr[3];
                g0[0] += x0 * w0[0]; g0[1] += x0 * w0[1]; g0[2] += x0 * w0[2]; g0[3] += x0 * w0[3]; g0[4] += x0 * w1[0]; g0[5] += x0 * w1[1]; g0[6] += x0 * w1[2]; g0[7] += x0 * w1[3];
                g0[8] += x0 * w2[0]; g0[9] += x0 * w2[1]; g0[10] += x0 * w2[2]; g0[11] += x0 * w2[3]; g0[12] += x0 * w3[0]; g0[13] += x0 * w3[1]; g0[14] += x0 * w3[2]; g0[15] += x0 * w3[3];
                if (c & 1) asm volatile("" ::: "memory"); }
        }
        { u32x4* xo = (u32x4*)(p.XN + (size_t)row * D + 16 * lane); xo[0] = pk0[0]; xo[1] = pk0[1]; }
        const float s0 = reduce16x64(g0, lane);
        if ((lane & 33) == 0) p.G[(size_t)row * 16 + (lane >> 1)] = s0;
    }
#undef N1_SRC
}
struct SchedInProj {
    const char* XN; const char* W; int G, c;
    __device__ __forceinline__ bool next(int i, pg8::Unit& u) const {
        const int L = i * G + c; if (L >= 1056) return false;
        if (L < 1024) { const int x = L & 7, uu = L >> 3; u.pm = 8 * x + (uu & 7); u.pn = uu >> 3; }
        else { const int r = L - 1024; u.pm = 64 + (r & 3); const int q = r >> 2; u.pn = (q < 4 ? 2 : 6) + q; }
        u.aux = 0; u.lrows = -1; u.arows = nullptr;
        u.a = XN + (size_t)u.pm * 256 * (D * 2); u.b = W + (size_t)u.pn * 256 * (D * 2);
        return true;
    }
};
struct EpiInProj {
    static constexpr bool PERM = true, AFTER_DRAIN = false;
    bf16_t* P; const float* tab;
    __device__ __forceinline__ void operator()(const f32x4 (&acc)[2][2][4][2], const pg8::Unit& u, int wr, int wc, int fr, int fq) const {
        const int row0 = u.pm * 256 + wr * 64 + fr, col0 = u.pn * 256 + wc * 32 + 8 * fq;
        const bool kcol = (u.pn == 2 || u.pn == 3 || u.pn == 10 || u.pn == 11);
        const float sc = kcol ? 0.08838834764831845f : 1.f;
        const bool rope = (u.pn >= 8 && u.pn < 12 && u.pm < 64);
        const int fbase = (wc & 1) * 16 + 4 * fq;
#pragma unroll
        for (int ai = 0; ai < 2; ++ai)
#pragma unroll
            for (int m = 0; m < 4; ++m) {
                const int r = row0 + ai * 128 + m * 16;
                f32x4 cs0 = (f32x4){1.f, 0.f, 1.f, 0.f}, cs1 = cs0;
                if (rope) { const int t = r & 4095; const int pos = (wc >> 1) ? (t & 63) : (t >> 6); const f32x4* tp = (const f32x4*)(tab + 2 * (pos * 32 + fbase)); cs0 = tp[0]; cs1 = tp[1]; }
#pragma unroll
                for (int bj = 0; bj < 2; ++bj) {
                    f32x4 v0 = acc[ai][bj][m][0] * sc, v1 = acc[ai][bj][m][1] * sc;
                    if (rope) {
                        const f32x4 a = v0, b = v1;
                        v0[0] = a[0] * cs0[0] - a[1] * cs0[1]; v0[1] = a[0] * cs0[1] + a[1] * cs0[0]; v0[2] = a[2] * cs0[2] - a[3] * cs0[3]; v0[3] = a[2] * cs0[3] + a[3] * cs0[2];
                        v1[0] = b[0] * cs1[0] - b[1] * cs1[1]; v1[1] = b[0] * cs1[1] + b[1] * cs1[0]; v1[2] = b[2] * cs1[2] - b[3] * cs1[3]; v1[3] = b[2] * cs1[3] + b[3] * cs1[2];
                    }
                    u32x4 w; w.x = cvt_pk_bf16(v0[0], v0[1]); w.y = cvt_pk_bf16(v0[2], v0[3]); w.z = cvt_pk_bf16(v1[0], v1[1]); w.w = cvt_pk_bf16(v1[2], v1[3]);
                    *(u32x4*)(P + (size_t)r * PBC + col0 + bj * 128) = w;
                }
            }
    }
};

typedef short s16x4 __attribute__((ext_vector_type(4)));
constexpr int NCH = 34;
constexpr int RS_QK = 272, RS_V = 304;
struct MixP {
    const bf16_t* Pb; const float* G; const float* gate_bias; const float* decay_logit; const float* normw;
    bf16_t* ST; float* NV; float* SC; bf16_t* YM;
};
__device__ __forceinline__ size_t mix_row(int b, int ch, int p) { return ch < 32 ? (size_t)b * T + ch * 128 + p : (size_t)ML + b * TC + (ch - 32) * 128 + p; }
__device__ __forceinline__ bf16x8 tr_frag(const LAS unsigned char* pl, int rs) {
    const s16x4 lo = __builtin_amdgcn_ds_read_tr16_b64_v4i16((LAS s16x4*)(pl));
    const s16x4 hi = __builtin_amdgcn_ds_read_tr16_b64_v4i16((LAS s16x4*)(pl + 4 * rs));
    return __builtin_shufflevector(lo, hi, 0, 1, 2, 3, 4, 5, 6, 7);
}
__device__ __forceinline__ void stage128(LAS unsigned char* dst, int rs, const bf16_t* src, size_t gstride, int wid) {
    const int t = ltid(wid), r = t >> 2;
#pragma unroll
    for (int j = 0; j < 4; ++j) { const int c = (j * 4 + (t & 3)) * 8; const u32x4 v = *(const u32x4*)(src + (size_t)r * gstride + c); *(LAS u32x4*)(dst + r * rs + c * 2) = v; }
}
template <int OP> __device__ __forceinline__ float scan_fb(float x, int tid, LAS float* tot) {
    const int lane = tid & 63, w = tid >> 6;
    if (w < 2) {
#pragma unroll
        for (int o = 1; o < 64; o <<= 1) { const float t = __shfl_up(x, o); if (lane >= o) x = OP ? fmaxf(x, t) : x + t; }
    } else if (w < 4) {
#pragma unroll
        for (int o = 1; o < 64; o <<= 1) { const float t = __shfl_down(x, o); if (lane + o < 64) x = OP ? fmaxf(x, t) : x + t; }
    }
    if (tid == 63) tot[2 * OP] = x;
    if (tid == 192) tot[2 * OP + 1] = x;
    __syncthreads();
    if (w == 1) x = OP ? fmaxf(x, tot[2 * OP]) : x + tot[2 * OP];
    if (w == 2) x = OP ? fmaxf(x, tot[2 * OP + 1]) : x + tot[2 * OP + 1];
    return x;
}
__device__ __forceinline__ void gate_load(const MixP& p, int kind, int b, int h, int ch, int tid, float& ig, float& lf) {
    ig = 0.f; lf = 0.f;
    if (tid < 256) {
        const int pq = tid & 127, dirb = tid >> 7;
        if (kind == 0) { const float* g = p.G + mix_row(b, ch, pq) * 16; ig = g[dirb * 4 + h] + p.gate_bias[dirb * 4 + h]; lf = g[8 + dirb * 4 + h] + p.gate_bias[8 + dirb * 4 + h]; }
        else lf = p.decay_logit[dirb * 4 + h];
    }
}
__device__ __forceinline__ void gate_scan(float ig, float lfraw, int tid, LAS float* tot, float& bb, float& aa, float& cm) {
    const float lf = tid < 256 ? logsigmoidf_(lfraw) : 0.f;
    bb = scan_fb<0>(lf, tid, tot);
    aa = ig - bb;
    cm = scan_fb<1>(aa, tid, tot);
}

__device__ __forceinline__ void phase_mixA(const MixP& p, LAS unsigned char* lds, int bid, int nb, int wid) {
    LAS unsigned char* Kimg = lds; LAS unsigned char* VF = lds + 34816; LAS unsigned char* VB = VF + 38912;
    LAS float* arr = (LAS float*)(VB + 38912);
    LAS float *wF = arr, *wB = arr + 128, *tot = arr + 256, *amx = arr + 260;
    const int tid = ltid(wid), wave = __builtin_amdgcn_readfirstlane(tid >> 6), lane = tid & 63, g = lane >> 4, i16 = lane & 15, q = i16 >> 2, pp = i16 & 3;
    const int r = tid >> 2; constexpr int NTILE = 2 * 16 * NCH;
    u32x4 kv[4], vv[4]; float ig = 0.f, lfr = 0.f;
#define MIXA_LOAD(tile_, KV, VV, IG, LF) do { const int ch_ = (tile_) % NCH, h_ = ((tile_) / NCH) & 3, b_ = ((tile_) / (NCH * 4)) & 3, kind_ = (tile_) / (NCH * 16); const size_t row0_ = mix_row(b_, ch_, 0); \
        const bf16_t* ksrc = p.Pb + (row0_ + r) * PBC + (kind_ ? PB_RK : PB_MK) + h_ * 128; const bf16_t* vsrc = p.Pb + (row0_ + r) * PBC + (kind_ ? PB_RV : PB_MV) + h_ * 128; \
        _Pragma("unroll") for (int j = 0; j < 4; ++j) { const int c = (j * 4 + (tid & 3)) * 8; KV[j] = *(const u32x4*)(ksrc + c); VV[j] = *(const u32x4*)(vsrc + c); } \
        gate_load(p, kind_, b_, h_, ch_, tid, IG, LF); } while (0)
    if (bid < NTILE) MIXA_LOAD(bid, kv, vv, ig, lfr);
    for (int tile = bid; tile < NTILE; tile += nb) {
        u32x4 kv2[4], vv2[4]; float ig2 = 0.f, lfr2 = 0.f;
        if (tile + nb < NTILE) MIXA_LOAD(tile + nb, kv2, vv2, ig2, lfr2);
        else {
#pragma unroll
            for (int j = 0; j < 4; ++j) { kv2[j] = kv[j]; vv2[j] = vv[j]; } }
        float bb, aa, cm; gate_scan(ig, lfr, tid, tot, bb, aa, cm);
        if (tid == 127) { amx[0] = cm; float* sc = p.SC + ((size_t)tile * 2 + 0) * 4; sc[0] = bb; sc[1] = cm; }
        if (tid == 128) { amx[1] = cm; float* sc = p.SC + ((size_t)tile * 2 + 1) * 4; sc[0] = bb; sc[1] = cm; }
        __syncthreads();
        if (tid < 256) (tid < 128 ? wF : wB)[tid & 127] = __expf(aa - amx[tid >> 7]);
#pragma unroll
        for (int j = 0; j < 4; ++j) { const int c = (j * 4 + (tid & 3)) * 8; *(LAS u32x4*)(Kimg + r * RS_QK + c * 2) = kv[j]; }
        __syncthreads();
        {
            const float wf = wF[r], wb = wB[r];
#pragma unroll
            for (int j = 0; j < 4; ++j) { const int c = (j * 4 + (tid & 3)) * 8; const u32x4 v = vv[j]; u32x4 of, ob;
#pragma unroll
                for (int e = 0; e < 4; ++e) { const float lo = __uint_as_float(v[e] << 16), hi = __uint_as_float(v[e] & 0xffff0000u); of[e] = cvt_pk_bf16(lo * wf, hi * wf); ob[e] = cvt_pk_bf16(lo * wb, hi * wb); }
                *(LAS u32x4*)(VF + r * RS_V + c * 2) = of; *(LAS u32x4*)(VB + r * RS_V + c * 2) = ob; }
            if (tid < 256) { const int rr = tid & 127; LAS unsigned char* V = tid < 128 ? VF : VB; const float w = (tid < 128 ? wF : wB)[rr];
                *(LAS u32x4*)(V + rr * RS_V + 256) = (u32x4){f2bf(w), 0u, 0u, 0u}; *(LAS u32x4*)(V + rr * RS_V + 272) = (u32x4){0u, 0u, 0u, 0u}; }
        }
        __syncthreads();
        const int dir = wave >> 2, kb = wave & 3; const LAS unsigned char* V = dir ? VB : VF;
        f32x4 acc[2][9];
#pragma unroll
        for (int mi = 0; mi < 2; ++mi)
#pragma unroll
            for (int ni = 0; ni < 9; ++ni) acc[mi][ni] = (f32x4){0.f, 0.f, 0.f, 0.f};
#pragma unroll
        for (int ks = 0; ks < 4; ++ks) {
            const int srow = 32 * ks + 8 * g + q;
            bf16x8 a[2];
#pragma unroll
            for (int mi = 0; mi < 2; ++mi) a[mi] = tr_frag(Kimg + srow * RS_QK + (32 * kb + 16 * mi + 4 * pp) * 2, RS_QK);
#pragma unroll
            for (int ni = 0; ni < 9; ++ni) { const bf16x8 bv = tr_frag(V + srow * RS_V + (16 * ni + 4 * pp) * 2, RS_V);
#pragma unroll
                for (int mi = 0; mi < 2; ++mi) acc[mi][ni] = __builtin_amdgcn_mfma_f32_16x16x32_bf16(a[mi], bv, acc[mi][ni], 0, 0, 0); }
        }
        bf16_t* st = p.ST + ((size_t)tile * 2 + dir) * 16384;
#pragma unroll
        for (int mi = 0; mi < 2; ++mi) { const int k0 = 32 * kb + 16 * mi + 4 * g;
#pragma unroll
            for (int ni = 0; ni < 8; ni += 2) { const f32x4 va = acc[mi][ni], vb = acc[mi][ni + 1]; u32x2 oa, ob; oa.x = pk2(va[0], va[1]); oa.y = pk2(va[2], va[3]); ob.x = pk2(vb[0], vb[1]); ob.y = pk2(vb[2], vb[3]);
                *(u32x4*)(st + (size_t)(16 * (ni + (g & 1)) + i16) * 128 + 32 * kb + 16 * mi + 8 * (g >> 1)) = widen_pair(oa, ob); }
            if (i16 == 0) *(f32x4*)(p.NV + ((size_t)tile * 2 + dir) * 128 + k0) = acc[mi][8]; }
#pragma unroll
        for (int j = 0; j < 4; ++j) { kv[j] = kv2[j]; vv[j] = vv2[j]; }
        ig = ig2; lfr = lfr2;
        __syncthreads();
    }
#undef MIXA_LOAD
}

__device__ __forceinline__ void phase_mixB(const MixP& p, int bid, int nb, int wid) {
    for (int w = bid * NTHR + ltid(wid); w < 64 * 2048; w += nb * NTHR) {
        const int combo = w >> 11, e = w & 2047, v = e >> 4, k0 = (e & 15) * 8;
        const int dir = combo & 1, h = (combo >> 1) & 3, b = (combo >> 3) & 3, kind = combo >> 5;
        const int tb = ((kind * 4 + b) * 4 + h) * NCH;
        float C[8], n[8];
#pragma unroll
        for (int j = 0; j < 8; ++j) { C[j] = 0.f; n[j] = 0.f; }
        float m = 0.f;
#pragma unroll 1
        for (int jb = 0; jb < NCH; jb += 17) {
            u32x4 U[17]; float BL[17], AM[17];
#pragma unroll
            for (int jj = 0; jj < 17; ++jj) { const int j = jb + jj; const int ch = dir ? 33 - j : (j < 2 ? 32 + j : j - 2); U[jj] = ntl((const u32x4*)(p.ST + ((size_t)(tb + ch) * 2 + dir) * 16384 + v * 128 + k0));
                const float* scl = p.SC + ((size_t)(tb + ch) * 2 + dir) * 4; BL[jj] = scl[0]; AM[jj] = scl[1]; }
#pragma unroll
            for (int jj = 0; jj < 17; ++jj) {
                const int j = jb + jj; const int ch = dir ? 33 - j : (j < 2 ? 32 + j : j - 2);
                const size_t td = (size_t)(tb + ch) * 2 + dir;
                float* sc = p.SC + td * 4; const float bL = BL[jj], amax = AM[jj];
                float mn, alpha, beta;
                if (kind == 0) { mn = fmaxf(bL + m, bL + amax); alpha = expf(bL + m - mn); beta = expf(bL + amax - mn); } else { mn = 0.f; alpha = expf(bL); beta = expf(bL + amax); }
                u32x4 o; o.x = pk2(C[0], C[1]); o.y = pk2(C[2], C[3]); o.z = pk2(C[4], C[5]); o.w = pk2(C[6], C[7]);
                *(u32x4*)(p.ST + td * 16384 + v * 128 + k0) = o;
                if (e == 0) sc[2] = m;
#pragma unroll
                for (int q = 0; q < 4; ++q) { C[2 * q] = alpha * C[2 * q] + beta * __uint_as_float(U[jj][q] << 16); C[2 * q + 1] = alpha * C[2 * q + 1] + beta * __uint_as_float(U[jj][q] & 0xffff0000u); }
                m = mn;
            }
        }
        if (v == 0) {
            float m2 = 0.f;
#pragma unroll 1
            for (int jb = 0; jb < NCH; jb += 17) {
                float BL[17], AM[17]; f32x4 N0[17], N1[17];
#pragma unroll
                for (int jj = 0; jj < 17; ++jj) { const int j = jb + jj; const int ch = dir ? 33 - j : (j < 2 ? 32 + j : j - 2); const size_t td = (size_t)(tb + ch) * 2 + dir;
                    const float* scl = p.SC + td * 4; BL[jj] = scl[0]; AM[jj] = scl[1]; const float* nv = p.NV + td * 128 + k0; N0[jj] = *(const f32x4*)nv; N1[jj] = *(const f32x4*)(nv + 4); }
#pragma unroll
                for (int jj = 0; jj < 17; ++jj) { const int j = jb + jj; const int ch = dir ? 33 - j : (j < 2 ? 32 + j : j - 2); const size_t td = (size_t)(tb + ch) * 2 + dir;
                    const float bL = BL[jj], amax = AM[jj]; float mn, alpha, beta;
                    if (kind == 0) { mn = fmaxf(bL + m2, bL + amax); alpha = expf(bL + m2 - mn); beta = expf(bL + amax - mn); } else { mn = 0.f; alpha = expf(bL); beta = expf(bL + amax); }
                    float* nv = p.NV + td * 128 + k0; const f32x4 n0 = N0[jj], n1 = N1[jj];
                    *(f32x4*)nv = (f32x4){n[0], n[1], n[2], n[3]}; *(f32x4*)(nv + 4) = (f32x4){n[4], n[5], n[6], n[7]};
#pragma unroll
                    for (int q = 0; q < 4; ++q) { n[q] = alpha * n[q] + beta * n0[q]; n[4 + q] = alpha * n[4 + q] + beta * n1[q]; }
                    m2 = mn; }
            }
        }
    }
}

__device__ __forceinline__ void phase_mixC(const MixP& p, LAS unsigned char* lds, int bid, int nb, int wid) {
    LAS unsigned char* Kimg = lds; LAS unsigned char* Vimg = lds + 34816; LAS unsigned char* CF = lds + 73728; LAS unsigned char* CB = lds + 112896;
    LAS float* Himg = (LAS float*)CF;
    LAS float* arr = (LAS float*)(lds + 152064);
    LAS float *aF = arr, *aB = arr + 128, *bF = arr + 256, *bB = arr + 384, *MF = arr + 512, *MB = arr + 640, *tot = arr + 768;
    int tid = ltid(wid); int sr = tid >> 2;
    u32x4 rk[4], rv[4]; float nf = 0.f, nbv = 0.f, ig = 0.f, lfr = 0.f, minF = 0.f, minB = 0.f;
#define MIXC_LOAD(tile_) do { const int ch_ = (tile_) & 31, h_ = ((tile_) >> 5) & 3, b_ = ((tile_) >> 7) & 3, kind_ = (tile_) >> 9; const int tA_ = ((kind_ * 4 + b_) * 4 + h_) * NCH + ch_; \
        const bf16_t* pr_ = p.Pb + ((size_t)b_ * T + ch_ * 128 + sr) * PBC + h_ * 128; \
        _Pragma("unroll") for (int j = 0; j < 4; ++j) { const int c = (j * 4 + (tid & 3)) * 8; rk[j] = *(const u32x4*)(pr_ + (kind_ ? PB_RK : PB_MK) + c); rv[j] = *(const u32x4*)(pr_ + (kind_ ? PB_RV : PB_MV) + c); } \
        if (tid < 128) { nf = p.NV[((size_t)tA_ * 2 + 0) * 128 + tid]; nbv = p.NV[((size_t)tA_ * 2 + 1) * 128 + tid]; } \
        gate_load(p, kind_, b_, h_, ch_, tid, ig, lfr); minF = p.SC[((size_t)tA_ * 2 + 0) * 4 + 2]; minB = p.SC[((size_t)tA_ * 2 + 1) * 4 + 2]; } while (0)
    u32x4 rc[8];
#define MIXC_LOADC(tile_) do { const int ch_ = (tile_) & 31, h_ = ((tile_) >> 5) & 3, b_ = ((tile_) >> 7) & 3, kind_ = (tile_) >> 9; const size_t tA_ = (size_t)(((kind_ * 4 + b_) * 4 + h_) * NCH + ch_); \
        const int t_ = ltid(wid); const bf16_t* cs_ = p.ST + tA_ * 2 * 16384 + (size_t)(t_ >> 2) * 128; \
        _Pragma("unroll") for (int j = 0; j < 4; ++j) { const int c = (j * 4 + (t_ & 3)) * 8; rc[j] = *(const u32x4*)(cs_ + c); rc[4 + j] = *(const u32x4*)(cs_ + 16384 + c); } } while (0)
    if (bid < 1024) { MIXC_LOAD(bid); MIXC_LOADC(bid); }
    for (int tile = bid; tile < 2 * 16 * 32; tile += nb) {
        tid = ltid(wid); sr = tid >> 2;
        const int wave = __builtin_amdgcn_readfirstlane(tid >> 6), lane = tid & 63, g = lane >> 4, i16 = lane & 15, q = i16 >> 2, pp = i16 & 3;
        const int ch = tile & 31, h = (tile >> 5) & 3, b = (tile >> 7) & 3, kind = tile >> 9;
        const size_t row0 = (size_t)b * T + ch * 128;
        const bf16_t* prow = p.Pb + row0 * PBC + h * 128;
        bf16x8 aq[4];
        { const bf16_t* qr = prow + (kind ? PB_RQ : PB_MQ) + (size_t)(16 * wave + i16) * PBC + 8 * g;
#pragma unroll
          for (int ks = 0; ks < 4; ++ks) aq[ks] = *(const bf16x8*)(qr + 32 * ks); }
#pragma unroll
        for (int j = 0; j < 4; ++j) { const int cby = (j * 4 + (tid & 3)) * 16; *(LAS u32x4*)(Kimg + sr * RS_QK + cby) = rk[j]; *(LAS u32x4*)(Vimg + sr * RS_V + cby) = rv[j]; }
#pragma unroll
        for (int j = 0; j < 4; ++j) { const int cby = (j * 4 + (tid & 3)) * 16; *(LAS u32x4*)(CF + sr * RS_QK + cby) = rc[j]; *(LAS u32x4*)(CB + sr * RS_QK + cby) = rc[4 + j]; }
        if (tid < 128) { *(LAS u32x4*)(Vimg + tid * RS_V + 256) = (u32x4){0x3F80u, 0u, 0u, 0u}; *(LAS u32x4*)(Vimg + tid * RS_V + 272) = (u32x4){0u, 0u, 0u, 0u};
            ((LAS unsigned short*)(CF + 128 * RS_QK))[tid] = (unsigned short)f2bf(nf); ((LAS unsigned short*)(CB + 128 * RS_QK))[tid] = (unsigned short)f2bf(nbv); }
        for (int z = tid; z < 15 * 68; z += NTHR) { ((LAS unsigned*)(CF + 129 * RS_QK))[z] = 0u; ((LAS unsigned*)(CB + 129 * RS_QK))[z] = 0u; }
        const float cminF = minF, cminB = minB;
        { float bb, aa, cm; gate_scan(ig, lfr, tid, tot, bb, aa, cm);
          if (tid < 256) { const int pq = tid & 127; (tid < 128 ? aF : aB)[pq] = aa; (tid < 128 ? bF : bB)[pq] = bb; (tid < 128 ? MF : MB)[pq] = kind == 0 ? fmaxf(cm, tid < 128 ? cminF : cminB) : -bb; } }
        __syncthreads();
        if (tile + nb < 1024) MIXC_LOAD(tile + nb);
        f32x4 accF[9], accB[9];
#pragma unroll
        for (int ni = 0; ni < 9; ++ni) { accF[ni] = (f32x4){0.f, 0.f, 0.f, 0.f}; accB[ni] = (f32x4){0.f, 0.f, 0.f, 0.f}; }
#pragma unroll
        for (int ks = 0; ks < 4; ++ks) {
#pragma unroll
            for (int ni = 0; ni < 9; ++ni) { const bf16x8 bc = *(const LAS bf16x8*)(CF + (16 * ni + i16) * RS_QK + (32 * ks + 8 * g) * 2); accF[ni] = __builtin_amdgcn_mfma_f32_16x16x32_bf16(aq[ks], bc, accF[ni], 0, 0, 0); }
            asm volatile("" ::: "memory");
#pragma unroll
            for (int ni = 0; ni < 9; ++ni) { const bf16x8 bc = *(const LAS bf16x8*)(CB + (16 * ni + i16) * RS_QK + (32 * ks + 8 * g) * 2); accB[ni] = __builtin_amdgcn_mfma_f32_16x16x32_bf16(aq[ks], bc, accB[ni], 0, 0, 0); }
            asm volatile("" ::: "memory");
        }
        u32x4 ogv[4]; float nwv = 0.f;
        {
            const int tl = 16 * wave + i16;
            const float MtF = MF[tl], MtB = MB[tl];
#pragma unroll
            for (int r = 0; r < 4; ++r) { const int t = 16 * wave + 4 * g + r; const float iwF = __expf(cminF - MF[t]), iwB = __expf(cminB - MB[t]);
#pragma unroll
                for (int ni = 0; ni < 9; ++ni) { accF[ni][r] *= iwF; accB[ni][r] *= iwB; } }
#pragma unroll
            for (int ks = 0; ks < 4; ++ks) {
                u32x4 pF, pB;
#pragma unroll
                for (int hf = 0; hf < 2; ++hf) { const int nj = 2 * ks + hf;
                    f32x4 st = (f32x4){0.f, 0.f, 0.f, 0.f};
#pragma unroll
                    for (int k2 = 0; k2 < 4; ++k2) { const bf16x8 ak = *(const LAS bf16x8*)(Kimg + (16 * nj + i16) * RS_QK + (32 * k2 + 8 * g) * 2); st = __builtin_amdgcn_mfma_f32_16x16x32_bf16(ak, aq[k2], st, 0, 0, 0); }
                    const int s0 = 16 * nj + 4 * g; const f32x4 avF = *(const LAS f32x4*)(aF + s0), avB = *(const LAS f32x4*)(aB + s0); float pf[4], pb[4];
#pragma unroll
                    for (int r = 0; r < 4; ++r) { const int sx = s0 + r; pf[r] = sx <= tl ? st[r] * __expf(avF[r] - MtF) : 0.f; pb[r] = sx >= tl ? st[r] * __expf(avB[r] - MtB) : 0.f; }
                    pF[2 * hf] = cvt_pk_bf16(pf[0], pf[1]); pF[2 * hf + 1] = cvt_pk_bf16(pf[2], pf[3]); pB[2 * hf] = cvt_pk_bf16(pb[0], pb[1]); pB[2 * hf + 1] = cvt_pk_bf16(pb[2], pb[3]); }
                asm volatile("s_nop 1" : "+v"(pF), "+v"(pB));
                const bf16x8 apF = __builtin_bit_cast(bf16x8, pF), apB = __builtin_bit_cast(bf16x8, pB);
#pragma unroll
                for (int ni = 0; ni < 9; ++ni) { const LAS unsigned char* pl = Vimg + (32 * ks + 4 * g + q) * RS_V + (16 * ni + 4 * pp) * 2;
                    const s16x4 lo = __builtin_amdgcn_ds_read_tr16_b64_v4i16((LAS s16x4*)(pl)), hi = __builtin_amdgcn_ds_read_tr16_b64_v4i16((LAS s16x4*)(pl + 16 * RS_V));
                    const bf16x8 bv = __builtin_bit_cast(bf16x8, __builtin_shufflevector(lo, hi, 0, 1, 2, 3, 4, 5, 6, 7));
                    accF[ni] = __builtin_amdgcn_mfma_f32_16x16x32_bf16(apF, bv, accF[ni], 0, 0, 0); accB[ni] = __builtin_amdgcn_mfma_f32_16x16x32_bf16(apB, bv, accB[ni], 0, 0, 0); }
                asm volatile("" ::: "memory");
            }
            { const int tid2 = ltid(wid); const u32x4* og = (const u32x4*)(p.Pb + (row0 + (tid2 >> 2)) * PBC + (kind ? PB_RO : PB_MO) + h * 128 + (tid2 & 3) * 32);
#pragma unroll
              for (int j = 0; j < 4; ++j) ogv[j] = og[j];
              if (tid2 < 128) nwv = p.normw[kind * 512 + h * 128 + tid2]; }
            if (kind == 0) {
#pragma unroll
                for (int r = 0; r < 4; ++r) { const int t = 16 * wave + 4 * g + r;
                    const float denF = __shfl(accF[8][r], lane & 48), denB = __shfl(accB[8][r], lane & 48);
                    const float invF = __builtin_amdgcn_rcpf(fmaxf(fabsf(denF), __expf(-(bF[t] + MF[t])))), invB = __builtin_amdgcn_rcpf(fmaxf(fabsf(denB), __expf(-(bB[t] + MB[t]))));
#pragma unroll
                    for (int ni = 0; ni < 8; ++ni) { accF[ni][r] *= invF; accB[ni][r] *= invB; } }
            }
            __syncthreads();
        }
        {
            const int tid2 = ltid(wid); const int t = tid2 >> 2, c0 = (tid2 & 3) * 32; const size_t row = row0 + t;
            LAS float* nwl = Himg + 128 * 132;
            if (tile + nb < 1024) MIXC_LOADC(tile + nb);
            if (tid2 < 128) nwl[tid2] = nwv;
#pragma unroll
            for (int r = 0; r < 4; ++r)
#pragma unroll
                for (int ni = 0; ni < 8; ++ni) Himg[(16 * wave + 4 * g + r) * 132 + 16 * ni + i16] = accF[ni][r] + accB[ni][r];
            __syncthreads();
            const LAS f32x4* hr = (const LAS f32x4*)(Himg + t * 132 + c0);
            f32x4 hv[8]; float ss = 0.f;
#pragma unroll
            for (int j = 0; j < 8; ++j) { hv[j] = hr[j]; ss += (hv[j][0] * hv[j][0] + hv[j][1] * hv[j][1]) + (hv[j][2] * hv[j][2] + hv[j][3] * hv[j][3]); }
            ss += __shfl_xor(ss, 1); ss += __shfl_xor(ss, 2);
            const float rn = rsqrtf(ss * (1.f / 128.f) + EPS);
            const LAS f32x4* nw = (const LAS f32x4*)(nwl + c0);
            u32x4* yo = (u32x4*)(p.YM + row * D + kind * 512 + h * 128 + c0);
#pragma unroll
            for (int j = 0; j < 4; ++j) { const u32x4 ov = ogv[j]; u32x4 o;
#pragma unroll
                for (int e = 0; e < 4; ++e) { const float o0 = __uint_as_float(ov[e] << 16), o1 = __uint_as_float(ov[e] & 0xffff0000u);
                    const float g0 = kind ? fast_silu(o0) : __builtin_amdgcn_rcpf(1.f + __expf(-o0)), g1 = kind ? fast_silu(o1) : __builtin_amdgcn_rcpf(1.f + __expf(-o1));
                    const int cc = 8 * j + 2 * e; const f32x4 hq = hv[cc >> 2]; const f32x4 wq = nw[cc >> 2];
                    o[e] = cvt_pk_bf16(g0 * hq[cc & 3] * rn * wq[cc & 3], g1 * hq[(cc & 3) + 1] * rn * wq[(cc & 3) + 1]); }
                yo[j] = o; }
        }
        __syncthreads();
    }
#undef MIXC_LOAD
#undef MIXC_LOADC
}
struct TailP {
    const float *x, *mod, *norm2_w, *w_router, *final_w, *wsc2, *biasr; const bf16_t *YM, *WoutT, *Ys, *WrT;
    bf16_t* xl; float *aff, *gate, *out, *xrec; fp8_t* H2; int *idx, *slotmap; unsigned* bar;
};
struct SchedOutProj {
    const char* A; const char* W; int G, c;
    __device__ __forceinline__ bool next(int i, pg8::Unit& u) const {
        const int L = i * G + c; if (L >= 256) return false;
        const int x = L & 7, uu = L >> 3; u.pm = 8 * x + (uu & 7); u.pn = uu >> 3; u.aux = 0; u.lrows = -1; u.arows = nullptr;
        u.a = A + (size_t)u.pm * 256 * (D * 2); u.b = W + (size_t)u.pn * 256 * (D * 2); return true;
    }
};
struct EpiOutProj {
    static constexpr bool PERM = false, AFTER_DRAIN = false;
    const float* x; const float* mod; bf16_t* xl;
    __device__ __forceinline__ void operator()(const f32x4 (&acc)[2][2][4][2], const pg8::Unit& u, int wr, int wc, int fr, int fq) const {
        const int row0 = u.pm * 256 + wr * 64 + fr, col0 = u.pn * 256 + wc * 32 + 4 * fq;
#pragma unroll
        for (int ai = 0; ai < 2; ++ai)
#pragma unroll
            for (int m = 0; m < 4; ++m) { const int r = row0 + ai * 128 + m * 16; const float* g1 = mod + (r >> 12) * 6144 + 2048;
#pragma unroll
                for (int bj = 0; bj < 2; ++bj)
#pragma unroll
                    for (int n = 0; n < 2; ++n) { const int c = col0 + bj * 128 + n * 16; const f32x4 xv = *(const f32x4*)(x + (size_t)r * D + c), gv = *(const f32x4*)(g1 + c);
                        const f32x4 o = xv + gv * acc[ai][bj][m][n]; u32x2 w; w.x = pk2(o[0], o[1]); w.y = pk2(o[2], o[3]); *(u32x2*)(xl + (size_t)r * D + c) = w; } }
    }
};
__device__ __forceinline__ void phase_norm2(const TailP& p, LAS unsigned char* lds, int bid, int nb, int wid) {
    LAS float* wg = (LAS float*)lds;
    const int tid = ltid(wid), wave = __builtin_amdgcn_readfirstlane(tid >> 6), lane = tid & 63;
    for (int i = tid; i < 1024 * 16; i += NTHR) { const int k = i >> 4, j = i & 15; wg[k * 20 + (k >> 4) * 4 + j] = p.w_router[i]; }
    __syncthreads();
    const int gw = bid * 8 + wave, NGW = nb * 8;
    u32x4 nx[2];
    if (gw < ML) {
#pragma unroll
        for (int i = 0; i < 2; ++i) nx[i] = *(const u32x4*)(p.xl + (size_t)gw * D + 16 * lane + 8 * i); }
    for (int row = gw; row < ML; row += NGW) {
        f32x4 v[4];
#pragma unroll
        for (int i = 0; i < 2; ++i) { v[2 * i] = bf4_f32(nx[i].x, nx[i].y); v[2 * i + 1] = bf4_f32(nx[i].z, nx[i].w); }
        { const int r2 = row + NGW; if (r2 < ML) {
#pragma unroll
            for (int i = 0; i < 2; ++i) nx[i] = *(const u32x4*)(p.xl + (size_t)r2 * D + 16 * lane + 8 * i); } }
        const float* md = p.mod + (row >> 12) * 6144 + 16 * lane; const float* nw = p.norm2_w + 16 * lane;
        float ss = 0.f;
#pragma unroll
        for (int i = 0; i < 4; ++i) ss += (v[i][0] * v[i][0] + v[i][1] * v[i][1]) + (v[i][2] * v[i][2] + v[i][3] * v[i][3]);
#pragma unroll
        for (int o = 1; o < 64; o <<= 1) ss += __shfl_xor(ss, o);
        const float rstd = rsqrtf(ss * (1.f / D) + EPS);
        float g[16];
#pragma unroll
        for (int j = 0; j < 16; ++j) g[j] = 0.f;
        u32x4 pk;
#pragma unroll
        for (int i = 0; i < 4; ++i) {
            const f32x4 w4 = *(const f32x4*)(nw + 4 * i), s4 = *(const f32x4*)(md + 4096 + 4 * i), h4 = *(const f32x4*)(md + 3072 + 4 * i);
            const f32x4 hh4 = v[i] * rstd * w4 * (s4 + 1.f) + h4;
            pk[i] = pk4_fp8(hh4[0], hh4[1], hh4[2], hh4[3]);
#pragma unroll
            for (int c = 0; c < 4; ++c) { const float hh = hh4[c]; const LAS f32x4* wr = (const LAS f32x4*)(wg + (16 * lane + 4 * i + c) * 20 + lane * 4); ROWDOT16(g, hh, wr); if (c & 1) asm volatile("" ::: "memory"); }
        }
        *(u32x4*)(p.H2 + (size_t)row * D + 16 * lane) = pk;
        const float lg = reduce16x64(g, lane);
        float mx = lg; mx = fmaxf(mx, __shfl_xor(mx, 2)); mx = fmaxf(mx, __shfl_xor(mx, 4)); mx = fmaxf(mx, __shfl_xor(mx, 8)); mx = fmaxf(mx, __shfl_xor(mx, 16));
        const float ex = expf(lg - mx); float sm = ex; sm += __shfl_xor(sm, 2); sm += __shfl_xor(sm, 4); sm += __shfl_xor(sm, 8); sm += __shfl_xor(sm, 16);
        if ((lane & 33) == 0) p.aff[(size_t)row * 16 + (lane >> 1)] = ex / sm;
    }
}
__device__ __forceinline__ void phase_topk(const TailP& p, LAS unsigned char* lds, int bid, int nb, int wid) {
    LAS unsigned* hist = (LAS unsigned*)lds;
    LAS unsigned* ctl = hist + 256;
    LAS unsigned* wsum = ctl + 8;
    const int tid = ltid(wid), wave = tid >> 6, lane = tid & 63;
    for (int item = bid; item < NB * NE; item += nb) {
        const int b = item >> 4, e = item & 15;
        unsigned key[8];
#pragma unroll
        for (int j = 0; j < 8; ++j) key[j] = __float_as_uint(p.aff[((size_t)b * T + tid * 8 + j) * 16 + e]);
        if (tid == 0) { ctl[0] = 0u; ctl[1] = (unsigned)CAP; }
        unsigned prefix = 0u, krem = CAP;
#pragma unroll 1
        for (int pass = 0; pass < 4; ++pass) {
            const int shift = 24 - 8 * pass;
            if (tid < 256) hist[tid] = 0u;
            __syncthreads();
#pragma unroll
            for (int j = 0; j < 8; ++j) { const bool match = pass == 0 ? true : ((key[j] >> (shift + 8)) == prefix); if (match) atomicAdd((unsigned*)(hist + ((key[j] >> shift) & 255u)), 1u); }
            __syncthreads();
            {
                unsigned mine = 0u, incl = 0u;
                if (tid < 256) { mine = hist[tid]; incl = mine;
#pragma unroll
                    for (int o = 1; o < 64; o <<= 1) { const unsigned t2 = __shfl_down(incl, o); if (lane + o < 64) incl += t2; }
                    if (lane == 0) wsum[wave] = incl; }
                __syncthreads();
                if (tid < 256) { unsigned above = incl - mine; for (int w2 = wave + 1; w2 < 4; ++w2) above += wsum[w2];
                    if (above < krem && krem <= above + mine) { ctl[0] = (prefix << 8) | (unsigned)tid; ctl[1] = krem - above; } }
            }
            __syncthreads();
            prefix = ctl[0]; krem = ctl[1];
            __syncthreads();
        }
        unsigned ng = 0u, ne = 0u;
#pragma unroll
        for (int j = 0; j < 8; ++j) { ng += key[j] > prefix ? 1u : 0u; ne += key[j] == prefix ? 1u : 0u; }
        unsigned sg = ng, se = ne;
#pragma unroll
        for (int o = 1; o < 64; o <<= 1) { const unsigned tg = __shfl_up(sg, o), te = __shfl_up(se, o); if (lane >= o) { sg += tg; se += te; } }
        if (lane == 63) { wsum[wave * 2] = sg; wsum[wave * 2 + 1] = se; }
        __syncthreads();
        unsigned bg = sg - ng, be = se - ne;
        for (int w = 0; w < wave; ++w) { bg += wsum[w * 2]; be += wsum[w * 2 + 1]; }
#pragma unroll
        for (int j = 0; j < 8; ++j) {
            const int t = tid * 8 + j; const bool gr = key[j] > prefix, eq = key[j] == prefix; const bool sel = gr || (eq && be < krem);
            const int cslot = (int)(bg + (be < krem ? be : krem)); const int R = e * 2048 + b * CAP + cslot;
            if (sel) { p.idx[R] = b * T + t; p.gate[R] = __uint_as_float(key[j]); }
            p.slotmap[((size_t)b * T + t) * NE + e] = sel ? R : -1;
            bg += gr ? 1u : 0u; be += eq ? 1u : 0u;
        }
        __syncthreads();
    }
}
struct XcdBarrier;
__device__ __forceinline__ void xcd_wait(const XcdBarrier& b, const int wid);
__device__ __forceinline__ void phase_final(const TailP& p, int bid, int nb, int wid, const XcdBarrier* wb) {
    const int tid = ltid(wid), wave = __builtin_amdgcn_readfirstlane(tid >> 6), lane = tid & 63;
    const int gw = bid * 8 + wave, NGW = nb * 8;
    f32x4 fw[4];
#pragma unroll
    for (int i = 0; i < 4; ++i) fw[i] = *(const f32x4*)(p.final_w + 4 * (lane + 64 * i));
    int smA = -1, smB = -1; unsigned rsA = 0u, rsB = 0u; int s0A = -1, s1A = -1, s2A = -1, s0B = -1, s1B = -1, s2B = -1;
    u32x2 xlA[4], xlB[4], ysA[3][4], ysB[3][4]; f32x4 gvA[4], gvB[4];
#define FIN_SLOTMAP(SM, row_) SM = lane < 16 ? p.slotmap[(size_t)(row_) * NE + lane] : -1
#define FIN_PICK(S, t_, SM) do { if (t_) { S = __builtin_amdgcn_readlane(SM, __builtin_ctz(t_)); t_ &= t_ - 1u; } else S = -1; } while (0)
#define FIN_ISSUE(X, row_) do { unsigned t_ = (unsigned)__ballot(sm##X >= 0); FIN_PICK(s0##X, t_, sm##X); FIN_PICK(s1##X, t_, sm##X); FIN_PICK(s2##X, t_, sm##X); rs##X = t_; \
        _Pragma("unroll") for (int i = 0; i < 4; ++i) { \
            if (s0##X >= 0) ys##X[0][i] = ntl((const u32x2*)(p.Ys + (size_t)s0##X * D) + lane + 64 * i); \
            if (s1##X >= 0) ys##X[1][i] = ntl((const u32x2*)(p.Ys + (size_t)s1##X * D) + lane + 64 * i); \
            if (s2##X >= 0) ys##X[2][i] = ntl((const u32x2*)(p.Ys + (size_t)s2##X * D) + lane + 64 * i); \
            xl##X[i] = ntl((const u32x2*)(p.xl + (size_t)(row_) * D) + lane + 64 * i); \
            gv##X[i] = *(const f32x4*)(p.mod + ((row_) >> 12) * 6144 + 5120 + 4 * (lane + 64 * i)); } } while (0)
#define FIN_ADD(w_) do { a[i][0] += __uint_as_float((w_).x << 16); a[i][1] += __uint_as_float((w_).x & 0xffff0000u); a[i][2] += __uint_as_float((w_).y << 16); a[i][3] += __uint_as_float((w_).y & 0xffff0000u); } while (0)
#define FIN_COMPUTE(X, row_) do { f32x4 a[4]; \
        _Pragma("unroll") for (int i = 0; i < 4; ++i) a[i] = (f32x4){0.f, 0.f, 0.f, 0.f}; \
        if (s0##X >= 0) { _Pragma("unroll") for (int i = 0; i < 4; ++i) FIN_ADD(ys##X[0][i]); } \
        if (s1##X >= 0) { _Pragma("unroll") for (int i = 0; i < 4; ++i) FIN_ADD(ys##X[1][i]); } \
        if (s2##X >= 0) { _Pragma("unroll") for (int i = 0; i < 4; ++i) FIN_ADD(ys##X[2][i]); } \
        for (unsigned rr = rs##X; rr; rr &= rr - 1u) { const int sl = __builtin_amdgcn_readlane(sm##X, __builtin_ctz(rr)); const u32x2* yr = (const u32x2*)(p.Ys + (size_t)sl * D); \
            _Pragma("unroll") for (int i = 0; i < 4; ++i) { const u32x2 w = ntl(yr + lane + 64 * i); FIN_ADD(w); } } \
        float ss = 0.f; \
        _Pragma("unroll") for (int i = 0; i < 4; ++i) { a[i] = bf4_f32(xl##X[i].x, xl##X[i].y) + gv##X[i] * a[i]; ss += (a[i][0] * a[i][0] + a[i][1] * a[i][1]) + (a[i][2] * a[i][2] + a[i][3] * a[i][3]); } \
        _Pragma("unroll") for (int o = 1; o < 64; o <<= 1) ss += __shfl_xor(ss, o); \
        const float rstd = rsqrtf(ss * (1.f / D) + EPS); \
        _Pragma("unroll") for (int i = 0; i < 4; ++i) nts((f32x4)(a[i] * rstd * fw[i]), (f32x4*)(p.out + (size_t)(row_) * D + 4 * (lane + 64 * i))); } while (0)
    int row = gw;
    if (row < ML) FIN_SLOTMAP(smA, row);
    if (row + NGW < ML) FIN_SLOTMAP(smB, row + NGW);
    if (wb) xcd_wait(*wb, wid);
    if (row < ML) FIN_ISSUE(A, row);
    for (;;) {
        if (row >= ML) break;
        if (row + NGW < ML) FIN_ISSUE(B, row + NGW);
        FIN_COMPUTE(A, row);
        if (row + 2 * NGW < ML) FIN_SLOTMAP(smA, row + 2 * NGW);
        row += NGW; if (row >= ML) break;
        if (row + NGW < ML) FIN_ISSUE(A, row + NGW);
        FIN_COMPUTE(B, row);
        if (row + 2 * NGW < ML) FIN_SLOTMAP(smB, row + 2 * NGW);
        row += NGW;
    }
#undef FIN_SLOTMAP
#undef FIN_PICK
#undef FIN_ISSUE
#undef FIN_ADD
#undef FIN_COMPUTE
}

#define XB_TMO      128
#define XB_XCNT(j)  (256  + 64 * (j))
#define XB_XSUB(j)  (1280 + 64 * (j))
#define XB_XGEN(j)  (2304 + 64 * (j))
#define XB_TOP      3328
#define XB_TOPGEN   3392
#define XCD_BAR_WORDS 3456
#define XB_SPIN_CAP (1u << 18)
__device__ __forceinline__ unsigned xb_ld(unsigned* p)              { return __hip_atomic_load(p, __ATOMIC_RELAXED, __HIP_MEMORY_SCOPE_AGENT); }
__device__ __forceinline__ unsigned xb_add(unsigned* p, unsigned v) { return __hip_atomic_fetch_add(p, v, __ATOMIC_RELAXED, __HIP_MEMORY_SCOPE_AGENT); }
__device__ __forceinline__ unsigned xb_xcc_id() { return (unsigned)__builtin_amdgcn_s_getreg((3 << 11) | 20) & 0xFu; }
#define XB_SPIN(cond, bar) do { unsigned _sp = 0; while (cond) { __builtin_amdgcn_s_sleep(1); \
    if ((++_sp & 255u) == 0u) { if (xb_ld(&(bar)[XB_TMO])) break; if (_sp > XB_SPIN_CAP) { atomicAdd(&(bar)[XB_TMO], 1u); break; } } } } while (0)
struct XcdBarrier { unsigned* bar; unsigned x; volatile LAS unsigned* st; };
__device__ __forceinline__ XcdBarrier xcd_barrier_post(unsigned* bar, volatile LAS unsigned* st) {
    XcdBarrier b; b.bar = bar; b.x = xb_xcc_id(); b.st = st;
    if (threadIdx.x == 0) (void)xb_add(&bar[XB_XCNT(b.x)], 1u);
    return b;
}
__device__ __forceinline__ void xcd_barrier_complete(unsigned* bar, unsigned x, unsigned& nloc, unsigned& nx) {
    const unsigned G = gridDim.x * gridDim.y * gridDim.z;
    unsigned sum, cnt, mine, sp = 0u;
    for (;;) {
        sum = 0u; cnt = 0u; mine = 0u;
#pragma unroll
        for (unsigned j = 0; j < 16; ++j) { const unsigned c = xb_ld(&bar[XB_XCNT(j)]); sum += c; cnt += (c > 0u) ? 1u : 0u; mine = (j == x) ? c : mine; }
        if (sum == G) break;
        __builtin_amdgcn_s_sleep(1);
        if ((++sp & 255u) == 0u) { if (xb_ld(&bar[XB_TMO])) break; if (sp > XB_SPIN_CAP) { atomicAdd(&bar[XB_TMO], 1u); break; } }
    }
    nloc = mine > 0u ? mine : 1u; nx = cnt > 0u ? cnt : 1u;
}
__device__ __forceinline__ void xcd_barrier(const XcdBarrier& b, const int wid) {
    const bool t0 = (wid == 0) && (__builtin_amdgcn_mbcnt_hi(~0u, __builtin_amdgcn_mbcnt_lo(~0u, 0u)) == 0u);
    asm volatile("s_waitcnt vmcnt(0)" ::: "memory");
    __syncthreads();
    if (t0) {
        unsigned* bar = b.bar;
        __builtin_amdgcn_s_waitcnt(0);
        unsigned nloc = b.st[0], nx = b.st[1];
        if (nloc == 0u) { xcd_barrier_complete(bar, b.x, nloc, nx); b.st[0] = nloc; b.st[1] = nx; }
        const unsigned old = xb_add(&bar[XB_XSUB(b.x)], 1u);
        const unsigned gen = old / nloc;
        if (old + 1u == (gen + 1u) * nloc) {
            __builtin_amdgcn_fence(__ATOMIC_RELEASE, "agent");
            asm volatile("s_waitcnt vmcnt(0)" ::: "memory");
            const unsigned og = xb_add(&bar[XB_TOP], 1u);
            const unsigned tgt = (og / nx + 1u) * nx;
            if (og + 1u != tgt) XB_SPIN(xb_ld(&bar[XB_TOP]) < tgt, bar);
            __builtin_amdgcn_fence(__ATOMIC_ACQUIRE, "agent");
            asm volatile("s_waitcnt vmcnt(0)" ::: "memory");
            xb_add(&bar[XB_XGEN(b.x)], 1u);
            asm volatile("s_waitcnt vmcnt(0)" ::: "memory");
        } else {
            XB_SPIN(xb_ld(&bar[XB_XGEN(b.x)]) == gen, bar);
            asm volatile("buffer_inv sc0" ::: "memory");
            asm volatile("s_waitcnt vmcnt(0)" ::: "memory");
        }
    }
    __syncthreads();
}
__device__ __forceinline__ void xcd_arrive(const XcdBarrier& b, const int wid) {
    const bool t0 = (wid == 0) && (__builtin_amdgcn_mbcnt_hi(~0u, __builtin_amdgcn_mbcnt_lo(~0u, 0u)) == 0u);
    asm volatile("s_waitcnt vmcnt(0)" ::: "memory");
    __syncthreads();
    if (t0) {
        unsigned* bar = b.bar;
        __builtin_amdgcn_s_waitcnt(0);
        unsigned nloc = b.st[0], nx = b.st[1];
        if (nloc == 0u) { xcd_barrier_complete(bar, b.x, nloc, nx); b.st[0] = nloc; b.st[1] = nx; }
        const unsigned old = xb_add(&bar[XB_XSUB(b.x)], 1u);
        const unsigned gen = old / nloc;
        unsigned role = 0u, tg = 0u;
        if (old + 1u == (gen + 1u) * nloc) {
            __builtin_amdgcn_fence(__ATOMIC_RELEASE, "agent");
            asm volatile("s_waitcnt vmcnt(0)" ::: "memory");
            const unsigned og = xb_add(&bar[XB_TOP], 1u);
            tg = (og / nx + 1u) * nx; role = 1u;
            if (og + 1u == tg) role = 2u;
        }
        b.st[2] = gen; b.st[3] = role; b.st[4] = tg;
    }
}
__device__ __forceinline__ void xcd_wait(const XcdBarrier& b, const int wid) {
    const bool t0 = (wid == 0) && (__builtin_amdgcn_mbcnt_hi(~0u, __builtin_amdgcn_mbcnt_lo(~0u, 0u)) == 0u);
    if (t0) {
        unsigned* bar = b.bar;
        const unsigned gen = b.st[2], role = b.st[3], tg = b.st[4];
        if (role != 0u) {
            if (role == 1u) XB_SPIN(xb_ld(&bar[XB_TOP]) < tg, bar);
            __builtin_amdgcn_fence(__ATOMIC_ACQUIRE, "agent");
            asm volatile("s_waitcnt vmcnt(0)" ::: "memory");
            xb_add(&bar[XB_XGEN(b.x)], 1u);
            asm volatile("s_waitcnt vmcnt(0)" ::: "memory");
        } else {
            XB_SPIN(xb_ld(&bar[XB_XGEN(b.x)]) == gen, bar);
            asm volatile("buffer_inv sc0" ::: "memory");
            asm volatile("s_waitcnt vmcnt(0)" ::: "memory");
        }
    }
    __syncthreads();
}

__device__ __forceinline__ void group_barrier(unsigned* cnt, unsigned target, unsigned* tmo, const int wid) {
    const bool t0 = (wid == 0) && (__builtin_amdgcn_mbcnt_hi(~0u, __builtin_amdgcn_mbcnt_lo(~0u, 0u)) == 0u);
    asm volatile("s_waitcnt vmcnt(0)" ::: "memory");
    __syncthreads();
    if (t0) {
        __builtin_amdgcn_fence(__ATOMIC_RELEASE, "agent");
        asm volatile("s_waitcnt vmcnt(0)" ::: "memory");
        (void)xb_add(cnt, 1u);
        unsigned sp = 0u;
        while (xb_ld(cnt) < target) { __builtin_amdgcn_s_sleep(1); if ((++sp & 255u) == 0u) { if (xb_ld(tmo)) break; if (sp > XB_SPIN_CAP) { atomicAdd(tmo, 1u); break; } } }
        __builtin_amdgcn_fence(__ATOMIC_ACQUIRE, "agent");
        asm volatile("s_waitcnt vmcnt(0)" ::: "memory");
    }
    __syncthreads();
}

struct EpiOutNorm {
    static constexpr bool PERM = true, AFTER_DRAIN = true;
    const float* x; const float* mod; bf16_t* xl; fp8_t* H2; float* aff; const float* wsc2; const bf16_t* WrT; const float* biasr; float* xrec; unsigned* bar;
    __device__ __forceinline__ void operator()(const f32x4 (&)[2][2][4][2], const pg8::Unit&, int, int, int, int) const {}
    __device__ __forceinline__ void fused(f32x4 (&acc)[2][2][4][2], const pg8::Unit& u, LAS unsigned char* lds, int wv) const {
        const int t = ltid(wv), lane = t & 63, w = __builtin_amdgcn_readfirstlane(t >> 6), wr = w >> 2, wc = w & 3, fr = lane & 15, fq = lane >> 4;
        const int b = u.pm >> 4;
        const int row0 = u.pm * 256 + wr * 64 + fr, colb = u.pn * 256 + wc * 32 + 8 * fq;
        LAS float* SS = (LAS float*)lds;
        LAS float* LG = SS + 1024;
        LAS float* RS = LG + 4 * 256 * 20;
        const rsrc_t rX = __builtin_amdgcn_make_buffer_rsrc((void*)xrec, 0, 0xffffffff, 0x00020000);
        const float* g1p = mod + b * 6144 + 2048; const float* wsp = wsc2 + b * D;
#pragma unroll
        for (int ai = 0; ai < 2; ++ai)
#pragma unroll
            for (int m = 0; m < 4; ++m) {
                const int r = row0 + ai * 128 + m * 16, rl = ai * 128 + wr * 64 + m * 16; float ss = 0.f; f32x4 lg = (f32x4){0.f, 0.f, 0.f, 0.f};
#pragma unroll
                for (int bj = 0; bj < 2; ++bj) { const int c = colb + bj * 128;
                    const f32x4 x0 = *(const f32x4*)(x + (size_t)r * D + c), x1 = *(const f32x4*)(x + (size_t)r * D + c + 4), g0 = *(const f32x4*)(g1p + c), g1v = *(const f32x4*)(g1p + c + 4);
                    const f32x4 v0 = x0 + g0 * acc[ai][bj][m][0], v1 = x1 + g1v * acc[ai][bj][m][1];
                    acc[ai][bj][m][0] = v0; acc[ai][bj][m][1] = v1;
                    ss += (v0[0] * v0[0] + v0[1] * v0[1]) + (v0[2] * v0[2] + v0[3] * v0[3]) + (v1[0] * v1[0] + v1[1] * v1[1]) + (v1[2] * v1[2] + v1[3] * v1[3]);
                    const f32x4 w0 = *(const f32x4*)(wsp + c), w1 = *(const f32x4*)(wsp + c + 4); const f32x4 u0 = v0 * w0, u1 = v1 * w1;
                    u32x4 ap; ap.x = cvt_pk_bf16(u0[0], u0[1]); ap.y = cvt_pk_bf16(u0[2], u0[3]); ap.z = cvt_pk_bf16(u1[0], u1[1]); ap.w = cvt_pk_bf16(u1[2], u1[3]);
                    const bf16x8 bq = *(const bf16x8*)(WrT + (size_t)fr * D + u.pn * 256 + bj * 128 + wc * 32 + 8 * fq);
                    asm volatile("s_nop 1" : "+v"(ap));
                    lg = __builtin_amdgcn_mfma_f32_16x16x32_bf16(__builtin_bit_cast(bf16x8, ap), bq, lg, 0, 0, 0); }
                ss += __shfl_xor(ss, 16); ss += __shfl_xor(ss, 32);
                if (fq == 0) SS[(rl + fr) * 4 + wc] = ss;
#pragma unroll
                for (int rg = 0; rg < 4; ++rg) LG[(wc * 256 + rl + 4 * fq + rg) * 20 + fr] = lg[rg];
            }
        __syncthreads();
        if (t < 256) { const f32x4 s4 = *(const LAS f32x4*)(SS + t * 4); const float ssum = (s4[0] + s4[1]) + (s4[2] + s4[3]);
            f32x4 q[4];
#pragma unroll
            for (int j = 0; j < 4; ++j) { const f32x4 a0 = *(const LAS f32x4*)(LG + (0 * 256 + t) * 20 + 4 * j), a1 = *(const LAS f32x4*)(LG + (1 * 256 + t) * 20 + 4 * j),
                                                      a2 = *(const LAS f32x4*)(LG + (2 * 256 + t) * 20 + 4 * j), a3 = *(const LAS f32x4*)(LG + (3 * 256 + t) * 20 + 4 * j); q[j] = (a0 + a1) + (a2 + a3); }
            const int ro = (((u.pm * 256 + t) * 4 + u.pn) * 20) * 4;
#pragma unroll
            for (int j = 0; j < 4; ++j) __builtin_amdgcn_raw_buffer_store_b128(__builtin_bit_cast(u32x4, q[j]), rX, ro + 16 * j, 0, 16);
            __builtin_amdgcn_raw_buffer_store_b128(__builtin_bit_cast(u32x4, (f32x4){ssum, 0.f, 0.f, 0.f}), rX, ro + 64, 0, 16); }
        asm volatile("s_waitcnt vmcnt(0)" ::: "memory");
        __syncthreads();
        const bool t0 = (t == 0);
        unsigned* cnt = bar + 4096 + 64 * u.pm;
        if (t0) (void)xb_add(cnt, 1u);
        {
#pragma unroll
            for (int ai = 0; ai < 2; ++ai)
#pragma unroll
                for (int m = 0; m < 4; ++m) { const int r = row0 + ai * 128 + m * 16;
#pragma unroll
                    for (int bj = 0; bj < 2; ++bj) { const int c = colb + bj * 128; const f32x4 a0 = acc[ai][bj][m][0], a1 = acc[ai][bj][m][1]; u32x4 w; w.x = pk2(a0[0], a0[1]); w.y = pk2(a0[2], a0[3]); w.z = pk2(a1[0], a1[1]); w.w = pk2(a1[2], a1[3]); *(u32x4*)(xl + (size_t)r * D + c) = w; } }
        }
        if (t0) { unsigned sp = 0u; unsigned* tmo = bar + XB_TMO;
            while (xb_ld(cnt) < 4u) { __builtin_amdgcn_s_sleep(1); if ((++sp & 255u) == 0u) { if (xb_ld(tmo)) break; if (sp > XB_SPIN_CAP) { atomicAdd(tmo, 1u); break; } } }
            asm volatile("s_waitcnt vmcnt(0)" ::: "memory"); }
        __syncthreads();
        if (t < 256) { const int so = (u.pm * 256 + t) * 4 * 20 * 4; float tot[17];
#define XREC_LD(i_) __builtin_bit_cast(f32x4, __builtin_amdgcn_raw_buffer_load_b128(rX, so + 16 * (i_), 0, 16))
#pragma unroll
            for (int i = 0; i < 17; ++i) tot[i] = 0.f;
#pragma unroll
            for (int o = 0; o < 4; ++o) { const f32x4 a0 = XREC_LD(o * 5), a1 = XREC_LD(o * 5 + 1), a2 = XREC_LD(o * 5 + 2), a3 = XREC_LD(o * 5 + 3), a4 = XREC_LD(o * 5 + 4);
                tot[1] += a0[0]; tot[2] += a0[1]; tot[3] += a0[2]; tot[4] += a0[3]; tot[5] += a1[0]; tot[6] += a1[1]; tot[7] += a1[2]; tot[8] += a1[3];
                tot[9] += a2[0]; tot[10] += a2[1]; tot[11] += a2[2]; tot[12] += a2[3]; tot[13] += a3[0]; tot[14] += a3[1]; tot[15] += a3[2]; tot[16] += a3[3]; tot[0] += a4[0]; }
            const float rstd = rsqrtf(tot[0] * (1.f / D) + EPS); RS[t] = rstd;
            if ((t >> 6) == u.pn) { float lgt[16], mx = -3.0e38f;
#pragma unroll
                for (int e = 0; e < 16; ++e) { lgt[e] = rstd * tot[1 + e] + biasr[b * 16 + e]; mx = fmaxf(mx, lgt[e]); }
                float sm = 0.f;
#pragma unroll
                for (int e = 0; e < 16; ++e) { lgt[e] = expf(lgt[e] - mx); sm += lgt[e]; }
                const float inv = 1.f / sm; f32x4* ao = (f32x4*)(aff + (size_t)(u.pm * 256 + t) * 16);
                ao[0] = (f32x4){lgt[0] * inv, lgt[1] * inv, lgt[2] * inv, lgt[3] * inv}; ao[1] = (f32x4){lgt[4] * inv, lgt[5] * inv, lgt[6] * inv, lgt[7] * inv};
                ao[2] = (f32x4){lgt[8] * inv, lgt[9] * inv, lgt[10] * inv, lgt[11] * inv}; ao[3] = (f32x4){lgt[12] * inv, lgt[13] * inv, lgt[14] * inv, lgt[15] * inv}; } }
        __syncthreads();
        const float* shp = mod + b * 6144 + 3072;
        { const int t2 = ltid(wv), l2 = t2 & 63, fr2 = l2 & 15, fq2 = l2 >> 4; const int row0b = u.pm * 256 + wr * 64 + fr2, colbb = u.pn * 256 + wc * 32 + 8 * fq2;
#pragma unroll
        for (int ai = 0; ai < 2; ++ai)
#pragma unroll
            for (int m = 0; m < 4; ++m) { const int r = row0b + ai * 128 + m * 16; const float rstd = RS[ai * 128 + wr * 64 + m * 16 + fr2];
#pragma unroll
                for (int bj = 0; bj < 2; ++bj) { const int c = colbb + bj * 128; const f32x4 v0 = acc[ai][bj][m][0], v1 = acc[ai][bj][m][1];
                    const f32x4 w0 = *(const f32x4*)(wsp + c), w1 = *(const f32x4*)(wsp + c + 4), s0 = *(const f32x4*)(shp + c), s1 = *(const f32x4*)(shp + c + 4);
                    const f32x4 h0 = v0 * rstd * w0 + s0, h1 = v1 * rstd * w1 + s1;
                    u32x2 o; o.x = pk4_fp8(h0[0], h0[1], h0[2], h0[3]); o.y = pk4_fp8(h1[0], h1[1], h1[2], h1[3]);
                    *(u32x2*)(H2 + (size_t)r * D + c) = o; } }
        }
    }
};

struct MegaP { FastQ q; MixP m; TailP t; FastP f; unsigned* bar; };
constexpr int MISC_OFF = LDS_BYTES - 256;
constexpr int CVT_NIT = NE * (2 * 8 * 88 + 22 * 32);
constexpr int CVT_SPLIT1 = (CVT_NIT * 70 / 100) & ~7, CVT_SPLIT2 = (CVT_NIT * 94 / 100) & ~7;
__global__ void __launch_bounds__(NTHR, 2) mega_fwd(MegaP P) {
    extern __shared__ __attribute__((aligned(16))) unsigned char lds_raw[];
    LAS unsigned char* lds = (LAS unsigned char*)lds_raw;
    const int bid = blockIdx.x, nb = gridDim.x;
    const int wid = __builtin_amdgcn_readfirstlane((int)threadIdx.x >> 6);
    volatile LAS unsigned* misc = (volatile LAS unsigned*)(lds + MISC_OFF);
    if (threadIdx.x < 64) misc[threadIdx.x] = 0u;
    __syncthreads();
    const XcdBarrier bar = xcd_barrier_post(P.bar, misc + 8);
    phase_mod(P.q, lds, bid, nb, wid);
    xcd_arrive(bar, wid);
    __syncthreads();
    {   const bool early = bar.st[3] == 0u;
        const bool cblk = bid == (nb > 184 ? 184 : 0);
        const int cmode = nb == 256 ? 1 : 0;
        for (int pass = 0; pass < 2; ++pass) {
            if (pass == (early ? 0 : 1)) {
                if (cblk) { LAS float* red = (LAS float*)(lds + 122880); const int tid0 = ltid(wid);
                    const float sg = calib_scale(P.f.w_gate, red, tid0), su = calib_scale(P.f.w_up, red, tid0), sd = calib_scale(P.f.w_down, red, tid0);
                    if (tid0 == 0) { P.f.wsc[0] = sg; P.f.wsc[1] = su; P.f.wsc[2] = sd; P.f.wsc[4] = 1.f / sg; P.f.wsc[5] = 1.f / su; P.f.wsc[6] = 1.f / sd; } }
                if (bid & 1) phase_convert_small(P.q, lds, bid, nb, wid, cmode);
            }
            if (pass == 0) xcd_wait(bar, wid);
        }
        __syncthreads();
        phase_norm1_t16(P.q, lds, bid, nb, wid);
        if (!(bid & 1)) { __syncthreads(); phase_convert_small(P.q, lds, bid, nb, wid, cmode); }
    }
    xcd_barrier(bar, wid);
    {
        const float sg = P.f.wsc[0], su = P.f.wsc[1], sd = P.f.wsc[2];
        CvtSide side; side.init(P.f, __builtin_bit_cast(float, __builtin_amdgcn_readfirstlane(__builtin_bit_cast(int, sg))), __builtin_bit_cast(float, __builtin_amdgcn_readfirstlane(__builtin_bit_cast(int, su))),
                                __builtin_bit_cast(float, __builtin_amdgcn_readfirstlane(__builtin_bit_cast(int, sd))), bid * 8 + wid, nb * 8, CVT_SPLIT1);
        SchedInProj S{(const char*)P.q.XN, (const char*)P.q.WinT, nb, bid}; EpiInProj E{P.q.Pb, P.q.ropetab}; pg8::gemm_phase<false>(lds, D, S, E, wid, side);
        side.skip = 0; while (side.busy()) { (void)side.issue(wid); (void)side.finish<0>(wid); }
        if (bid >= 1056 - 4 * nb && nb == 256) phase_convert_moe(P.f, lds, CVT_SPLIT1, CVT_SPLIT2, bid - (1056 - 4 * nb), 5 * nb - 1056, wid, true, side.sg, side.su, side.sd);
    }
    xcd_barrier(bar, wid);
    phase_mixA(P.m, lds, bid, nb, wid);
    if (nb == 256) phase_convert_small(P.q, lds, bid, nb, wid, 2);
    if (nb == 256 && bid >= nb - NB) phase_tables(P.q, lds, bid - (nb - NB), wid);
    xcd_barrier(bar, wid);
    phase_mixB(P.m, bid, nb, wid);
    xcd_barrier(bar, wid);
    phase_mixC(P.m, lds, bid, nb, wid);
    xcd_barrier(bar, wid);
    if (nb == 256) { SchedOutProj S{(const char*)P.t.YM, (const char*)P.t.WoutT, nb, bid};
        EpiOutNorm E{P.t.x, P.t.mod, P.t.xl, P.t.H2, P.t.aff, P.t.wsc2, P.t.WrT, P.t.biasr, P.t.xrec, P.t.bar}; pg8::gemm_phase<false>(lds, D, S, E, wid); }
    else { SchedOutProj S{(const char*)P.t.YM, (const char*)P.t.WoutT, nb, bid}; EpiOutProj E{P.t.x, P.t.mod, P.t.xl}; pg8::gemm_phase<false>(lds, D, S, E, wid); }
    xcd_barrier(bar, wid);
    if (nb != 256) { phase_norm2(P.t, lds, bid, nb, wid); xcd_barrier(bar, wid); }
    if (bid < NB * NE || nb != 256) phase_topk(P.t, lds, bid, nb, wid);
    if (nb == 256) { if (bid >= NB * NE) phase_convert_moe(P.f, lds, CVT_SPLIT2, CVT_NIT, bid - NB * NE, nb - NB * NE, wid, true, P.f.wsc[0], P.f.wsc[1], P.f.wsc[2]); }
    else phase_convert_moe(P.f, lds, CVT_SPLIT1, CVT_NIT, bid, nb, wid);
    xcd_barrier(bar, wid);
    {
        constexpr int LROW0 = pg8::STAGE_BYTES;
        const bool lok = (nb & 7) == 0;
        if (lok) { for (int i = ltid(wid); i < 4096; i += NTHR) ((LAS int*)(lds + LROW0))[i] = P.f.erow[(bid & 7) * 4096 + i]; }
        __syncthreads();
        SchedMoe1 S{(const char*)P.f.H2, P.f.erow, (const char*)P.f.WguT, nb, bid, lok ? LROW0 : -1}; const unsigned eg = (254u - (__float_as_uint(P.f.wsc[0]) >> 23)) * 0x01010101u, eu = (254u - (__float_as_uint(P.f.wsc[1]) >> 23)) * 0x01010101u;
        EpiSwiGLU E{P.f.Hb, eg, eu}; pg8::gemm_phase<true>(lds, D / 2, S, E, wid); }
    xcd_barrier(bar, wid);
    { SchedMoe2 S{(const char*)P.f.Hb, (const char*)P.f.WdT, nb, bid}; const unsigned ed = (254u - (__float_as_uint(P.f.wsc[2]) >> 23)) * 0x01010101u; EpiDownBf16 E{P.f.Ys, P.f.gate, ed, ed}; pg8::gemm_phase<true>(lds, FF / 2, S, E, wid); }
    xcd_arrive(bar, wid);
    phase_final(P.t, bid, nb, wid, &bar);
}

extern "C" void kernel_launch(void* const* d_in, const int* in_sizes, int n_in, void* d_out, int out_size, void* d_ws, size_t ws_size, hipStream_t stream) {
    const float* x = (const float*)d_in[0]; const float* c = (const float*)d_in[1]; const float* ctx = (const float*)d_in[2]; const float* c_ctx = (const float*)d_in[3];
    const float* w_ada = (const float*)d_in[4]; const float* b_ada = (const float*)d_in[5]; const float* norm1_w = (const float*)d_in[6]; const float* norm2_w = (const float*)d_in[7];
    const float* w_in = (const float*)d_in[8]; const float* gate_bias = (const float*)d_in[9]; const float* decay_logit = (const float*)d_in[10];
    const float* mnw = (const float*)d_in[11]; const float* rnw = (const float*)d_in[12]; const float* w_out = (const float*)d_in[13]; const float* w_router = (const float*)d_in[14];
    const float* w_gate = (const float*)d_in[15]; const float* w_up = (const float*)d_in[16]; const float* w_down = (const float*)d_in[17]; const float* final_w = (const float*)d_in[18];
    float* out = (float*)d_out;
    char* ws = (char*)d_ws; size_t off = 0;
    auto carve = [&](size_t bytes) { char* p = ws + off; off += (bytes + 255) & ~(size_t)255; return p; };
    unsigned* bar = (unsigned*)carve(32768);
    float* mod = (float*)carve(5 * 6144 * 4);
    float* ropetab = (float*)carve(2048 * 2 * 4); float* normw = (float*)carve(1024 * 4); float* wsc2 = (float*)carve(4 * 1024 * 4); float* biasr = (float*)carve(256); bf16_t* WrT = (bf16_t*)carve(16 * 1024 * 2);
    float* xrec = (float*)carve((size_t)ML * 4 * 20 * 4); float* G = (float*)carve((size_t)MA * 16 * 4);
    float* aff = (float*)carve((size_t)ML * 16 * 4);
    float* gate = (float*)carve(NSLOT * 4); int* erow = (int*)carve(NSLOT * 4);
    int* slotmap = (int*)carve((size_t)ML * NE * 4);
    float* NV = (float*)carve((size_t)2 * 16 * NCH * 2 * 128 * 4); float* SC = (float*)carve((size_t)2 * 16 * NCH * 2 * 4 * 4);
    bf16_t* xl = (bf16_t*)carve((size_t)ML * D * 2);
    bf16_t* WinT = (bf16_t*)carve((size_t)4096 * D * 2); bf16_t* WoutT = (bf16_t*)carve((size_t)D * D * 2);
    fp8_t* WguT = (fp8_t*)carve((size_t)NE * 5632 * D);
    fp8_t* WdT = (fp8_t*)carve((size_t)NE * D * FF);
    float* wsc = (float*)carve(256);
    const size_t e0 = off;
    bf16_t* XN = (bf16_t*)carve((size_t)MA * D * 2); bf16_t* Pb = (bf16_t*)carve((size_t)MA * PBC * 2);
    bf16_t* ST = (bf16_t*)carve((size_t)2 * 16 * NCH * 2 * 16384 * 2); bf16_t* YM = (bf16_t*)carve((size_t)ML * D * 2);
    const size_t early_end = off; off = e0;
    fp8_t* Hb = (fp8_t*)carve((size_t)NSLOT * FF); fp8_t* H2 = (fp8_t*)carve((size_t)ML * D); bf16_t* Ys = (bf16_t*)carve((size_t)NSLOT * D * 2);
    if (off < early_end) off = early_end;
    if (off > ws_size) { fprintf(stderr, "ws too small: need %zu have %zu\n", off, ws_size); return; }

    static int grid = 0;
    if (!grid) {
        int dev = 0, cus = 0, per_cu = 0;
        hipGetDevice(&dev); hipDeviceGetAttribute(&cus, hipDeviceAttributeMultiprocessorCount, dev);
        hipFuncSetAttribute((const void*)mega_fwd, hipFuncAttributeMaxDynamicSharedMemorySize, LDS_BYTES);
        hipOccupancyMaxActiveBlocksPerMultiprocessor(&per_cu, mega_fwd, NTHR, LDS_BYTES);
        if (per_cu < 1) { fprintf(stderr, "occupancy query says 0 blocks/CU\n"); per_cu = 1; }
        grid = cus * 1;
        if (grid % 8) grid -= grid % 8;
    }
    MegaP P{};
    P.q.x = x; P.q.ctx = ctx; P.q.c = c; P.q.c_ctx = c_ctx; P.q.w_ada = w_ada; P.q.b_ada = b_ada; P.q.norm1_w = norm1_w; P.q.w_in = w_in; P.q.w_out = w_out; P.q.mnw = mnw; P.q.rnw = rnw; P.q.w_router = w_router; P.q.norm2_w = norm2_w; P.q.wsc2 = wsc2; P.q.biasr = biasr; P.q.WrT = WrT;
    P.q.mod = mod; P.q.ropetab = ropetab; P.q.G = G; P.q.normw = normw; P.q.WinT = WinT; P.q.WoutT = WoutT; P.q.XN = XN; P.q.Pb = Pb;
    P.m.Pb = Pb; P.m.G = G; P.m.gate_bias = gate_bias; P.m.decay_logit = decay_logit; P.m.normw = normw; P.m.ST = ST; P.m.NV = NV; P.m.SC = SC; P.m.YM = YM;
    P.t.x = x; P.t.mod = mod; P.t.norm2_w = norm2_w; P.t.w_router = w_router; P.t.final_w = final_w; P.t.YM = YM; P.t.WoutT = WoutT; P.t.Ys = Ys;
    P.t.wsc2 = wsc2; P.t.biasr = biasr; P.t.WrT = WrT; P.t.xrec = xrec; P.t.bar = bar; P.t.xl = xl; P.t.aff = aff; P.t.gate = gate; P.t.out = out; P.t.H2 = H2; P.t.idx = erow; P.t.slotmap = slotmap;
    P.f.w_gate = w_gate; P.f.w_up = w_up; P.f.w_down = w_down; P.f.gate = gate; P.f.erow = erow; P.f.wsc = wsc; P.f.WguT = WguT; P.f.WdT = WdT; P.f.H2 = H2; P.f.Hb = Hb; P.f.Ys = Ys;
    P.bar = bar;
    hipMemsetAsync(bar, 0, 32768, stream);
    void* args[] = {&P};
    hipError_t e = hipLaunchCooperativeKernel((const void*)mega_fwd, dim3(grid), dim3(NTHR), args, LDS_BYTES, stream);
    if (e != hipSuccess) fprintf(stderr, "cooperative launch failed: %s (grid %d)\n", hipGetErrorString(e), grid);
}
```
